# Optimizing an MI355X kernel written in HIP

```python
import math
import jax, jax.numpy as jnp
from jax import lax
import numpy as np

D_MODEL = 1024
BATCH = 2
SEQ = 8192
DEPTH = 1
DEC_BATCH = 32
DEC_SEQ = 4
PAST_LEN = 16384
PAGE_SIZE = 128

N_HEADS = 8
HEAD_DIM = 64
N_KV_HEADS = 2
GROUP = N_HEADS // N_KV_HEADS
NSA_WIDTH = N_HEADS * HEAD_DIM
KV_WIDTH = N_KV_HEADS * HEAD_DIM
CMP_LEN = 32
CMP_STRIDE = 16
CMP_RATIO = CMP_LEN // CMP_STRIDE
CMP_HIDDEN = 256
SEL_BLOCK = 64
N_SELECT = 16
WINDOW = 512
CONV_DIM = 512
CONV_WIDTH = 3
D_FF = 4 * D_MODEL
N_BUCKETS = 32
MAX_DISTANCE = 128
Q_BLOCK = 128
RMS_EPS = 1e-6
NEG_INF = -1e30
FORCE_BONUS = 1e4
SPLIT_SIZES = (NSA_WIDTH,) + (KV_WIDTH,) * 6 + (3 * N_HEADS, CONV_DIM, CONV_DIM, CONV_DIM, D_MODEL, D_MODEL)
IN_COLS = sum(SPLIT_SIZES)

kernel_name = "hybrid_nsa_shortconv_decode_step"


def rms_norm(x, g):
    x32 = x.astype(jnp.float32)
    y = x32 * lax.rsqrt(jnp.mean(x32 * x32, axis=-1, keepdims=True) + RMS_EPS)
    return (y * g.astype(jnp.float32)).astype(x.dtype)


def rel_bucket(dist):
    max_exact = N_BUCKETS // 2
    n = jnp.maximum(dist, 0)
    nf = jnp.maximum(n, max_exact).astype(jnp.float32)
    large = max_exact + (jnp.log(nf / max_exact) / math.log(MAX_DISTANCE / max_exact)
                         * (N_BUCKETS - max_exact)).astype(jnp.int32)
    return jnp.where(n < max_exact, n, jnp.minimum(large, N_BUCKETS - 1))


def masked_softmax(logits, valid):
    p = jax.nn.softmax(jnp.where(valid, logits, NEG_INF), axis=-1)
    return p * jnp.any(valid, axis=-1, keepdims=True)


def compress(k, pe, w1, w2):
    b, t, hk, dh = k.shape
    n_chunk = t // CMP_STRIDE
    n_cmp = n_chunk - CMP_RATIO + 1
    chunks = (k[:, :n_chunk * CMP_STRIDE]
              .reshape(b, n_chunk, CMP_STRIDE, hk, dh)
              .transpose(0, 1, 3, 2, 4)
              .reshape(b, n_chunk, hk, CMP_STRIDE * dh))
    w1r = w1.reshape(CMP_RATIO, CMP_STRIDE * dh, CMP_HIDDEN)
    proj = jnp.einsum('bckx,mxh->mbckh', chunks, w1r)
    hid = pe.reshape(-1) @ w1
    for m in range(CMP_RATIO):
        hid = hid + proj[m, :, m:m + n_cmp]
    return jax.nn.gelu(hid) @ w2


def cmp_to_sel_map(n_cmp, n_blocks):
    c0 = jnp.arange(n_cmp)[:, None] * CMP_STRIDE
    s0 = jnp.arange(n_blocks)[None, :] * SEL_BLOCK
    ov = jnp.minimum(c0 + CMP_LEN, s0 + SEL_BLOCK) - jnp.maximum(c0, s0)
    return jnp.clip(ov, 0).astype(jnp.float32) / CMP_LEN


def nsa_group(q, t, kc, vc, cend, ksb, vsb, kw, vw, wpos, gates, table_g, sel_map):
    b, g, nq, dh = q.shape
    scale = dh ** -0.5
    f32 = jnp.float32
    cdist = t[:, None] - cend[None, :]
    lc = jnp.einsum('bgqd,bcd->bgqc', q, kc).astype(f32) * scale + table_g[:, rel_bucket(cdist)]
    pc = masked_softmax(lc, cdist >= 0)
    o_cmp = jnp.einsum('bgqc,bcd->bgqd', pc.astype(vc.dtype), vc)
    n_blocks = ksb.shape[1]
    blk = jnp.arange(n_blocks)[None, :]
    cur = (t // SEL_BLOCK)[:, None]
    imp = jnp.einsum('bgqc,cj->bqj', pc, sel_map)
    forced = (blk == 0) | (blk == cur) | (blk == cur - 1)
    imp = jnp.where(blk > cur, NEG_INF, imp + FORCE_BONUS * forced)
    _, idx = lax.top_k(imp, min(N_SELECT, n_blocks))
    bidx = jnp.arange(b)[:, None, None]
    ks, vs = ksb[bidx, idx], vsb[bidx, idx]
    sdist = t[None, :, None, None] - (idx[..., None] * SEL_BLOCK + jnp.arange(SEL_BLOCK))
    ls = (jnp.einsum('bgqd,bqnld->bgqnl', q, ks).astype(f32) * scale
          + jnp.moveaxis(table_g[:, rel_bucket(sdist)], 0, 1))
    n_keys = idx.shape[-1] * SEL_BLOCK
    ps = masked_softmax(ls.reshape(b, g, nq, n_keys), (sdist >= 0).reshape(b, 1, nq, n_keys))
    o_slc = jnp.einsum('bgqm,bqmd->bgqd', ps.astype(vs.dtype), vs.reshape(b, nq, n_keys, dh))
    wdist = t[:, None] - wpos[None, :]
    lw = jnp.einsum('bgqd,bkd->bgqk', q, kw).astype(f32) * scale + table_g[:, rel_bucket(wdist)]
    pw = masked_softmax(lw, (wdist >= 0) & (wdist < WINDOW) & (wpos >= 0)[None, :])
    o_win = jnp.einsum('bgqk,bkd->bgqd', pw.astype(vw.dtype), vw)
    gs = jax.nn.sigmoid(gates.astype(f32)).astype(o_cmp.dtype)
    return gs[..., 0:1] * o_cmp + gs[..., 1:2] * o_slc + gs[..., 2:3] * o_win


nsa_attend = jax.vmap(nsa_group, in_axes=(0, None, 0, 0, None, 0, 0, 0, 0, None, 0, 0, None))


def kv_rows(z):
    return z.reshape(z.shape[0], z.shape[1], N_KV_HEADS, HEAD_DIM)


def to_groups(z, last):
    return z.reshape(z.shape[0], z.shape[1], N_KV_HEADS, GROUP, last).transpose(2, 0, 3, 1, 4)


def nsa_memory(kc, vc, ks, vs, cmp_w):
    pe_k, w1_k, w2_k, pe_v, w1_v, w2_v = cmp_w
    b, t, hk, dh = kc.shape
    kcmp = compress(kc, pe_k, w1_k, w2_k).transpose(2, 0, 1, 3)
    vcmp = compress(vc, pe_v, w1_v, w2_v).transpose(2, 0, 1, 3)
    n_cmp = kcmp.shape[2]
    cend = jnp.arange(n_cmp) * CMP_STRIDE + CMP_LEN - 1
    n_blocks = -(-t // SEL_BLOCK)
    pad = ((0, 0), (0, n_blocks * SEL_BLOCK - t), (0, 0), (0, 0))

    def blocks(z):
        return jnp.pad(z, pad).reshape(b, n_blocks, SEL_BLOCK, hk, dh).transpose(3, 0, 1, 2, 4)

    return kcmp, vcmp, cend, blocks(ks), blocks(vs), cmp_to_sel_map(n_cmp, n_blocks)


def nsa_prompt(q, kc, vc, ks, vs, kw, vw, gates, table, cmp_w):
    b, t, _ = q.shape
    kcmp, vcmp, cend, ksb, vsb, sel_map = nsa_memory(kc, vc, ks, vs, cmp_w)
    qg, gg = to_groups(q, HEAD_DIM), to_groups(gates, 3)
    pad = ((0, 0), (0, 0), (WINDOW, 0), (0, 0))
    kwp = jnp.pad(kw.transpose(2, 0, 1, 3), pad)
    vwp = jnp.pad(vw.transpose(2, 0, 1, 3), pad)

    def block(qb):
        s0 = qb * Q_BLOCK
        pos = s0 + jnp.arange(Q_BLOCK)
        wpos = s0 - WINDOW + jnp.arange(Q_BLOCK + WINDOW)
        return nsa_attend(
            lax.dynamic_slice_in_dim(qg, s0, Q_BLOCK, axis=3), pos, kcmp, vcmp, cend, ksb, vsb,
            lax.dynamic_slice_in_dim(kwp, s0, Q_BLOCK + WINDOW, axis=2),
            lax.dynamic_slice_in_dim(vwp, s0, Q_BLOCK + WINDOW, axis=2), wpos,
            lax.dynamic_slice_in_dim(gg, s0, Q_BLOCK, axis=3), table, sel_map)

    outs = lax.map(block, jnp.arange(t // Q_BLOCK))
    return outs.transpose(2, 0, 4, 1, 3, 5).reshape(b, t, NSA_WIDTH)


def nsa_sample(q, kc, vc, ks, vs, kw, vw, gates, table, cmp_w, past_len):
    b, s, _ = q.shape
    kcmp, vcmp, cend, ksb, vsb, sel_map = nsa_memory(kc, vc, ks, vs, cmp_w)
    lw = kw.shape[1]
    pos = past_len + jnp.arange(s)
    wpos = past_len + s - lw + jnp.arange(lw)
    o = nsa_attend(to_groups(q, HEAD_DIM), pos, kcmp, vcmp, cend, ksb, vsb,
                   kw.transpose(2, 0, 1, 3), vw.transpose(2, 0, 1, 3), wpos,
                   to_groups(gates, 3), table, sel_map)
    return o.transpose(1, 3, 0, 2, 4).reshape(b, s, NSA_WIDTH)


def short_conv(b_gate, c_gate, h, past, conv_w, conv_b):
    u = c_gate * h
    up = jnp.concatenate([past.astype(u.dtype), u], axis=1)
    t = u.shape[1]
    y = conv_b
    for k in range(CONV_WIDTH):
        y = y + conv_w[k] * up[:, k:k + t]
    return b_gate * y, up[:, t:]


def mixer_inputs(x, g_attn, w_in):
    h = rms_norm(x, g_attn)
    offsets = np.cumsum(SPLIT_SIZES)[:-1].tolist()
    return jnp.split(h @ w_in, offsets, axis=-1)


def merge_and_mlp(x, a, c, ga, gb, w_nsa_out, w_conv_out, w_o, g_mlp, w_up, w_down):
    m = jax.nn.sigmoid(ga) * (a @ w_nsa_out) + jax.nn.sigmoid(gb) * (c @ w_conv_out)
    x = x + m @ w_o
    h = rms_norm(x, g_mlp)
    return x + jnp.square(jax.nn.relu(h @ w_up)) @ w_down


def setup_inputs(seed: int = 0) -> dict:
    key = jax.random.key(seed)
    keys = iter(jax.random.split(key, 40))

    def nrm(shape, scale):
        return scale * jax.random.normal(next(keys), shape, jnp.float32)

    n_pages = PAST_LEN // PAGE_SIZE
    n_phys = (DEC_BATCH * n_pages * 5) // 4
    win_buf = min(WINDOW, PAST_LEN)
    perm = jax.random.permutation(next(keys), n_phys)
    page_table = perm[:DEC_BATCH * n_pages].reshape(DEC_BATCH, n_pages).astype(jnp.int32)
    page_shape = (DEPTH, n_phys, PAGE_SIZE, N_KV_HEADS, HEAD_DIM)
    win_shape = (DEPTH, DEC_BATCH, win_buf, N_KV_HEADS, HEAD_DIM)
    L = DEPTH
    return {
        "x_prompt": nrm((BATCH, SEQ, D_MODEL), 1.0),
        "x_sample": nrm((DEC_BATCH, DEC_SEQ, D_MODEL), 1.0),
        "cache_cmp_k": nrm(page_shape, 1.0),
        "cache_cmp_v": nrm(page_shape, 1.0),
        "cache_slc_k": nrm(page_shape, 1.0),
        "cache_slc_v": nrm(page_shape, 1.0),
        "state_win_k": nrm(win_shape, 1.0),
        "state_win_v": nrm(win_shape, 1.0),
        "state_conv": nrm((DEPTH, DEC_BATCH, CONV_WIDTH - 1, CONV_DIM), 1.0),
        "page_table": page_table,
        "g_attn": 1.0 + nrm((L, D_MODEL), 0.02),
        "w_in": nrm((L, D_MODEL, IN_COLS), D_MODEL ** -0.5),
        "cmp_pe_k": nrm((L, CMP_LEN, HEAD_DIM), 0.1),
        "cmp_w1_k": nrm((L, CMP_LEN * HEAD_DIM, CMP_HIDDEN), (CMP_LEN * HEAD_DIM) ** -0.5),
        "cmp_w2_k": nrm((L, CMP_HIDDEN, HEAD_DIM), CMP_HIDDEN ** -0.5),
        "cmp_pe_v": nrm((L, CMP_LEN, HEAD_DIM), 0.1),
        "cmp_w1_v": nrm((L, CMP_LEN * HEAD_DIM, CMP_HIDDEN), (CMP_LEN * HEAD_DIM) ** -0.5),
        "cmp_w2_v": nrm((L, CMP_HIDDEN, HEAD_DIM), CMP_HIDDEN ** -0.5),
        "conv_w": nrm((L, CONV_WIDTH, CONV_DIM), CONV_WIDTH ** -0.5),
        "conv_b": nrm((L, CONV_DIM), 0.01),
        "w_nsa_out": nrm((L, NSA_WIDTH, D_MODEL), NSA_WIDTH ** -0.5),
        "w_conv_out": nrm((L, CONV_DIM, D_MODEL), CONV_DIM ** -0.5),
        "w_o": nrm((L, D_MODEL, D_MODEL), D_MODEL ** -0.5),
        "g_mlp": 1.0 + nrm((L, D_MODEL), 0.02),
        "w_up": nrm((L, D_MODEL, D_FF), D_MODEL ** -0.5),
        "w_down": nrm((L, D_FF, D_MODEL), D_FF ** -0.5),
        "rel_bias": nrm((N_BUCKETS, N_HEADS), 0.5),
        "g_final": 1.0 + nrm((D_MODEL,), 0.02),
    }


def reference(x_prompt, x_sample, cache_cmp_k, cache_cmp_v, cache_slc_k, cache_slc_v,
              state_win_k, state_win_v, state_conv, page_table,
              g_attn, w_in, cmp_pe_k, cmp_w1_k, cmp_w2_k, cmp_pe_v, cmp_w1_v, cmp_w2_v,
              conv_w, conv_b, w_nsa_out, w_conv_out, w_o, g_mlp, w_up, w_down,
              rel_bias, g_final):
    table = rel_bias.astype(jnp.float32).T.reshape(N_KV_HEADS, GROUP, N_BUCKETS)
    n_prompt, len_prompt, _ = x_prompt.shape
    n_sample = x_sample.shape[0]
    past_len = page_table.shape[1] * cache_cmp_k.shape[2]
    win_buf = state_win_k.shape[2]
    win_prompt = min(WINDOW, len_prompt)

    def paged(cache):
        return cache[page_table].reshape(n_sample, past_len, N_KV_HEADS, HEAD_DIM)

    xp, xs = x_prompt, x_sample
    new_p = [[] for _ in range(7)]
    new_s = [[] for _ in range(7)]
    for l in range(DEPTH):
        cmp_w = (cmp_pe_k[l], cmp_w1_k[l], cmp_w2_k[l], cmp_pe_v[l], cmp_w1_v[l], cmp_w2_v[l])
        tail = (w_nsa_out[l], w_conv_out[l], w_o[l], g_mlp[l], w_up[l], w_down[l])

        q, kc, vc, ks, vs, kw, vw, gn, bg, cg, hc, ga, gb = mixer_inputs(xp, g_attn[l], w_in[l])
        kc, vc, ks, vs, kw, vw = (kv_rows(z) for z in (kc, vc, ks, vs, kw, vw))
        a = nsa_prompt(q, kc, vc, ks, vs, kw, vw, gn, table, cmp_w)
        c, conv_p = short_conv(bg, cg, hc, jnp.zeros((n_prompt, CONV_WIDTH - 1, CONV_DIM), hc.dtype),
                               conv_w[l], conv_b[l])
        xp = merge_and_mlp(xp, a, c, ga, gb, *tail)
        for lst, z in zip(new_p, (kc, vc, ks, vs, kw[:, -win_prompt:], vw[:, -win_prompt:], conv_p)):
            lst.append(z)

        q, kc, vc, ks, vs, kw, vw, gn, bg, cg, hc, ga, gb = mixer_inputs(xs, g_attn[l], w_in[l])
        kc, vc, ks, vs, kw, vw = (kv_rows(z) for z in (kc, vc, ks, vs, kw, vw))
        kc_all = jnp.concatenate([paged(cache_cmp_k[l]).astype(kc.dtype), kc], axis=1)
        vc_all = jnp.concatenate([paged(cache_cmp_v[l]).astype(vc.dtype), vc], axis=1)
        ks_all = jnp.concatenate([paged(cache_slc_k[l]).astype(ks.dtype), ks], axis=1)
        vs_all = jnp.concatenate([paged(cache_slc_v[l]).astype(vs.dtype), vs], axis=1)
        kw_all = jnp.concatenate([state_win_k[l].astype(kw.dtype), kw], axis=1)
        vw_all = jnp.concatenate([state_win_v[l].astype(vw.dtype), vw], axis=1)
        a = nsa_sample(q, kc_all, vc_all, ks_all, vs_all, kw_all, vw_all, gn, table, cmp_w, past_len)
        c, conv_s = short_conv(bg, cg, hc, state_conv[l], conv_w[l], conv_b[l])
        xs = merge_and_mlp(xs, a, c, ga, gb, *tail)
        for lst, z in zip(new_s, (kc, vc, ks, vs, kw_all[:, -win_buf:], vw_all[:, -win_buf:], conv_s)):
            lst.append(z)

    p_cmp_k, p_cmp_v, p_slc_k, p_slc_v, p_win_k, p_win_v, p_conv = (jnp.stack(z) for z in new_p)
    s_cmp_k, s_cmp_v, s_slc_k, s_slc_v, s_win_k, s_win_v, s_conv = (jnp.stack(z) for z in new_s)
    y_prompt = rms_norm(xp, g_final)
    y_sample = rms_norm(xs, g_final)
    return (y_prompt, y_sample,
            p_cmp_k, p_cmp_v, p_slc_k, p_slc_v, p_win_k, p_win_v, p_conv,
            s_cmp_k, s_cmp_v, s_slc_k, s_slc_v, s_win_k, s_win_v, s_conv)
```

```cpp
#include <hip/hip_runtime.h>
#include <cstdio>
#include <cstdint>

#ifndef MK_N_LAUNCHES
#define MK_N_LAUNCHES 1
#endif

constexpr int DM = 1024, BATCH = 2, SEQ = 8192, NP = BATCH * SEQ;
constexpr int DECB = 32, DECS = 4, NSMP = DECB * DECS;
constexpr int MTOK = NP + 256;
constexpr int PAST = 16384, PAGE = 128, NPAGE = PAST / PAGE, NPHYS = 5120;
constexpr int NH = 8, HD = 64, NKV = 2, GRP = 4, NSAW = 512, KVW = 128;
constexpr int CMPH = 256, DFF = 4096, CONVD = 512, INCOLS = 4888, NIN = 5120;
constexpr int WINL = 512, NSEL = 16;
constexpr float RMS_EPS = 1e-6f;
constexpr float LOG2E = 1.4426950408889634f;
constexpr float QSCALE = 0.125f * LOG2E;

constexpr size_t O_YP = 0, O_YS = O_YP + (size_t)NP * DM;
constexpr size_t O_PCK = O_YS + (size_t)NSMP * DM, O_PCV = O_PCK + (size_t)NP * KVW, O_PSK = O_PCV + (size_t)NP * KVW, O_PSV = O_PSK + (size_t)NP * KVW;
constexpr size_t O_PWK = O_PSV + (size_t)NP * KVW, O_PWV = O_PWK + (size_t)BATCH * WINL * KVW, O_PCONV = O_PWV + (size_t)BATCH * WINL * KVW;
constexpr size_t O_SCK = O_PCONV + (size_t)BATCH * 2 * CONVD, O_SCV = O_SCK + (size_t)NSMP * KVW, O_SSK = O_SCV + (size_t)NSMP * KVW, O_SSV = O_SSK + (size_t)NSMP * KVW;
constexpr size_t O_SWK = O_SSV + (size_t)NSMP * KVW, O_SWV = O_SWK + (size_t)DECB * WINL * KVW, O_SCONV = O_SWV + (size_t)DECB * WINL * KVW;
constexpr size_t O_END = O_SCONV + (size_t)DECB * 2 * CONVD;
static_assert(O_END == 29853696, "d_out map");

constexpr size_t MiB = 1u << 20;
constexpr size_t WS_CTL = 0, CTL_ZERO_BYTES = 1 * MiB;
constexpr size_t WS_WIN = 2 * MiB;
constexpr size_t WS_WNSA = 12 * MiB;
constexpr size_t WS_WCONV = 13 * MiB;
constexpr size_t WS_WO = 14 * MiB;
constexpr size_t WS_WUP = 16 * MiB;
constexpr size_t WS_WDN = 24 * MiB;
constexpr size_t WS_W1K = 32 * MiB, WS_W1V = 33 * MiB;
constexpr size_t WS_W2K = 34 * MiB, WS_W2V = 34 * MiB + 65536;
constexpr size_t WS_PE = 34 * MiB + 131072;
constexpr size_t WS_XN = 36 * MiB;
constexpr size_t WS_QB = 70 * MiB;
constexpr size_t WS_CV = 88 * MiB;
constexpr size_t WS_GAB = 138 * MiB;
constexpr size_t WS_GN = 204 * MiB;
constexpr size_t WS_CKP = 208 * MiB, WS_KSP = 213 * MiB, WS_KWP = 218 * MiB;
constexpr size_t WS_CVP = 223 * MiB, WS_VTS = 228 * MiB, WS_VTW = 233 * MiB;
constexpr size_t KV3_STRIDE = 5 * MiB;
constexpr size_t WS_GP = 238 * MiB;
constexpr size_t WS_KCP = 240 * MiB;
constexpr size_t WS_VCTP = 241 * MiB;
constexpr size_t WS_AB = 242 * MiB;
constexpr size_t WS_CB = 259 * MiB;
constexpr size_t WS_M1 = 276 * MiB;
constexpr size_t WS_MB = 342 * MiB;
constexpr size_t WS_X1 = 375 * MiB;
constexpr size_t WS_X1B = 441 * MiB;
constexpr size_t WS_PSS = 474 * MiB;
constexpr size_t WS_H = 476 * MiB;
constexpr size_t WS_CKS = 608 * MiB, WS_CVS = 738 * MiB;
constexpr size_t WS_GS = 868 * MiB;
constexpr size_t WS_KCS = 932 * MiB, WS_VCS = 948 * MiB;
constexpr size_t WS_KWS = 964 * MiB, WS_VTWS = 970 * MiB;
constexpr size_t WS_PD = 976 * MiB;
constexpr size_t WS_PSS2 = 982 * MiB;
constexpr size_t WS_END = 984 * MiB;
constexpr int CW_TMO = 0, CW_QUEUE = 64, CW_BAR = 4096, CW_PANEL = 32768;

constexpr int RING_OFF = 0, RING_BYTES = 131072;
constexpr int LUT_OFF = RING_BYTES, LUT_BYTES = 4096;
constexpr int WSCR_OFF = LUT_OFF + LUT_BYTES, WSCR_BYTES = 2304;
constexpr int LDSCTL_OFF = WSCR_OFF + 8 * WSCR_BYTES, MISC_OFF = LDSCTL_OFF + 320;
constexpr int LDS_BYTES = 155648;
static_assert(MISC_OFF + 128 <= LDS_BYTES && LDS_BYTES <= 163840, "LDS map");
constexpr int NWAVES = 8;
#ifndef W_IN_R0
#define W_IN_R0 7
#endif

namespace pg8 {
#define PG8_LAS __attribute__((address_space(3)))
typedef unsigned short bf16_t;
typedef short bf16x8 __attribute__((ext_vector_type(8)));
typedef float f32x4 __attribute__((ext_vector_type(4)));
typedef unsigned u32x4 __attribute__((ext_vector_type(4)));
constexpr int BM = 256, BK = 64, HALF = 128, HTB = HALF * BK * 2  , STAGE_BYTES = 8 * HTB, NXCD = 8, WGM = 8;

__host__ __device__ __forceinline__ int lds_byte(int r, int c) { const int st = (r >> 4) * 2 + (c >> 5), rr = r & 15, cc = c & 31, ob = rr * 64 + cc * 2; return st * 1024 + (ob ^ (((ob >> 9) & 1) << 5)); }
__host__ __device__ __forceinline__ void stage_rc(int b, int& R, int& C) { const int st = b / 1024, sb = b % 1024, swz = sb ^ (((sb >> 9) & 1) << 5); R = (st >> 1) * 16 + swz / 64; C = (st & 1) * 32 + (swz % 64) / 2; }
__host__ __device__ __forceinline__ int perm32(int rho) { const int n = rho >> 4, i = rho & 15; return 8 * (i >> 2) + 4 * n + (i & 3); }

struct Unit { int pm, pn, aoff; };
struct Gemm { const bf16_t* A; const bf16_t* Bt; int M, N, K, lda, ldb; };

struct StaticOrder {
    int nM, nN, nwg, G, c;
    __host__ __device__ void init(int M, int N, int G_, int c_) { nM = M / BM; nN = N / BM; nwg = nM * nN; G = G_; c = c_; }
    __host__ __device__ __forceinline__ bool next(int i, Unit& u) const {
        const long L = (long)i * G + c; if (L >= nwg) return false;
        int wgid = (int)L; { const int q = nwg / NXCD, r = nwg % NXCD, xcd = wgid % NXCD, off = wgid / NXCD; wgid = (xcd < r ? xcd * (q + 1) : r * (q + 1) + (xcd - r) * q) + off; }
        const int nig = WGM * nN, gid = wgid / nig, fm = gid * WGM, gsz = (nM - fm) < WGM ? (nM - fm) : WGM;
        u.pm = fm + ((wgid % nig) % gsz); u.pn = (wgid % nig) / gsz; u.aoff = 0; return true;
    }
    __device__ __forceinline__ void a_ready(const Unit&) const {}
    __device__ __forceinline__ void done(const Unit&) const {}
};

typedef float f32x2_t __attribute__((ext_vector_type(2)));
typedef __bf16 bf16x2_t __attribute__((ext_vector_type(2)));
__device__ __forceinline__ unsigned cvt_pk_bf16(float lo, float hi) { f32x2_t v = {lo, hi}; bf16x2_t b = __builtin_convertvector(v, bf16x2_t); return __builtin_bit_cast(unsigned, b); }
struct MixedOrder {
    int nM, nN, nwg, c, R0; bool conv;
    __host__ __device__ void init(int M, int N, int c_, int R0_) { nM = M / BM; nN = N / BM; nwg = nM * nN; c = c_; R0 = R0_; conv = (c_ & 1) == 0; }
    __host__ __device__ __forceinline__ bool next(int i, Unit& u) const {
        const long L = conv ? (long)R0 * 128 + (long)i * 256 + c : (i < R0 ? (long)i * 128 + (c >> 1) : (long)R0 * 128 + (long)(i - R0) * 256 + c);
        if (L >= nwg) return false;
        int wgid = (int)L; { const int q = nwg / NXCD, r = nwg % NXCD, xcd = wgid % NXCD, off = wgid / NXCD; wgid = (xcd < r ? xcd * (q + 1) : r * (q + 1) + (xcd - r) * q) + off; }
        const int nig = WGM * nN, gid = wgid / nig, fm = gid * WGM, gsz = (nM - fm) < WGM ? (nM - fm) : WGM;
        u.pm = fm + ((wgid % nig) % gsz); u.pn = (wgid % nig) / gsz; u.aoff = 0; return true;
    }
    __device__ __forceinline__ void a_ready(const Unit&) const {}
    __device__ __forceinline__ void done(const Unit&) const {}
};
typedef unsigned u32x2 __attribute__((ext_vector_type(2)));
__device__ __forceinline__ float sigmoid_f(float x) { return __builtin_amdgcn_rcpf(1.f + __builtin_amdgcn_exp2f(x * -1.4426950408889634f)); }
__device__ __forceinline__ float gelu_tanh_f(float x) {
    const float u2 = x * (1.5957691216057308f + 0.07135481627263f * x * x);
    return x * __builtin_amdgcn_rcpf(1.f + __builtin_amdgcn_exp2f(u2 * -1.4426950408889634f));
}
__device__ __forceinline__ float bf2f(unsigned short h) { return __builtin_bit_cast(float, (unsigned)h << 16); }
__device__ __forceinline__ float bflo(unsigned w) { return __builtin_bit_cast(float, w << 16); }
__device__ __forceinline__ float bfhi(unsigned w) { return __builtin_bit_cast(float, w & 0xffff0000u); }
__device__ __forceinline__ unsigned short f2bf_rne(float f) { unsigned u = __builtin_bit_cast(unsigned, f); return (unsigned short)((u + 0x7fffu + ((u >> 16) & 1u)) >> 16); }
__device__ __forceinline__ u32x4 pack8(const f32x4& a, const f32x4& b) { u32x4 w; w.x = cvt_pk_bf16(a[0], a[1]); w.y = cvt_pk_bf16(a[2], a[3]); w.z = cvt_pk_bf16(b[0], b[1]); w.w = cvt_pk_bf16(b[2], b[3]); return w; }
__device__ __forceinline__ int kperm64(int k) { return (k & 32) + 8 * ((k >> 2) & 3) + 4 * ((k >> 4) & 1) + (k & 3); }
__device__ __forceinline__ int ktile_off(int key, int d) { return ((key >> 4) * 2 + (d >> 5)) * 512 + (((d >> 3) & 3) * 16 + (key & 15)) * 8 + (d & 7); }
__device__ __forceinline__ int vtile_off(int key, int d) { const int p = kperm64(key); return ((d >> 4) * 2 + (p >> 5)) * 512 + (((p >> 3) & 3) * 16 + (d & 15)) * 8 + (p & 7); }

#ifdef DBG_NO_SIG
#define SIGF(x) (x)
#else
#define SIGF(x) sigmoid_f(x)
#endif
__device__ __forceinline__ int vtile8_off(int key, int d) { const int p = kperm64(key); return ((d >> 4) * 64 + ((p >> 3) & 3) * 16 + (d & 15)) * 16 + (p >> 5) * 8 + (p & 7); }
__device__ __forceinline__ int ktile8_off(int key, int d) { return ((key >> 4) * 64 + ((d >> 3) & 3) * 16 + (key & 15)) * 16 + (d >> 5) * 8 + (d & 7); }
__device__ __forceinline__ unsigned char f2fp8(float x) { return (unsigned char)(__builtin_amdgcn_cvt_pk_fp8_f32(x, 0.f, 0, false) & 0xff); }
struct EpiIn {
    static constexpr bool PERM = true, AFTER_DRAIN = false;
    __device__ __forceinline__ bool reset_acc(const Unit&) const { return true; }
    float* out; bf16_t *Qb, *CV, *GAB; float* GN; bf16_t *K3, *V3;
    __device__ __forceinline__ void operator()(const f32x4 (&acc)[2][2][4][2], const Unit& u, int wr, int wc, int fr, int fq) const {
        const int pn = u.pn, rbase = u.pm * BM + wr * 64 + fr, cw = wc * 32 + fq * 8;
        if (pn < 2) {
#pragma unroll
            for (int ai = 0; ai < 2; ++ai)
#pragma unroll
                for (int m = 0; m < 4; ++m) { const int row = rbase + ai * HALF + m * 16; bf16_t* p = Qb + (size_t)row * 512 + pn * 256 + cw;
#pragma unroll
                    for (int bj = 0; bj < 2; ++bj) *(u32x4*)(p + bj * HALF) = pack8(acc[ai][bj][m][0] * QSCALE, acc[ai][bj][m][1] * QSCALE); }
        } else if (pn < 5) {
            const int kvh = wc >> 1, d0 = cw & 63;
#pragma unroll
            for (int ai = 0; ai < 2; ++ai)
#pragma unroll
                for (int m = 0; m < 4; ++m) { const int row = rbase + ai * HALF + m * 16;
                    if (row < NP) {
                        const int b = row >> 13, t = row & (SEQ - 1);
                        float *fk, *fv;
                        if (pn == 2) { fk = out + O_PCK + (size_t)row * 128; fv = out + O_PCV + (size_t)row * 128; }
                        else if (pn == 3) { fk = out + O_PSK + (size_t)row * 128; fv = out + O_PSV + (size_t)row * 128; }
                        else { const bool w = t >= SEQ - WINL; const size_t o = (size_t)(b * WINL + (t - (SEQ - WINL))) * 128; fk = w ? out + O_PWK + o : nullptr; fv = w ? out + O_PWV + o : nullptr; }
                        if (fk) { *(f32x4*)(fk + cw) = acc[ai][0][m][0]; *(f32x4*)(fk + cw + 4) = acc[ai][0][m][1]; *(f32x4*)(fv + cw) = acc[ai][1][m][0]; *(f32x4*)(fv + cw + 4) = acc[ai][1][m][1]; }
                        bf16_t* kd = K3 + (size_t)(pn - 2) * (KV3_STRIDE / 2); bf16_t* vd = V3 + (size_t)(pn - 2) * (KV3_STRIDE / 2);
                        if (pn == 2) { const size_t ro = ((size_t)(b * 2 + kvh) * SEQ + t) * 64 + d0;
                            *(u32x4*)(kd + ro) = pack8(acc[ai][0][m][0], acc[ai][0][m][1]); *(u32x4*)(vd + ro) = pack8(acc[ai][1][m][0], acc[ai][1][m][1]); }
                        else { const size_t blk = ((size_t)(b * 2 + kvh) * 128 + (t >> 6)) * 4096;
                            { const f32x4 ka = acc[ai][0][m][0], kb = acc[ai][0][m][1]; int w0 = 0, w1 = 0;
                              w0 = __builtin_amdgcn_cvt_pk_fp8_f32(ka[0], ka[1], w0, false); w0 = __builtin_amdgcn_cvt_pk_fp8_f32(ka[2], ka[3], w0, true);
                              w1 = __builtin_amdgcn_cvt_pk_fp8_f32(kb[0], kb[1], w1, false); w1 = __builtin_amdgcn_cvt_pk_fp8_f32(kb[2], kb[3], w1, true);
                              u32x2 kw; kw.x = (unsigned)w0; kw.y = (unsigned)w1; *(u32x2*)((unsigned char*)(kd + blk) + ktile8_off(t & 63, d0)) = kw; }
                            unsigned char* vt = (unsigned char*)(vd + blk);
#pragma unroll
                            for (int n = 0; n < 2; ++n)
#pragma unroll
                                for (int i = 0; i < 4; ++i) vt[vtile8_off(t & 63, d0 + n * 4 + i)] = f2fp8(acc[ai][1][m][n][i]); }
                    } else if (row < NP + NSMP) {
                        const int tk = row - NP, bs = tk >> 2, s = tk & 3;
                        float *fk, *fv;
                        if (pn == 2) { fk = out + O_SCK + (size_t)tk * 128; fv = out + O_SCV + (size_t)tk * 128; }
                        else if (pn == 3) { fk = out + O_SSK + (size_t)tk * 128; fv = out + O_SSV + (size_t)tk * 128; }
                        else { const size_t o = (size_t)(bs * WINL + (WINL - DECS) + s) * 128; fk = out + O_SWK + o; fv = out + O_SWV + o; }
                        *(f32x4*)(fk + cw) = acc[ai][0][m][0]; *(f32x4*)(fk + cw + 4) = acc[ai][0][m][1]; *(f32x4*)(fv + cw) = acc[ai][1][m][0]; *(f32x4*)(fv + cw + 4) = acc[ai][1][m][1];
                    }
                }
        } else if (pn < 11) {
#pragma unroll
            for (int ai = 0; ai < 2; ++ai)
#pragma unroll
                for (int m = 0; m < 4; ++m) { const int row = rbase + ai * HALF + m * 16; bf16_t* p = CV + (size_t)row * 1536 + (pn - 5) * 256 + cw;
#pragma unroll
                    for (int bj = 0; bj < 2; ++bj) *(u32x4*)(p + bj * HALF) = pack8(acc[ai][bj][m][0], acc[ai][bj][m][1]); }
        } else if (pn < 19) {
#pragma unroll
            for (int ai = 0; ai < 2; ++ai)
#pragma unroll
                for (int m = 0; m < 4; ++m) { const int row = rbase + ai * HALF + m * 16; bf16_t* p = GAB + (size_t)row * 2048 + (pn - 11) * 256 + cw;
#pragma unroll
                    for (int bj = 0; bj < 2; ++bj) { f32x4 a = acc[ai][bj][m][0], b = acc[ai][bj][m][1];
#pragma unroll
                        for (int i = 0; i < 4; ++i) { a[i] = SIGF(a[i]); b[i] = SIGF(b[i]); }
                        *(u32x4*)(p + bj * HALF) = pack8(a, b); } }
        } else {
            if (wc == 0 && fq < 3) {
#pragma unroll
                for (int ai = 0; ai < 2; ++ai)
#pragma unroll
                    for (int m = 0; m < 4; ++m) { const int row = rbase + ai * HALF + m * 16; float* p = GN + (size_t)row * 32 + cw;
#pragma unroll
                        for (int n = 0; n < 2; ++n) { f32x4 a = acc[ai][0][m][n];
#pragma unroll
                            for (int i = 0; i < 4; ++i) a[i] = sigmoid_f(a[i]);
                            *(f32x4*)(p + 4 * n) = a; } }
            }
        }
    }
};

struct EpiCmp {
    static constexpr bool PERM = true, AFTER_DRAIN = false;
    __device__ __forceinline__ bool reset_acc(const Unit&) const { return true; }
    bf16_t* G; const float* pe; size_t gstride;
    __device__ __forceinline__ void operator()(const f32x4 (&acc)[2][2][4][2], const Unit& u, int wr, int wc, int fr, int fq) const {
        const int rbase = u.pm * BM + wr * 64 + fr, cw = wc * 32 + fq * 8; const float* pe = this->pe + u.pn * 256; bf16_t* G = this->G + (size_t)u.pn * gstride;
        f32x4 pv[2][2];
#pragma unroll
        for (int bj = 0; bj < 2; ++bj)
#pragma unroll
            for (int n = 0; n < 2; ++n) pv[bj][n] = *(const f32x4*)(pe + bj * HALF + cw + 4 * n);
#pragma unroll
        for (int ai = 0; ai < 2; ++ai)
#pragma unroll
            for (int m = 0; m < 4; ++m) { const int row = rbase + ai * HALF + m * 16; bf16_t* p = G + (size_t)row * 256 + cw;
#pragma unroll
                for (int bj = 0; bj < 2; ++bj) { f32x4 a = acc[ai][bj][m][0] + pv[bj][0], b = acc[ai][bj][m][1] + pv[bj][1];
#pragma unroll
                    for (int i = 0; i < 4; ++i) { a[i] = gelu_tanh_f(a[i]); b[i] = gelu_tanh_f(b[i]); }
                    *(u32x4*)(p + bj * HALF) = pack8(a, b); } }
    }
};

struct PairOrder {
    StaticOrder so; int npn, aoff;
    __host__ __device__ void init(int M, int N, int G_, int c_, int aoff_) { so.init(M, N, G_, c_); npn = N / BM; aoff = aoff_; }
    __host__ __device__ __forceinline__ bool next(int i, Unit& u) const { if (i >= 2 || !so.next(0, u)) return false; if (i == 1) { u.pn += npn; u.aoff = aoff; } return true; }
    __device__ __forceinline__ void a_ready(const Unit&) const {}
    __device__ __forceinline__ void done(const Unit&) const {}
};
struct EpiNC {
    static constexpr bool PERM = true, AFTER_DRAIN = false;
    const bf16_t* GAB; bf16_t* Mb;
    __device__ __forceinline__ bool reset_acc(const Unit& u) const { return u.pn >= 4; }
    __device__ __forceinline__ void operator()(f32x4 (&acc)[2][2][4][2], const Unit& u, int wr, int wc, int fr, int fq) const {
        const bool first = u.pn < 4; const int rbase = u.pm * BM + wr * 64 + fr, c0 = (u.pn & 3) * BM + wc * 32 + fq * 8;
#pragma unroll
        for (int ai = 0; ai < 2; ++ai)
#pragma unroll
            for (int m = 0; m < 4; ++m) { const int row = rbase + ai * HALF + m * 16;
#pragma unroll
                for (int bj = 0; bj < 2; ++bj) { const int col = c0 + bj * HALF; const u32x4 gb = *(const u32x4*)(GAB + (size_t)row * 2048 + 1024 + col);
                    float sb[8] = {bflo(gb.x), bfhi(gb.x), bflo(gb.y), bfhi(gb.y), bflo(gb.z), bfhi(gb.z), bflo(gb.w), bfhi(gb.w)};
                    if (first) { const u32x4 ga = *(const u32x4*)(GAB + (size_t)row * 2048 + col);
                        const float sa[8] = {bflo(ga.x), bfhi(ga.x), bflo(ga.y), bfhi(ga.y), bflo(ga.z), bfhi(ga.z), bflo(ga.w), bfhi(ga.w)};
#pragma unroll
                        for (int i = 0; i < 4; ++i) { acc[ai][bj][m][0][i] *= sa[i] * __builtin_amdgcn_rcpf(sb[i]); acc[ai][bj][m][1][i] *= sa[4 + i] * __builtin_amdgcn_rcpf(sb[4 + i]); }
                    } else { f32x4 a = acc[ai][bj][m][0], b = acc[ai][bj][m][1];
#pragma unroll
                        for (int i = 0; i < 4; ++i) { a[i] *= sb[i]; b[i] *= sb[4 + i]; }
                        *(u32x4*)(Mb + (size_t)row * 1024 + col) = pack8(a, b); } } }
    }
};
struct EpiNsa {
    static constexpr bool PERM = true, AFTER_DRAIN = false;
    __device__ __forceinline__ bool reset_acc(const Unit&) const { return true; }
    float* M1; const bf16_t* GAB;
    __device__ __forceinline__ void operator()(const f32x4 (&acc)[2][2][4][2], const Unit& u, int wr, int wc, int fr, int fq) const {
        const int rbase = u.pm * BM + wr * 64 + fr, c0 = u.pn * BM + wc * 32 + fq * 8;
#pragma unroll
        for (int ai = 0; ai < 2; ++ai)
#pragma unroll
            for (int m = 0; m < 4; ++m) { const int row = rbase + ai * HALF + m * 16;
#pragma unroll
                for (int bj = 0; bj < 2; ++bj) { const int col = c0 + bj * HALF; const u32x4 g = *(const u32x4*)(GAB + (size_t)row * 2048 + col);
                    f32x4 a = acc[ai][bj][m][0], b = acc[ai][bj][m][1];
                    a[0] *= bflo(g.x); a[1] *= bfhi(g.x); a[2] *= bflo(g.y); a[3] *= bfhi(g.y); b[0] *= bflo(g.z); b[1] *= bfhi(g.z); b[2] *= bflo(g.w); b[3] *= bfhi(g.w);
                    float* p = M1 + (size_t)row * 1024 + col; *(f32x4*)p = a; *(f32x4*)(p + 4) = b; } }
    }
};
struct EpiConv {
    static constexpr bool PERM = true, AFTER_DRAIN = false;
    __device__ __forceinline__ bool reset_acc(const Unit&) const { return true; }
    const float* M1; const bf16_t* GAB; bf16_t* Mb;
    __device__ __forceinline__ void operator()(const f32x4 (&acc)[2][2][4][2], const Unit& u, int wr, int wc, int fr, int fq) const {
        const int rbase = u.pm * BM + wr * 64 + fr, c0 = u.pn * BM + wc * 32 + fq * 8;
#pragma unroll
        for (int ai = 0; ai < 2; ++ai)
#pragma unroll
            for (int m = 0; m < 4; ++m) { const int row = rbase + ai * HALF + m * 16;
#pragma unroll
                for (int bj = 0; bj < 2; ++bj) { const int col = c0 + bj * HALF; const u32x4 g = *(const u32x4*)(GAB + (size_t)row * 2048 + 1024 + col);
                    const float* p = M1 + (size_t)row * 1024 + col;
#ifdef DBG_NO_M1
                    f32x4 a = (f32x4){0.f, 0.f, 0.f, 0.f}, b = a; (void)p;
#else
                    f32x4 a = *(const f32x4*)p, b = *(const f32x4*)(p + 4);
#endif
                    const f32x4 x = acc[ai][bj][m][0], y = acc[ai][bj][m][1];
                    a[0] += x[0] * bflo(g.x); a[1] += x[1] * bfhi(g.x); a[2] += x[2] * bflo(g.y); a[3] += x[3] * bfhi(g.y); b[0] += y[0] * bflo(g.z); b[1] += y[1] * bfhi(g.z); b[2] += y[2] * bflo(g.w); b[3] += y[3] * bfhi(g.w);
                    *(u32x4*)(Mb + (size_t)row * 1024 + col) = pack8(a, b); } }
    }
};
struct EpiWo {
    static constexpr bool PERM = true, AFTER_DRAIN = false;
    __device__ __forceinline__ bool reset_acc(const Unit&) const { return true; }
    const float *xp, *xs; float* X1; bf16_t* X1b; float* PSS;
    __device__ __forceinline__ void operator()(const f32x4 (&acc)[2][2][4][2], const Unit& u, int wr, int wc, int fr, int fq) const {
        const int rbase = u.pm * BM + wr * 64 + fr, c0 = u.pn * BM + wc * 32 + fq * 8;
#pragma unroll
        for (int ai = 0; ai < 2; ++ai)
#pragma unroll
            for (int m = 0; m < 4; ++m) { const int row = rbase + ai * HALF + m * 16;
                const float* xr = row < NP ? xp + (size_t)row * 1024 : (row < NP + NSMP ? xs + (size_t)(row - NP) * 1024 : nullptr);
                float ss = 0.f;
#pragma unroll
                for (int bj = 0; bj < 2; ++bj) { const int col = c0 + bj * HALF;
                    f32x4 a = acc[ai][bj][m][0], b = acc[ai][bj][m][1];
                    if (xr) { a += *(const f32x4*)(xr + col); b += *(const f32x4*)(xr + col + 4); }
                    *(u32x4*)(X1b + (size_t)row * 1024 + col) = pack8(a, b);
                    ss += (a[0] * a[0] + a[1] * a[1]) + (a[2] * a[2] + a[3] * a[3]) + (b[0] * b[0] + b[1] * b[1]) + (b[2] * b[2] + b[3] * b[3]); }
                ss += __shfl_xor(ss, 16); ss += __shfl_xor(ss, 32);
                if (fq == 0) PSS[(size_t)row * 16 + u.pn * 4 + wc] = ss; }
    }
};
struct EpiUp {
    static constexpr bool PERM = true, AFTER_DRAIN = false;
    __device__ __forceinline__ bool reset_acc(const Unit&) const { return true; }
    const float* PSS; bf16_t* H;
    __device__ __forceinline__ void operator()(const f32x4 (&acc)[2][2][4][2], const Unit& u, int wr, int wc, int fr, int fq) const {
        const int rbase = u.pm * BM + wr * 64 + fr, c0 = u.pn * BM + wc * 32 + fq * 8;
#pragma unroll
        for (int ai = 0; ai < 2; ++ai)
#pragma unroll
            for (int m = 0; m < 4; ++m) { const int row = rbase + ai * HALF + m * 16;
                const f32x4* ps = (const f32x4*)(PSS + (size_t)row * 16); const f32x4 s0 = ps[0], s1 = ps[1], s2 = ps[2], s3 = ps[3];
                const float ssum = (((s0[0] + s0[1]) + (s0[2] + s0[3])) + ((s1[0] + s1[1]) + (s1[2] + s1[3]))) + (((s2[0] + s2[1]) + (s2[2] + s2[3])) + ((s3[0] + s3[1]) + (s3[2] + s3[3])));
                const float rstd = __builtin_amdgcn_rsqf(ssum * (1.f / 1024.f) + RMS_EPS);
#pragma unroll
                for (int bj = 0; bj < 2; ++bj) { f32x4 a = acc[ai][bj][m][0] * rstd, b = acc[ai][bj][m][1] * rstd;
#pragma unroll
                    for (int i = 0; i < 4; ++i) { a[i] = a[i] > 0.f ? a[i] * a[i] : 0.f; b[i] = b[i] > 0.f ? b[i] * b[i] : 0.f; }
                    *(u32x4*)(H + (size_t)row * 4096 + c0 + bj * HALF) = pack8(a, b); } }
    }
};
struct EpiDownNorm {
    static constexpr bool PERM = true, AFTER_DRAIN = false;
    __device__ __forceinline__ bool reset_acc(const Unit&) const { return true; }
    const bf16_t* X1b; float* out; const float* gf; float* PSS2; unsigned* cnt; unsigned* tmo;
    __device__ __forceinline__ void operator()(f32x4 (&acc)[2][2][4][2], const Unit& u, int wr, int wc, int fr, int fq) const {
        const int rbase = u.pm * BM + wr * 64 + fr, c0 = u.pn * BM + wc * 32 + fq * 8;
#pragma unroll
        for (int ai = 0; ai < 2; ++ai)
#pragma unroll
            for (int m = 0; m < 4; ++m) { const int row = rbase + ai * HALF + m * 16; float ss = 0.f;
#pragma unroll
                for (int bj = 0; bj < 2; ++bj) { const int col = c0 + bj * HALF; const u32x4 g = *(const u32x4*)(X1b + (size_t)row * 1024 + col);
                    f32x4 a = acc[ai][bj][m][0], b = acc[ai][bj][m][1];
                    a[0] += bflo(g.x); a[1] += bfhi(g.x); a[2] += bflo(g.y); a[3] += bfhi(g.y); b[0] += bflo(g.z); b[1] += bfhi(g.z); b[2] += bflo(g.w); b[3] += bfhi(g.w);
                    acc[ai][bj][m][0] = a; acc[ai][bj][m][1] = b;
                    ss += (a[0] * a[0] + a[1] * a[1]) + (a[2] * a[2] + a[3] * a[3]) + (b[0] * b[0] + b[1] * b[1]) + (b[2] * b[2] + b[3] * b[3]); }
                ss += __shfl_xor(ss, 16); ss += __shfl_xor(ss, 32);
                if (fq == 0) __hip_atomic_store(PSS2 + (size_t)row * 16 + u.pn * 4 + wc, ss, __ATOMIC_RELAXED, __HIP_MEMORY_SCOPE_AGENT); }
        asm volatile("s_waitcnt vmcnt(0)" ::: "memory");
        unsigned* c = cnt + 64 * u.pm;
        if ((threadIdx.x & 63) == 0) {
            (void)__hip_atomic_fetch_add(c, 1u, __ATOMIC_RELAXED, __HIP_MEMORY_SCOPE_AGENT);
            unsigned sp = 0;
            while (__hip_atomic_load(c, __ATOMIC_RELAXED, __HIP_MEMORY_SCOPE_AGENT) < 32u) { __builtin_amdgcn_s_sleep(1);
                if (++sp > (1u << 22)) { __hip_atomic_store(tmo, 1u, __ATOMIC_RELAXED, __HIP_MEMORY_SCOPE_AGENT); break; } }
        }
        __builtin_amdgcn_fence(__ATOMIC_ACQUIRE, "agent");
        asm volatile("s_waitcnt vmcnt(0)" ::: "memory");
#pragma unroll
        for (int ai = 0; ai < 2; ++ai)
#pragma unroll
            for (int m = 0; m < 4; ++m) { const int row = rbase + ai * HALF + m * 16;
                const f32x4* ps = (const f32x4*)(PSS2 + (size_t)row * 16); const f32x4 s0 = ps[0], s1 = ps[1], s2 = ps[2], s3 = ps[3];
                const float ssum = (((s0[0] + s0[1]) + (s0[2] + s0[3])) + ((s1[0] + s1[1]) + (s1[2] + s1[3]))) + (((s2[0] + s2[1]) + (s2[2] + s2[3])) + ((s3[0] + s3[1]) + (s3[2] + s3[3])));
                const float rstd = 1.f / sqrtf(ssum * (1.f / 1024.f) + RMS_EPS);
                float* orow = out + O_YP + (size_t)row * 1024;
#pragma unroll
                for (int bj = 0; bj < 2; ++bj) { const int col = c0 + bj * HALF; const f32x4 g0 = *(const f32x4*)(gf + col), g1 = *(const f32x4*)(gf + col + 4);
                    *(f32x4*)(orow + col) = acc[ai][bj][m][0] * rstd * g0; *(f32x4*)(orow + col + 4) = acc[ai][bj][m][1] * rstd * g1; } }
    }
};
struct EpiDown {
    static constexpr bool PERM = true, AFTER_DRAIN = false;
    __device__ __forceinline__ bool reset_acc(const Unit&) const { return true; }
    const bf16_t* X1b; float* out;
    __device__ __forceinline__ void operator()(const f32x4 (&acc)[2][2][4][2], const Unit& u, int wr, int wc, int fr, int fq) const {
        const int rbase = u.pm * BM + wr * 64 + fr, c0 = u.pn * BM + wc * 32 + fq * 8;
#pragma unroll
        for (int ai = 0; ai < 2; ++ai)
#pragma unroll
            for (int m = 0; m < 4; ++m) { const int row = rbase + ai * HALF + m * 16;
                if (row < NP) { float* orow = out + O_YP + (size_t)row * 1024;
#pragma unroll
                    for (int bj = 0; bj < 2; ++bj) { const int col = c0 + bj * HALF; const u32x4 g = *(const u32x4*)(X1b + (size_t)row * 1024 + col);
                        f32x4 a = acc[ai][bj][m][0], b = acc[ai][bj][m][1];
                        a[0] += bflo(g.x); a[1] += bfhi(g.x); a[2] += bflo(g.y); a[3] += bfhi(g.y); b[0] += bflo(g.z); b[1] += bfhi(g.z); b[2] += bflo(g.w); b[3] += bfhi(g.w);
                        *(f32x4*)(orow + col) = a; *(f32x4*)(orow + col + 4) = b; } } }
    }
};
template <class Epi, class Sched, bool ALIGN_EPI = false, bool SP2 = false>
__device__ __forceinline__ void gemm_phase(PG8_LAS unsigned char* lds, const Gemm g, const Sched& S, const Epi& E) {
    const int tid = threadIdx.x, wid = __builtin_amdgcn_readfirstlane(tid >> 6), lane = tid & 63, wr = wid >> 2, wc = wid & 3, fr = lane & 15, fq = lane >> 4;
    const int K = g.K, nt = K / BK;
    unsigned voffA[2], voffB[2];
#pragma unroll
    for (int i = 0; i < 2; ++i) { int R, C; stage_rc(tid * 16 + i * 8192, R, C); const int Rb = Epi::PERM ? ((R & ~31) + perm32(R & 31)) : R;
        voffA[i] = (unsigned)(R * g.lda + C) * 2u; voffB[i] = (unsigned)(Rb * g.ldb + C) * 2u; }
    const size_t kstep = (size_t)(BK * 2);
    const size_t hstepA = (size_t)HALF * g.lda * 2, hstepB = (size_t)HALF * g.ldb * 2;
    const size_t tstepA = 2 * hstepA, tstepB = 2 * hstepB;
    const unsigned ldsw = (unsigned)wid * 1024u;
    const int aoff = lds_byte(wr * 64 + fr, fq * 8), boff = lds_byte(wc * 32 + fr, fq * 8);
#define PG8_SA(b, h) (((b) * 2 + (h)) * HTB)
#define PG8_SB(b, h) ((4 + (b) * 2 + (h)) * HTB)
#define PG8_STAGE(bufoff, gbase, voff) do { _Pragma("unroll") for (int _i = 0; _i < 2; ++_i) \
        __builtin_amdgcn_global_load_lds((const unsigned*)((const char*)(gbase) + (voff)[_i]), (PG8_LAS unsigned*)(lds + (bufoff) + ldsw + _i * 8192), 16, 0, 0); } while (0)
#define PG8_LDA(dst, b, h) do { _Pragma("unroll") for (int m = 0; m < 4; ++m) _Pragma("unroll") for (int k = 0; k < 2; ++k) dst[m][k] = *(const PG8_LAS bf16x8*)(lds + PG8_SA(b, h) + aoff + m * 2048 + k * 1024); } while (0)
#define PG8_LDB(dst, b, h) do { _Pragma("unroll") for (int n = 0; n < 2; ++n) _Pragma("unroll") for (int k = 0; k < 2; ++k) dst[n][k] = *(const PG8_LAS bf16x8*)(lds + PG8_SB(b, h) + boff + n * 2048 + k * 1024); } while (0)
#define PG8_MMA(ai, bj, At, Bt) do { __builtin_amdgcn_s_setprio(1); _Pragma("unroll") for (int m = 0; m < 4; ++m) _Pragma("unroll") for (int n = 0; n < 2; ++n) _Pragma("unroll") for (int k = 0; k < 2; ++k) \
        acc[ai][bj][m][n] = __builtin_amdgcn_mfma_f32_16x16x32_bf16(Bt[n][k], At[m][k], acc[ai][bj][m][n], 0, 0, 0); __builtin_amdgcn_s_setprio(0); } while (0)
#define PG8_WAIT_V(n) asm volatile("s_waitcnt vmcnt(" #n ")" ::: "memory")
#define PG8_WAIT_L(n) asm volatile("s_waitcnt lgkmcnt(" #n ")" ::: "memory")
#define PG8_BAR __builtin_amdgcn_s_barrier()
#define PG8_SCHED __builtin_amdgcn_sched_barrier(0)
    Unit cur, nxt; int ui = 0;
    if (!S.next(0, cur)) return;
    f32x4 acc[2][2][4][2];
#pragma unroll
    for (int a = 0; a < 2; ++a)
#pragma unroll
        for (int b = 0; b < 2; ++b)
#pragma unroll
            for (int m = 0; m < 4; ++m)
#pragma unroll
                for (int n = 0; n < 2; ++n) acc[a][b][m][n] = (f32x4){0.f, 0.f, 0.f, 0.f};
    bf16x8 At[4][2], B0[2][2], B1[2][2];
    const char* cA = (const char*)g.A + (size_t)cur.pm * tstepA + cur.aoff; const char* cB = (const char*)g.Bt + (size_t)cur.pn * tstepB;
    S.a_ready(cur);
    if constexpr (SP2) {
        PG8_STAGE(PG8_SB(0, 0), cB, voffB); PG8_STAGE(PG8_SB(0, 1), cB + hstepB, voffB); PG8_STAGE(PG8_SA(0, 0), cA, voffA); PG8_STAGE(PG8_SA(0, 1), cA + hstepA, voffA);
        if (wr == 1) PG8_BAR;
        PG8_WAIT_V(2); PG8_BAR;
        PG8_STAGE(PG8_SB(1, 0), cB + kstep, voffB); PG8_STAGE(PG8_SA(1, 0), cA + kstep, voffA); PG8_STAGE(PG8_SB(1, 1), cB + hstepB + kstep, voffB);
        PG8_WAIT_V(6); PG8_BAR;
    } else {
        PG8_STAGE(PG8_SB(0, 0), cB, voffB); PG8_STAGE(PG8_SA(0, 0), cA, voffA); PG8_STAGE(PG8_SB(0, 1), cB + hstepB, voffB); PG8_STAGE(PG8_SA(0, 1), cA + hstepA, voffA);
        if (wr == 1) PG8_BAR;
        PG8_WAIT_V(4); PG8_BAR;
        PG8_STAGE(PG8_SB(1, 0), cB + kstep, voffB); PG8_STAGE(PG8_SA(1, 0), cA + kstep, voffA); PG8_STAGE(PG8_SB(1, 1), cB + hstepB + kstep, voffB);
        PG8_WAIT_V(6); PG8_BAR;
    }
    for (;;) {
        const bool has_next = S.next(ui + 1, nxt);
        const char* nA = has_next ? (const char*)g.A + (size_t)nxt.pm * tstepA + nxt.aoff : cA; const char* nB = has_next ? (const char*)g.Bt + (size_t)nxt.pn * tstepB : cB;
        for (int t = 0; t < nt; t += 2) {
            const bool last = (t == nt - 2);
            const char* a1 = cA + (size_t)(t + 1) * kstep;
            const char* a2 = last ? nA : cA + (size_t)(t + 2) * kstep; const char* b2 = last ? nB : cB + (size_t)(t + 2) * kstep;
            const char* a3 = a2 + kstep; const char* b3 = b2 + kstep;
            if (last && has_next) S.a_ready(nxt);
            if constexpr (SP2) {
            PG8_LDB(B0, 0, 0); PG8_LDB(B1, 0, 1); PG8_SCHED; PG8_LDA(At, 0, 0); PG8_STAGE(PG8_SA(1, 1), a1 + hstepA, voffA);
            PG8_WAIT_V(8); PG8_WAIT_L(0); PG8_BAR; PG8_MMA(0, 0, At, B0); PG8_MMA(0, 1, At, B1); PG8_BAR; PG8_SCHED;
            PG8_LDA(At, 0, 1); PG8_STAGE(PG8_SB(0, 0), b2, voffB); PG8_STAGE(PG8_SB(0, 1), b2 + hstepB, voffB); PG8_STAGE(PG8_SA(0, 0), a2, voffA);
            PG8_WAIT_V(8); PG8_WAIT_L(0); PG8_BAR; PG8_MMA(1, 0, At, B0); PG8_MMA(1, 1, At, B1); PG8_BAR; PG8_SCHED;
            PG8_LDB(B0, 1, 0); PG8_LDB(B1, 1, 1); PG8_SCHED; PG8_LDA(At, 1, 0); PG8_STAGE(PG8_SA(0, 1), a2 + hstepA, voffA);
            PG8_WAIT_V(8); PG8_WAIT_L(0); PG8_BAR; PG8_MMA(0, 0, At, B0); PG8_MMA(0, 1, At, B1); PG8_BAR; PG8_SCHED;
            PG8_LDA(At, 1, 1); PG8_STAGE(PG8_SB(1, 0), b3, voffB); PG8_STAGE(PG8_SB(1, 1), b3 + hstepB, voffB); PG8_STAGE(PG8_SA(1, 0), a3, voffA);
            PG8_WAIT_V(8); PG8_WAIT_L(0); PG8_BAR; PG8_MMA(1, 0, At, B0); PG8_MMA(1, 1, At, B1); PG8_BAR; PG8_SCHED;
            } else {
            PG8_LDB(B0, 0, 0); PG8_SCHED; PG8_LDA(At, 0, 0); PG8_STAGE(PG8_SA(1, 1), a1 + hstepA, voffA);
            PG8_WAIT_L(8); PG8_BAR; PG8_WAIT_L(0); PG8_MMA(0, 0, At, B0); PG8_BAR; PG8_SCHED;
            PG8_LDB(B1, 0, 1); PG8_STAGE(PG8_SB(0, 0), b2, voffB);
            PG8_BAR; PG8_WAIT_L(0); PG8_MMA(0, 1, At, B1); PG8_BAR;
            PG8_LDA(At, 0, 1); PG8_STAGE(PG8_SA(0, 0), a2, voffA);
            PG8_BAR; PG8_WAIT_L(0); PG8_MMA(1, 0, At, B0); PG8_BAR; PG8_SCHED;
            PG8_STAGE(PG8_SB(0, 1), b2 + hstepB, voffB);
            PG8_WAIT_V(6); PG8_BAR; PG8_MMA(1, 1, At, B1); PG8_BAR;
            PG8_LDB(B0, 1, 0); PG8_SCHED; PG8_LDA(At, 1, 0); PG8_STAGE(PG8_SA(0, 1), a2 + hstepA, voffA);
            PG8_WAIT_L(8); PG8_BAR; PG8_WAIT_L(0); PG8_MMA(0, 0, At, B0); PG8_BAR; PG8_SCHED;
            PG8_LDB(B1, 1, 1); PG8_STAGE(PG8_SB(1, 0), b3, voffB);
            PG8_BAR; PG8_WAIT_L(0); PG8_MMA(0, 1, At, B1); PG8_BAR;
            PG8_LDA(At, 1, 1); PG8_STAGE(PG8_SA(1, 0), a3, voffA);
            PG8_BAR; PG8_WAIT_L(0); PG8_MMA(1, 0, At, B0); PG8_BAR; PG8_SCHED;
            PG8_STAGE(PG8_SB(1, 1), b3 + hstepB, voffB);
            PG8_WAIT_V(6); PG8_BAR; PG8_MMA(1, 1, At, B1); PG8_BAR;
            }
        }
        if constexpr (ALIGN_EPI) { if (wr == 0) PG8_BAR; }
        if constexpr (!Epi::AFTER_DRAIN) { E(acc, cur, wr, wc, fr, fq); S.done(cur); }
        if (!has_next) break;
        if (E.reset_acc(cur)) {
#pragma unroll
        for (int a = 0; a < 2; ++a)
#pragma unroll
            for (int b = 0; b < 2; ++b)
#pragma unroll
                for (int m = 0; m < 4; ++m)
#pragma unroll
                    for (int n = 0; n < 2; ++n) acc[a][b][m][n] = (f32x4){0.f, 0.f, 0.f, 0.f};
        }
        cur = nxt; cA = nA; cB = nB; ++ui;
        if constexpr (ALIGN_EPI) { if (wr == 1) PG8_BAR; }
    }
    PG8_WAIT_V(0);
    if constexpr (!ALIGN_EPI) { if (wr == 0) PG8_BAR; }
    PG8_BAR;
    if constexpr (Epi::AFTER_DRAIN) { E.fused(acc, cur, wr, wc, fr, fq, lds, wid, lane); S.done(cur); }
#undef PG8_SA
#undef PG8_SB
#undef PG8_STAGE
#undef PG8_LDA
#undef PG8_LDB
#undef PG8_MMA
#undef PG8_WAIT_V
#undef PG8_WAIT_L
#undef PG8_BAR
#undef PG8_SCHED
}
}

#define GAS __attribute__((address_space(1)))
#define LAS __attribute__((address_space(3)))
typedef unsigned short bf16;
typedef unsigned v4u __attribute__((ext_vector_type(4)));
typedef unsigned v2u __attribute__((ext_vector_type(2)));
typedef float f32x4 __attribute__((ext_vector_type(4)));
typedef short bf16x8 __attribute__((ext_vector_type(8)));
typedef GAS unsigned gu32;
#define RLX_AGENT __ATOMIC_RELAXED, __HIP_MEMORY_SCOPE_AGENT
#define LDS_WAIT() asm volatile("s_waitcnt lgkmcnt(0)" ::: "memory")
#define VM_WAIT() asm volatile("s_waitcnt vmcnt(0)" ::: "memory")
using pg8::bf2f; using pg8::bflo; using pg8::bfhi; using pg8::f2bf_rne; using pg8::kperm64; using pg8::ktile_off; using pg8::vtile_off; using pg8::vtile8_off; using pg8::ktile8_off; using pg8::sigmoid_f; using pg8::gelu_tanh_f; using pg8::cvt_pk_bf16;
__device__ __forceinline__ unsigned pk2(float lo, float hi) { return cvt_pk_bf16(lo, hi); }

#define XB_TMO      128
#define XB_XCNT(j)  (256  + 64 * (j))
#define XB_XSUB(j)  (1280 + 64 * (j))
#define XB_XGEN(j)  (2304 + 64 * (j))
#define XB_TOP      3328
#define XB_TOPGEN   3392
#define XCD_BAR_WORDS 3456
#define XB_SPIN_CAP (1u << 18)

__device__ __forceinline__ unsigned xb_ld(unsigned* p)              { return __hip_atomic_load(p, __ATOMIC_RELAXED, __HIP_MEMORY_SCOPE_AGENT); }
__device__ __forceinline__ unsigned xb_add(unsigned* p, unsigned v) { return __hip_atomic_fetch_add(p, v, __ATOMIC_RELAXED, __HIP_MEMORY_SCOPE_AGENT); }
__device__ __forceinline__ unsigned xb_xcc_id() { return (unsigned)__builtin_amdgcn_s_getreg((3 << 11) | 20) & 0xFu; }
#define XB_SPIN(cond, bar) do { unsigned _sp = 0; while (cond) { __builtin_amdgcn_s_sleep(1); \
    if ((++_sp & 255u) == 0u) { if (xb_ld(&(bar)[XB_TMO])) break; if (_sp > XB_SPIN_CAP) { atomicAdd(&(bar)[XB_TMO], 1u); break; } } } } while (0)

struct XcdBarrier {
    unsigned* bar; unsigned x;
    volatile LAS unsigned* st;
};

__device__ __forceinline__ XcdBarrier xcd_barrier_post(unsigned* bar, volatile LAS unsigned* st) {
    XcdBarrier b; b.bar = bar; b.x = xb_xcc_id(); b.st = st;
    if (threadIdx.x == 0) (void)xb_add(&bar[XB_XCNT(b.x)], 1u);
    return b;
}
__device__ __forceinline__ void xcd_barrier_complete(unsigned* bar, unsigned x, unsigned& nloc, unsigned& nx) {
    const unsigned G = gridDim.x * gridDim.y * gridDim.z;
    unsigned sum, cnt, mine, sp = 0u;
    for (;;) {
        sum = 0u; cnt = 0u; mine = 0u;
#pragma unroll
        for (unsigned j = 0; j < 16; ++j) { const unsigned c = xb_ld(&bar[XB_XCNT(j)]); sum += c; cnt += (c > 0u) ? 1u : 0u; mine = (j == x) ? c : mine; }
        if (sum == G) break;
        __builtin_amdgcn_s_sleep(1);
        if ((++sp & 255u) == 0u) { if (xb_ld(&bar[XB_TMO])) break; if (sp > XB_SPIN_CAP) { atomicAdd(&bar[XB_TMO], 1u); break; } }
    }
    nloc = mine > 0u ? mine : 1u; nx = cnt > 0u ? cnt : 1u;
}

__device__ __forceinline__ void xcd_barrier(const XcdBarrier& b) {
    asm volatile("s_waitcnt vmcnt(0)" ::: "memory");
    __syncthreads();
    if (threadIdx.x == 0) {
        unsigned* bar = b.bar;
        __builtin_amdgcn_s_waitcnt(0);
        unsigned nloc = b.st[0], nx = b.st[1];
        if (nloc == 0u) { xcd_barrier_complete(bar, b.x, nloc, nx); b.st[0] = nloc; b.st[1] = nx; }
        const unsigned old = xb_add(&bar[XB_XSUB(b.x)], 1u);
        const unsigned gen = old / nloc;
        if (old + 1u == (gen + 1u) * nloc) {
            __builtin_amdgcn_fence(__ATOMIC_RELEASE, "agent");
            asm volatile("s_waitcnt vmcnt(0)" ::: "memory");
            const unsigned og = xb_add(&bar[XB_TOP], 1u);
            const unsigned tg = og / nx;
            if (og + 1u == (tg + 1u) * nx) xb_add(&bar[XB_TOPGEN], 1u);
            else XB_SPIN(xb_ld(&bar[XB_TOPGEN]) == tg, bar);
            __builtin_amdgcn_fence(__ATOMIC_ACQUIRE, "agent");
            xb_add(&bar[XB_XGEN(b.x)], 1u);
            asm volatile("s_waitcnt vmcnt(0)" ::: "memory");
        } else {
            XB_SPIN(xb_ld(&bar[XB_XGEN(b.x)]) == gen, bar);
            __builtin_amdgcn_fence(__ATOMIC_ACQUIRE, "agent");
            asm volatile("s_waitcnt vmcnt(0)" ::: "memory");
        }
    }
    __syncthreads();
}

__device__ __forceinline__ float wave_sum(float v) {
#pragma unroll
    for (int o = 1; o < 64; o <<= 1) v += __shfl_xor(v, o);
    return v;
}
__device__ __forceinline__ float wave_max(float v) {
#pragma unroll
    for (int o = 1; o < 64; o <<= 1) v = fmaxf(v, __shfl_xor(v, o));
    return v;
}
__device__ __forceinline__ int colmap_in(int n) { return n < 1280 ? n : (n < 4864 ? n + 24 : (n < 4888 ? n - 4864 + 1280 : -1)); }

template <int MODE>
__device__ __forceinline__ void p0_transpose_item(const float* W, int K, int N, int Nout, bf16* WT, const float* kscale, LAS float* scr, int item, int lane) {
    const int nblk = Nout / 32, kb = item / nblk, nb = item % nblk, k0 = 64 * kb, n0 = 32 * nb;
    const int col = MODE ? colmap_in(n0 + (lane & 31)) : n0 + (lane & 31);
    float wv[32];
#pragma unroll
    for (int i = 0; i < 32; ++i) { const int kk = 2 * i + (lane >> 5); wv[i] = col >= 0 ? W[(size_t)(k0 + kk) * N + col] : 0.f; }
#pragma unroll
    for (int i = 0; i < 32; ++i) { const int kk = 2 * i + (lane >> 5); float v = wv[i]; if (kscale) v *= kscale[k0 + kk]; scr[kk * 33 + (lane & 31)] = v; }
    LDS_WAIT(); asm volatile("" ::: "memory");
    const int c = lane & 7;
#pragma unroll
    for (int j = 0; j < 4; ++j) { const int n = (lane >> 3) + 8 * j; const LAS float* s = scr + (8 * c) * 33 + n;
        v4u o; o.x = pk2(s[0 * 33], s[1 * 33]); o.y = pk2(s[2 * 33], s[3 * 33]); o.z = pk2(s[4 * 33], s[5 * 33]); o.w = pk2(s[6 * 33], s[7 * 33]);
        *(GAS v4u*)(WT + (size_t)(n0 + n) * K + k0 + 8 * c) = o; }
    LDS_WAIT(); asm volatile("" ::: "memory");
}
__device__ __forceinline__ void rms_row_to_bf16(const float* xrow, const float* g, bf16* orow, int lane) {
    const GAS f32x4* xr = (const GAS f32x4*)xrow + lane; const GAS f32x4* gr = (const GAS f32x4*)g + lane;
    f32x4 v[4]; float s = 0.f;
#pragma unroll
    for (int j = 0; j < 4; ++j) { v[j] = xr[64 * j]; s += (v[j].x * v[j].x + v[j].y * v[j].y) + (v[j].z * v[j].z + v[j].w * v[j].w); }
    const float rstd = 1.f / sqrtf(wave_sum(s) * (1.f / 1024.f) + RMS_EPS);
    GAS v2u* o8 = (GAS v2u*)orow + lane;
#pragma unroll
    for (int j = 0; j < 4; ++j) { const f32x4 gg = gr[64 * j]; v2u w; w.x = pk2(v[j].x * rstd * gg.x, v[j].y * rstd * gg.y); w.y = pk2(v[j].z * rstd * gg.z, v[j].w * rstd * gg.w); o8[64 * j] = w; }
}

template <int RT, int CT, bool TR = true, class Epi>
__device__ __forceinline__ void skinny_unit(const bf16* A, int lda, const bf16* Bt, int ldb, int K, int row0, int col0, const Epi& E, int lane) {
    const int r = lane & 15, q = lane >> 4;
    f32x4 acc[RT][CT];
#pragma unroll
    for (int a = 0; a < RT; ++a)
#pragma unroll
        for (int b = 0; b < CT; ++b) acc[a][b] = (f32x4){0.f, 0.f, 0.f, 0.f};
    const bf16* ap = A + (size_t)(row0 + r) * lda + q * 8;
    const bf16* bp = Bt + (size_t)(col0 + r) * ldb + q * 8;
#pragma unroll 8
    for (int k = 0; k < K; k += 32) {
        bf16x8 af[RT], bfr[CT];
#pragma unroll
        for (int a = 0; a < RT; ++a) af[a] = *(const GAS bf16x8*)(ap + (size_t)a * 16 * lda + k);
#pragma unroll
        for (int b = 0; b < CT; ++b) bfr[b] = *(const GAS bf16x8*)(bp + (size_t)b * 16 * ldb + k);
#pragma unroll
        for (int a = 0; a < RT; ++a)
#pragma unroll
            for (int b = 0; b < CT; ++b) acc[a][b] = TR ? __builtin_amdgcn_mfma_f32_16x16x32_bf16(bfr[b], af[a], acc[a][b], 0, 0, 0) : __builtin_amdgcn_mfma_f32_16x16x32_bf16(af[a], bfr[b], acc[a][b], 0, 0, 0);
    }
    E(acc, row0, col0, r, q);
}
struct SkHid {
    bf16* G; const float* pe;
    template <int RT, int CT> __device__ __forceinline__ void operator()(const f32x4 (&acc)[RT][CT], int row0, int col0, int r, int q) const {
#pragma unroll
        for (int b = 0; b < CT; ++b) { const int col = col0 + 16 * b + 4 * q; const f32x4 pv = *(const f32x4*)(pe + col);
#pragma unroll
            for (int a = 0; a < RT; ++a) { f32x4 v = acc[a][b] + pv;
#pragma unroll
                for (int i = 0; i < 4; ++i) v[i] = gelu_tanh_f(v[i]);
                v2u w; w.x = pk2(v[0], v[1]); w.y = pk2(v[2], v[3]); *(GAS v2u*)(G + (size_t)(row0 + 16 * a + r) * 256 + col) = w; } }
    }
};
struct SkOutF32 {
    float* O;
    template <int RT, int CT> __device__ __forceinline__ void operator()(const f32x4 (&acc)[RT][CT], int row0, int col0, int r, int q) const {
#pragma unroll
        for (int a = 0; a < RT; ++a)
#pragma unroll
            for (int b = 0; b < CT; ++b) *(GAS f32x4*)(O + (size_t)(row0 + 16 * a + r) * 64 + col0 + 16 * b + 4 * q) = acc[a][b];
    }
};
struct SkOutKT {
    bf16* O;
    template <int RT, int CT> __device__ __forceinline__ void operator()(const f32x4 (&acc)[RT][CT], int row0, int col0, int r, int q) const {
#pragma unroll
        for (int a = 0; a < RT; ++a) { const int row = row0 + 16 * a + r; bf16* base = O + (size_t)(row >> 6) * 4096;
#pragma unroll
            for (int b = 0; b < CT; ++b) { v2u w; w.x = pk2(acc[a][b][0], acc[a][b][1]); w.y = pk2(acc[a][b][2], acc[a][b][3]); *(GAS v2u*)(base + ktile_off(row & 63, col0 + 16 * b + 4 * q)) = w; } }
    }
};
struct SkOutVT {
    bf16* VT;
    template <int RT, int CT> __device__ __forceinline__ void operator()(const f32x4 (&acc)[RT][CT], int row0, int col0, int r, int q) const {
#pragma unroll
        for (int a = 0; a < RT; ++a) { const int row = row0 + 16 * a + 4 * q; bf16* base = VT + (size_t)(row >> 6) * 4096;
#pragma unroll
            for (int b = 0; b < CT; ++b) { v2u w; w.x = pk2(acc[a][b][0], acc[a][b][1]); w.y = pk2(acc[a][b][2], acc[a][b][3]); *(GAS v2u*)(base + vtile_off(row & 63, col0 + 16 * b + r)) = w; } }
    }
};
struct SkWo {
    const float* xs; float* X1; bf16* X1b; float* PSS; int slot;
    template <int RT, int CT> __device__ __forceinline__ void operator()(const f32x4 (&acc)[RT][CT], int row0, int col0, int r, int q) const {
#pragma unroll
        for (int a = 0; a < RT; ++a) { const int row = row0 + 16 * a + r; float ss = 0.f;
#pragma unroll
            for (int b = 0; b < CT; ++b) { const int col = col0 + 16 * b + 4 * q; const f32x4 v = acc[a][b] + *(const GAS f32x4*)(xs + (size_t)(row - NP) * 1024 + col);
                *(GAS f32x4*)(X1 + (size_t)row * 1024 + col) = v; v2u w; w.x = pk2(v[0], v[1]); w.y = pk2(v[2], v[3]); *(GAS v2u*)(X1b + (size_t)row * 1024 + col) = w;
                ss += (v[0] * v[0] + v[1] * v[1]) + (v[2] * v[2] + v[3] * v[3]); }
            ss += __shfl_xor(ss, 16); ss += __shfl_xor(ss, 32);
            if (q == 0) PSS[(size_t)row * 16 + slot] = ss; }
    }
};
struct SkUp {
    const float* PSS; bf16* H;
    template <int RT, int CT> __device__ __forceinline__ void operator()(const f32x4 (&acc)[RT][CT], int row0, int col0, int r, int q) const {
#pragma unroll
        for (int a = 0; a < RT; ++a) { const int row = row0 + 16 * a + r;
            const GAS f32x4* ps = (const GAS f32x4*)(PSS + (size_t)row * 16); const f32x4 s0 = ps[0], s1 = ps[1], s2 = ps[2], s3 = ps[3];
            const float ssum = (((s0[0] + s0[1]) + (s0[2] + s0[3])) + ((s1[0] + s1[1]) + (s1[2] + s1[3]))) + (((s2[0] + s2[1]) + (s2[2] + s2[3])) + ((s3[0] + s3[1]) + (s3[2] + s3[3])));
            const float rstd = __builtin_amdgcn_rsqf(ssum * (1.f / 1024.f) + RMS_EPS);
#pragma unroll
            for (int b = 0; b < CT; ++b) { f32x4 v = acc[a][b] * rstd;
#pragma unroll
                for (int i = 0; i < 4; ++i) v[i] = v[i] > 0.f ? v[i] * v[i] : 0.f;
                v2u w; w.x = pk2(v[0], v[1]); w.y = pk2(v[2], v[3]); *(GAS v2u*)(H + (size_t)row * 4096 + col0 + 16 * b + 4 * q) = w; } }
    }
};
struct SkPart {
    float* P;
    template <int RT, int CT> __device__ __forceinline__ void operator()(const f32x4 (&acc)[RT][CT], int row0, int col0, int r, int q) const {
#pragma unroll
        for (int a = 0; a < RT; ++a)
#pragma unroll
            for (int b = 0; b < CT; ++b) *(GAS f32x4*)(P + (size_t)(row0 + 16 * a + r) * 1024 + col0 + 16 * b + 4 * q) = acc[a][b];
    }
};

struct AttnMaskSel { int d0; bool sel; static constexpr int KS = 16, IS = 1; __device__ __forceinline__ bool ok(int d) const { return sel && d >= 0; } };
struct AttnMaskWin { int d0; static constexpr int KS = 16, IS = 1; __device__ __forceinline__ bool ok(int d) const { return d >= 0 && d < WINL; } };
struct AttnMaskCmp { int d0; static constexpr int KS = 256, IS = 16; __device__ __forceinline__ bool ok(int d) const { return d >= 0; } };

struct SrcB {
    static constexpr bool LATE_V = true;
    const bf16* Kb; const bf16* VTb;
    __device__ __forceinline__ bf16x8 kfrag(int kt, int ks, int r, int qp) const { return *(const GAS bf16x8*)(Kb + ((kt * 2 + ks) * 64 + qp * 16 + r) * 8); }
    __device__ __forceinline__ bf16x8 vfrag(int dt, int k2, int r, int qp) const { return *(const GAS bf16x8*)(VTb + ((dt * 2 + k2) * 64 + qp * 16 + r) * 8); }
};
struct SrcF {
    static constexpr bool LATE_V = true;
    const float* Kp; const float* Vp;
    __device__ __forceinline__ bf16x8 kfrag(int kt, int ks, int r, int qp) const {
        const GAS f32x4* p = (const GAS f32x4*)(Kp + (size_t)(16 * kt + r) * 128 + 32 * ks + 8 * qp); const f32x4 a = p[0], b = p[1];
        v4u w; w.x = pk2(a[0], a[1]); w.y = pk2(a[2], a[3]); w.z = pk2(b[0], b[1]); w.w = pk2(b[2], b[3]); return __builtin_bit_cast(bf16x8, w); }
    __device__ __forceinline__ bf16x8 vfrag(int dt, int k2, int r, int qp) const { float v[8]; const GAS float* p = (const GAS float*)(Vp + (size_t)(4 * qp) * 128 + r);
#pragma unroll
        for (int j = 0; j < 8; ++j) v[j] = p[(32 * k2 + (j < 4 ? j : 12 + j)) * 128 + 16 * dt];
        v4u w; w.x = pk2(v[0], v[1]); w.y = pk2(v[2], v[3]); w.z = pk2(v[4], v[5]); w.w = pk2(v[6], v[7]); return __builtin_bit_cast(bf16x8, w); }
};

template <bool FAST, class Src, class Mask>
__device__ __forceinline__ void attn_scores(const Src& src, const bf16x8 (&qf)[2], const LAS float* lutg, const Mask& mk, float ini, f32x4 (&S)[4], int r, int qp) {
    bf16x8 kf[4][2];
#pragma unroll
    for (int kt = 0; kt < 4; ++kt)
#pragma unroll
        for (int ks = 0; ks < 2; ++ks) kf[kt][ks] = src.kfrag(kt, ks, r, qp);
#pragma unroll
    for (int kt = 0; kt < 4; ++kt) {
        S[kt] = __builtin_amdgcn_mfma_f32_16x16x32_bf16(kf[kt][0], qf[0], (f32x4){ini, ini, ini, ini}, 0, 0, 0);
        S[kt] = __builtin_amdgcn_mfma_f32_16x16x32_bf16(kf[kt][1], qf[1], S[kt], 0, 0, 0);
    }
    if (!FAST) {
        int d0 = mk.d0; asm volatile("" : "+v"(d0));
        float bvv[4][4];
#pragma unroll
        for (int kt = 0; kt < 4; ++kt)
#pragma unroll
            for (int i = 0; i < 4; ++i) { const int d = d0 - Mask::KS * kt - Mask::IS * i; const int dc = d < 0 ? 0 : (d > 127 ? 127 : d); bvv[kt][i] = lutg[dc]; }
#pragma unroll
        for (int kt = 0; kt < 4; ++kt) asm volatile("" : "+v"(bvv[kt][0]), "+v"(bvv[kt][1]), "+v"(bvv[kt][2]), "+v"(bvv[kt][3]));
#pragma unroll
        for (int kt = 0; kt < 4; ++kt)
#pragma unroll
            for (int i = 0; i < 4; ++i) { const int d = d0 - Mask::KS * kt - Mask::IS * i; S[kt][i] = mk.ok(d) ? S[kt][i] + bvv[kt][i] : -1.0e30f; }
    }
}
template <bool FAST, class Src, class Mask>
__device__ __forceinline__ void attn_block(const Src& src, const bf16x8 (&qf)[2], const LAS float* lutg, const Mask& mk, float bcol, float& m, float& l, f32x4 (&O)[4], int r, int qp) {
    bf16x8 vf[4][2];
    if constexpr (!Src::LATE_V) {
#pragma unroll
        for (int dt = 0; dt < 4; ++dt)
#pragma unroll
            for (int k2 = 0; k2 < 2; ++k2) vf[dt][k2] = src.vfrag(dt, k2, r, qp);
    }
    const bool have = m > -1.0e29f; const float off = have ? m : 0.f;
    f32x4 S[4];
    attn_scores<FAST>(src, qf, lutg, mk, FAST ? bcol - off : -off, S, r, qp);
    if constexpr (Src::LATE_V) {
        asm volatile("" ::: "memory");
#pragma unroll
        for (int dt = 0; dt < 4; ++dt)
#pragma unroll
            for (int k2 = 0; k2 < 2; ++k2) vf[dt][k2] = src.vfrag(dt, k2, r, qp);
    }
    float mx = fmaxf(fmaxf(fmaxf(S[0][0], S[0][1]), fmaxf(S[0][2], S[0][3])), fmaxf(fmaxf(S[1][0], S[1][1]), fmaxf(S[1][2], S[1][3])));
    mx = fmaxf(mx, fmaxf(fmaxf(fmaxf(S[2][0], S[2][1]), fmaxf(S[2][2], S[2][3])), fmaxf(fmaxf(S[3][0], S[3][1]), fmaxf(S[3][2], S[3][3]))));
    if (__any(have ? (mx > 8.f) : (mx > -1.0e29f))) {
        mx = fmaxf(mx, __shfl_xor(mx, 16)); mx = fmaxf(mx, __shfl_xor(mx, 32));
        const bool need = have ? (mx > 8.f) : (mx > -1.0e29f);
        const float delta = need ? mx : 0.f, sc = __builtin_amdgcn_exp2f(-delta);
        l *= sc; m = need ? off + mx : m;
#pragma unroll
        for (int dt = 0; dt < 4; ++dt) O[dt] = O[dt] * sc;
#pragma unroll
        for (int kt = 0; kt < 4; ++kt) S[kt] = S[kt] - delta;
    }
    float ps = 0.f;
#pragma unroll
    for (int kt = 0; kt < 4; ++kt)
#pragma unroll
        for (int i = 0; i < 4; ++i) { const float p = __builtin_amdgcn_exp2f(S[kt][i]); S[kt][i] = p; ps += p; }
    l += ps;
    bf16x8 pf[2];
#pragma unroll
    for (int k2 = 0; k2 < 2; ++k2) { v4u w; w.x = pk2(S[2 * k2][0], S[2 * k2][1]); w.y = pk2(S[2 * k2][2], S[2 * k2][3]); w.z = pk2(S[2 * k2 + 1][0], S[2 * k2 + 1][1]); w.w = pk2(S[2 * k2 + 1][2], S[2 * k2 + 1][3]);
        pf[k2] = __builtin_bit_cast(bf16x8, w); }
#pragma unroll
    for (int dt = 0; dt < 4; ++dt) {
        O[dt] = __builtin_amdgcn_mfma_f32_16x16x32_bf16(vf[dt][0], pf[0], O[dt], 0, 0, 0);
        O[dt] = __builtin_amdgcn_mfma_f32_16x16x32_bf16(vf[dt][1], pf[1], O[dt], 0, 0, 0); }
}
__device__ __forceinline__ float quad_xor1(float v) { return __builtin_bit_cast(float, __builtin_amdgcn_mov_dpp(__builtin_bit_cast(int, v), 0xB1, 0xF, 0xF, true)); }
__device__ __forceinline__ float quad_xor2(float v) { return __builtin_bit_cast(float, __builtin_amdgcn_mov_dpp(__builtin_bit_cast(int, v), 0x4E, 0xF, 0xF, true)); }
__device__ __forceinline__ float col_total(float l) { float lt = l + __shfl_xor(l, 16); lt += __shfl_xor(lt, 32); return lt; }

struct Blk { const bf16* K; const bf16* VT; int j; bool fast; };
struct LaneCtx { int dbase; float bfar; unsigned long long mlo, mhi; };
template <bool VF8>
__device__ __forceinline__ void load_block(v4u (&kf)[8], v4u (&vf)[8], const Blk& bl, unsigned lane16) {
    const GAS unsigned char* kb = (const GAS unsigned char*)bl.K; const GAS unsigned char* vb = (const GAS unsigned char*)bl.VT;
    if (VF8) {
#pragma unroll
        for (int kt = 0; kt < 4; ++kt) kf[kt] = *(const GAS v4u*)(kb + (size_t)lane16 + kt * 1024);
#pragma unroll
        for (int dt = 0; dt < 4; ++dt) vf[dt] = *(const GAS v4u*)(vb + (size_t)lane16 + dt * 1024);
    } else {
#pragma unroll
        for (int f = 0; f < 8; ++f) kf[f] = *(const GAS v4u*)(kb + (size_t)lane16 + f * 1024);
#pragma unroll
        for (int f = 0; f < 8; ++f) vf[f] = *(const GAS v4u*)(vb + (size_t)lane16 + f * 1024);
    }
}
template <int KS, int IS, int DSTEP, bool WIN, bool VF8, bool MASKED>
__device__ __forceinline__ void compute_block(const v4u (&kf)[8], const v4u (&vf)[8], const Blk& bl, const LaneCtx& lc, const bf16x8 (&qf)[2], const long (&qf8)[2], const LAS float* lutg, float& m, float& l, f32x4 (&O)[4]) {
    const bool have = m > -1.0e29f; const float off = have ? m : 0.f;
    bool sel = true;
    if (MASKED) { const unsigned long long mq = (bl.j & 64) ? lc.mhi : lc.mlo; sel = ((mq >> (bl.j & 63)) & 1ull) != 0ull; }
    const float bcol = sel ? lc.bfar : -1.0e30f;
    const float ini = bl.fast ? bcol - off : -off;
    f32x4 S[4];
#pragma unroll
    for (int kt = 0; kt < 4; ++kt) {
        if (VF8) { const long k0 = (long)(((unsigned long long)kf[kt].y << 32) | (unsigned long long)kf[kt].x), k1 = (long)(((unsigned long long)kf[kt].w << 32) | (unsigned long long)kf[kt].z);
            S[kt] = __builtin_amdgcn_mfma_f32_16x16x32_fp8_fp8(k0, qf8[0], (f32x4){ini, ini, ini, ini}, 0, 0, 0);
            S[kt] = __builtin_amdgcn_mfma_f32_16x16x32_fp8_fp8(k1, qf8[1], S[kt], 0, 0, 0);
        } else {
            S[kt] = __builtin_amdgcn_mfma_f32_16x16x32_bf16(__builtin_bit_cast(bf16x8, kf[kt * 2]), qf[0], (f32x4){ini, ini, ini, ini}, 0, 0, 0);
            S[kt] = __builtin_amdgcn_mfma_f32_16x16x32_bf16(__builtin_bit_cast(bf16x8, kf[kt * 2 + 1]), qf[1], S[kt], 0, 0, 0); }
    }
    if (!bl.fast) {
        int d0 = lc.dbase - DSTEP * bl.j; asm volatile("" : "+v"(d0));
        float bv[4][4];
#pragma unroll
        for (int kt = 0; kt < 4; ++kt)
#pragma unroll
            for (int i = 0; i < 4; ++i) { const int d = d0 - KS * kt - IS * i; const int dc = d < 0 ? 0 : (d > 127 ? 127 : d); bv[kt][i] = lutg[dc]; }
#pragma unroll
        for (int kt = 0; kt < 4; ++kt) asm volatile("" : "+v"(bv[kt][0]), "+v"(bv[kt][1]), "+v"(bv[kt][2]), "+v"(bv[kt][3]));
#pragma unroll
        for (int kt = 0; kt < 4; ++kt)
#pragma unroll
            for (int i = 0; i < 4; ++i) { const int d = d0 - KS * kt - IS * i; const bool ok = sel && d >= 0 && (!WIN || d < WINL);
                S[kt][i] = ok ? S[kt][i] + bv[kt][i] : -1.0e30f; }
    }
    float mx = fmaxf(fmaxf(fmaxf(S[0][0], S[0][1]), fmaxf(S[0][2], S[0][3])), fmaxf(fmaxf(S[1][0], S[1][1]), fmaxf(S[1][2], S[1][3])));
    mx = fmaxf(mx, fmaxf(fmaxf(fmaxf(S[2][0], S[2][1]), fmaxf(S[2][2], S[2][3])), fmaxf(fmaxf(S[3][0], S[3][1]), fmaxf(S[3][2], S[3][3]))));
    if (__any(have ? (mx > 8.f) : (mx > -1.0e29f))) {
        mx = fmaxf(mx, __shfl_xor(mx, 16)); mx = fmaxf(mx, __shfl_xor(mx, 32));
        const bool need = have ? (mx > 8.f) : (mx > -1.0e29f);
        const float delta = need ? mx : 0.f, sc = __builtin_amdgcn_exp2f(-delta);
        l *= sc; m = need ? off + mx : m;
#pragma unroll
        for (int dt = 0; dt < 4; ++dt) O[dt] = O[dt] * sc;
#pragma unroll
        for (int kt = 0; kt < 4; ++kt) S[kt] = S[kt] - delta;
    }
    float ps = 0.f;
#pragma unroll
    for (int kt = 0; kt < 4; ++kt)
#pragma unroll
        for (int i = 0; i < 4; ++i) { const float p = __builtin_amdgcn_exp2f(S[kt][i]); S[kt][i] = p; ps += p; }
    l += ps;
    if (VF8) {
        long pf8[2];
#pragma unroll
        for (int k2 = 0; k2 < 2; ++k2) { int w0 = 0, w1 = 0;
            w0 = __builtin_amdgcn_cvt_pk_fp8_f32(S[2 * k2][0], S[2 * k2][1], w0, false); w0 = __builtin_amdgcn_cvt_pk_fp8_f32(S[2 * k2][2], S[2 * k2][3], w0, true);
            w1 = __builtin_amdgcn_cvt_pk_fp8_f32(S[2 * k2 + 1][0], S[2 * k2 + 1][1], w1, false); w1 = __builtin_amdgcn_cvt_pk_fp8_f32(S[2 * k2 + 1][2], S[2 * k2 + 1][3], w1, true);
            pf8[k2] = (long)(((unsigned long long)(unsigned)w1 << 32) | (unsigned long long)(unsigned)w0); }
#pragma unroll
        for (int dt = 0; dt < 4; ++dt) {
            const long v0 = (long)(((unsigned long long)vf[dt].y << 32) | (unsigned long long)vf[dt].x), v1 = (long)(((unsigned long long)vf[dt].w << 32) | (unsigned long long)vf[dt].z);
            O[dt] = __builtin_amdgcn_mfma_f32_16x16x32_fp8_fp8(v0, pf8[0], O[dt], 0, 0, 0);
            O[dt] = __builtin_amdgcn_mfma_f32_16x16x32_fp8_fp8(v1, pf8[1], O[dt], 0, 0, 0); }
    } else {
        bf16x8 pf[2];
#pragma unroll
        for (int k2 = 0; k2 < 2; ++k2) { v4u w; w.x = pk2(S[2 * k2][0], S[2 * k2][1]); w.y = pk2(S[2 * k2][2], S[2 * k2][3]); w.z = pk2(S[2 * k2 + 1][0], S[2 * k2 + 1][1]); w.w = pk2(S[2 * k2 + 1][2], S[2 * k2 + 1][3]);
            pf[k2] = __builtin_bit_cast(bf16x8, w); }
#pragma unroll
        for (int dt = 0; dt < 4; ++dt) {
            O[dt] = __builtin_amdgcn_mfma_f32_16x16x32_bf16(__builtin_bit_cast(bf16x8, vf[dt * 2]), pf[0], O[dt], 0, 0, 0);
            O[dt] = __builtin_amdgcn_mfma_f32_16x16x32_bf16(__builtin_bit_cast(bf16x8, vf[dt * 2 + 1]), pf[1], O[dt], 0, 0, 0); }
    }
}
template <int KS, int IS, int DSTEP, bool WIN, bool VF8, bool MASKED, class Next>
__device__ __forceinline__ void run_blocks(Next& next, int n, const LaneCtx& lc, const bf16x8 (&qf)[2], const LAS float* lutg, float& m, float& l, f32x4 (&O)[4], unsigned lane16) {
    Blk b0, b1; v4u kA[8], kB[8], vA[8], vB[8];
    long qf8[2] = {0, 0};
    if (VF8) {
#pragma unroll
        for (int ks = 0; ks < 2; ++ks) { const v4u w = __builtin_bit_cast(v4u, qf[ks]); int a = 0, b = 0;
            a = __builtin_amdgcn_cvt_pk_fp8_f32(bflo(w.x), bfhi(w.x), a, false); a = __builtin_amdgcn_cvt_pk_fp8_f32(bflo(w.y), bfhi(w.y), a, true);
            b = __builtin_amdgcn_cvt_pk_fp8_f32(bflo(w.z), bfhi(w.z), b, false); b = __builtin_amdgcn_cvt_pk_fp8_f32(bflo(w.w), bfhi(w.w), b, true);
            qf8[ks] = (long)(((unsigned long long)(unsigned)b << 32) | (unsigned long long)(unsigned)a); } }
    if (n <= 0) return;
    (void)next(b0);
    load_block<VF8>(kA, vA, b0, lane16);
#pragma unroll 1
    for (int p = n >> 1; p > 0; --p) {
        b1 = b0; (void)next(b1);
        load_block<VF8>(kB, vB, b1, lane16); __builtin_amdgcn_sched_barrier(0);
        compute_block<KS, IS, DSTEP, WIN, VF8, MASKED>(kA, vA, b0, lc, qf, qf8, lutg, m, l, O);
        b0 = b1; (void)next(b0);
        load_block<VF8>(kA, vA, b0, lane16); __builtin_amdgcn_sched_barrier(0);
        compute_block<KS, IS, DSTEP, WIN, VF8, MASKED>(kB, vB, b1, lc, qf, qf8, lutg, m, l, O);
    }
    if (n & 1) compute_block<KS, IS, DSTEP, WIN, VF8, MASKED>(kA, vA, b0, lc, qf, qf8, lutg, m, l, O);
}

__device__ __forceinline__ void acc_set(LAS float* aL, const f32x4 (&O)[4], float s, int lane) {
#pragma unroll
    for (int dt = 0; dt < 4; ++dt)
#pragma unroll
        for (int i = 0; i < 4; ++i) aL[(dt * 4 + i) * 64 + lane] = O[dt][i] * s; }
__device__ __forceinline__ void acc_add(LAS float* aL, const f32x4 (&O)[4], float s, int lane) {
#pragma unroll
    for (int dt = 0; dt < 4; ++dt)
#pragma unroll
        for (int i = 0; i < 4; ++i) aL[(dt * 4 + i) * 64 + lane] += O[dt][i] * s; }
template <int NSBP>
__device__ __forceinline__ void cmp_branch(const bf16* KC, const bf16* VCT, int ncb, int tcol, int t0, bool want_imp, const bf16x8 (&qf)[2], const LAS float* lutg, float bfar, float gate, LAS float* aL, LAS float* imp, int lane) {
    const int r = lane & 15, qp = lane >> 4, slot = r >> 2, g = r & 3;
    float m = -3.0e38f, l = 0.f; f32x4 O[4];
#pragma unroll
    for (int dt = 0; dt < 4; ++dt) O[dt] = (f32x4){0.f, 0.f, 0.f, 0.f};
    { int cb = 0;
      const LaneCtx lc{tcol - 31 - 64 * qp, bfar, 0ull, 0ull};
      auto next = [&](Blk& bl) -> bool { if (cb >= ncb) return false; bl.K = KC + (size_t)cb * 4096; bl.VT = VCT + (size_t)cb * 4096; bl.j = cb;
          bl.fast = t0 - (1024 * cb + 1039) >= 113; ++cb; return true; };
      run_blocks<256, 16, 1024, false, false, false>(next, ncb, lc, qf, lutg, m, l, O, (unsigned)lane * 16u); }
    const float lt = col_total(l), rl = lt > 0.f ? 1.f / lt : 0.f;
    acc_set(aL, O, gate * rl, lane);
    if (want_imp) {
        float hprev = 0.f; const int src_lane = (lane + 48) & 63; const float mm = m > -1.0e29f ? m : 0.f;
        bf16x8 kA[4][2], kB[4][2];
        auto ldk = [&](bf16x8 (&kf)[4][2], int cb) { const bf16* K = KC + (size_t)cb * 4096;
#pragma unroll
            for (int kt = 0; kt < 4; ++kt)
#pragma unroll
                for (int ks = 0; ks < 2; ++ks) kf[kt][ks] = *(const GAS bf16x8*)(K + ((kt * 2 + ks) * 64 + lane) * 8); };
        auto score = [&](const bf16x8 (&kf)[4][2], int cb) {
            const bool fast = t0 - (1024 * cb + 1039) >= 113; const float ini = fast ? bfar - mm : -mm; f32x4 S[4];
#pragma unroll
            for (int kt = 0; kt < 4; ++kt) { S[kt] = __builtin_amdgcn_mfma_f32_16x16x32_bf16(kf[kt][0], qf[0], (f32x4){ini, ini, ini, ini}, 0, 0, 0); S[kt] = __builtin_amdgcn_mfma_f32_16x16x32_bf16(kf[kt][1], qf[1], S[kt], 0, 0, 0); }
            if (!fast) { int d0 = tcol - 31 - 16 * (64 * cb + 4 * qp); asm volatile("" : "+v"(d0)); float b2[4][4];
#pragma unroll
                for (int kt = 0; kt < 4; ++kt)
#pragma unroll
                    for (int i = 0; i < 4; ++i) { const int d = d0 - 256 * kt - 16 * i; const int dc = d < 0 ? 0 : (d > 127 ? 127 : d); b2[kt][i] = lutg[dc]; }
#pragma unroll
                for (int kt = 0; kt < 4; ++kt) asm volatile("" : "+v"(b2[kt][0]), "+v"(b2[kt][1]), "+v"(b2[kt][2]), "+v"(b2[kt][3]));
#pragma unroll
                for (int kt = 0; kt < 4; ++kt)
#pragma unroll
                    for (int i = 0; i < 4; ++i) { const int d = d0 - 256 * kt - 16 * i; S[kt][i] = d >= 0 ? S[kt][i] + b2[kt][i] : -1.0e30f; } }
#pragma unroll
            for (int kt = 0; kt < 4; ++kt) { float pr[4];
#pragma unroll
                for (int i = 0; i < 4; ++i) pr[i] = __builtin_amdgcn_exp2f(S[kt][i]) * rl;
                const float h = 0.5f * pr[3]; const float a = (pr[0] + pr[1]) + (pr[2] + h);
                const float r1 = __shfl(hprev, src_lane), r2 = __shfl(h, src_lane);
                float v = a + (qp == 0 ? r1 : r2);
                v += quad_xor1(v); v += quad_xor2(v);
                const int j = 16 * cb + 4 * kt + qp;
                if (g == 0 && j < NSBP) imp[slot * NSBP + j] = v;
                hprev = h; } };
        if (ncb > 0) { ldk(kA, 0); int cb = 0;
#pragma unroll 1
            for (int p = ncb >> 1; p > 0; --p) {
                ldk(kB, cb + 1); score(kA, cb); ++cb;
                ldk(kA, cb + 1 < ncb ? cb + 1 : cb); score(kB, cb); ++cb;
            }
            if (ncb & 1) score(kA, cb); }
        LDS_WAIT(); asm volatile("" ::: "memory");
    }
}
struct PAttn { const bf16 *Qb, *KSp, *KWp, *VTs, *VTw, *KCp, *VCTp; const float* GN; bf16* Ab; };

template <class Pre>
__device__ __forceinline__ void prompt_attn_group(const PAttn& T, int b, int kvh, int t0, const LAS float* lut, LAS float* imp  , LAS unsigned* selm  , int lane, const Pre& pre) {
    const int r = lane & 15, qp = lane >> 4, qi = r >> 2, g = r & 3;
    const int tcol = t0 + qi, tok = b * SEQ + tcol, head = kvh * 4 + g, bk = b * 2 + kvh, cur = t0 >> 6;
    const LAS float* lutg = lut + head * 128; const float bfar = lutg[127];
    LAS float* aL = imp + 2048;
    bf16x8 qf[2];
#pragma unroll
    for (int ks = 0; ks < 2; ++ks) qf[ks] = *(const GAS bf16x8*)(T.Qb + (size_t)tok * 512 + head * 64 + 32 * ks + 8 * qp);
    const float* gp = T.GN + (size_t)tok * 32 + kvh * 12 + g * 3;
    const float g0 = gp[0], g1 = gp[1], g2 = gp[2];
    unsigned mym[4], un[4];
    const int tmax = t0 + 3;
    const int ncb = tmax >= 31 ? (((tmax - 31) >> 4) >> 6) + 1 : 0;
    cmp_branch<128>(T.KCp + (size_t)bk * 512 * 64, T.VCTp + (size_t)bk * 8 * 4096, ncb, tcol, t0, cur >= 16, qf, lutg, bfar, g0, aL, imp, lane);
    if (cur >= 16) {
        { const int qs = lane >> 4, e = lane & 15; int io = qs * 128 + e; asm volatile("" : "+v"(io));
            LAS unsigned* impk = (LAS unsigned*)imp; unsigned key[8], rank[8];
#pragma unroll
            for (int i = 0; i < 8; ++i) { const int j = e + 16 * i; const unsigned bits = impk[io + 16 * i]; key[i] = (j >= 1 && j <= cur - 2) ? ((bits & ~127u) | (unsigned)(127 - j)) : 0u; rank[i] = 0u; }
#pragma unroll
            for (int i = 0; i < 8; ++i) impk[io + 16 * i] = key[i];
            if (e < 4) selm[qs * 4 + e] = 0u;
            LDS_WAIT(); asm volatile("" ::: "memory");
            const LAS v4u* kq = (const LAS v4u*)(impk + qs * 128);
            const int nk4 = (cur + 2) >> 2;
#pragma unroll 4
            for (int k4 = 0; k4 < nk4; ++k4) { const v4u kk = kq[k4];
#pragma unroll
                for (int i = 0; i < 8; ++i) rank[i] += (kk.x > key[i] ? 1u : 0u) + (kk.y > key[i] ? 1u : 0u) + (kk.z > key[i] ? 1u : 0u) + (kk.w > key[i] ? 1u : 0u); }
            unsigned mk4[4] = {0u, 0u, 0u, 0u};
#pragma unroll
            for (int i = 0; i < 8; ++i) { const int j = e + 16 * i; const bool tk = key[i] != 0u && rank[i] < (unsigned)(NSEL - 3);
#pragma unroll
                for (int w = 0; w < 4; ++w) mk4[w] |= (tk && w == (j >> 5)) ? (1u << (j & 31)) : 0u; }
            if (e == 0) {
#pragma unroll
                for (int w = 0; w < 4; ++w) { unsigned f = 0u; if (w == 0) f |= 1u; if (w == (cur >> 5)) f |= 1u << (cur & 31); if (w == ((cur - 1) >> 5)) f |= 1u << ((cur - 1) & 31); mk4[w] |= f; } }
#pragma unroll
            for (int w = 0; w < 4; ++w) if (mk4[w]) (void)__hip_atomic_fetch_or(selm + qs * 4 + w, mk4[w], __ATOMIC_RELAXED, __HIP_MEMORY_SCOPE_WORKGROUP);
        }
        LDS_WAIT(); asm volatile("" ::: "memory");
#pragma unroll
        for (int w = 0; w < 4; ++w) { mym[w] = selm[qi * 4 + w]; const unsigned u = selm[w] | selm[4 + w] | selm[8 + w] | selm[12 + w]; un[w] = (unsigned)__builtin_amdgcn_readfirstlane((int)u); }
        LDS_WAIT(); asm volatile("" ::: "memory");
    } else {
        mym[0] = (2u << cur) - 1u; mym[1] = 0u; mym[2] = 0u; mym[3] = 0u;
#pragma unroll
        for (int w = 0; w < 4; ++w) un[w] = mym[w];
    }
    {
        float m = -3.0e38f, l = 0.f; f32x4 O[4];
#pragma unroll
        for (int dt = 0; dt < 4; ++dt) O[dt] = (f32x4){0.f, 0.f, 0.f, 0.f};
        { unsigned long long ulo = ((unsigned long long)un[1] << 32) | un[0], uhi = ((unsigned long long)un[3] << 32) | un[2];
          const LaneCtx lc{tcol - 4 * qp, bfar, ((unsigned long long)mym[1] << 32) | mym[0], ((unsigned long long)mym[3] << 32) | mym[2]};
          auto next = [&](Blk& bl) -> bool {
              if ((ulo | uhi) == 0ull) return false;
              const bool inlo = ulo != 0ull; const unsigned long long u = inlo ? ulo : uhi;
              const int j = (inlo ? 0 : 64) + __builtin_ctzll(u); const unsigned long long u2 = u & (u - 1ull);
              ulo = inlo ? u2 : ulo; uhi = inlo ? uhi : u2;
              bl.K = T.KSp + (size_t)(bk * SEQ + 64 * j) * 64; bl.VT = T.VTs + (size_t)(bk * 128 + j) * 4096; bl.j = j; bl.fast = j <= cur - 3; return true; };
          run_blocks<16, 1, 64, false, true, true>(next, __builtin_popcountll(ulo) + __builtin_popcountll(uhi), lc, qf, lutg, m, l, O, (unsigned)lane * 16u); }
        const float lt = col_total(l), rl = lt > 0.f ? 1.f / lt : 0.f;
        acc_add(aL, O, g1 * rl, lane);
    }
    pre();
    {
        float m = -3.0e38f, l = 0.f; f32x4 O[4];
#pragma unroll
        for (int dt = 0; dt < 4; ++dt) O[dt] = (f32x4){0.f, 0.f, 0.f, 0.f};
        const int jlo = t0 >= WINL - 1 ? (t0 - (WINL - 1)) >> 6 : 0;
        { int j = jlo;
          const LaneCtx lc{tcol - 4 * qp, bfar, 0ull, 0ull};
          auto next = [&](Blk& bl) -> bool { if (j > cur) return false; bl.K = T.KWp + (size_t)(bk * SEQ + 64 * j) * 64; bl.VT = T.VTw + (size_t)(bk * 128 + j) * 4096; bl.j = j;
              bl.fast = t0 - (64 * j + 63) >= 113 && t0 + 3 - 64 * j < WINL; ++j; return true; };
          run_blocks<16, 1, 64, true, true, false>(next, cur - jlo + 1, lc, qf, lutg, m, l, O, (unsigned)lane * 16u); }
        const float lt = col_total(l), rl = lt > 0.f ? 1.f / lt : 0.f;
        bf16* ap = T.Ab + (size_t)tok * 512 + head * 64 + 4 * qp; const float s2 = g2 * rl;
#pragma unroll
        for (int dt = 0; dt < 4; ++dt) { float a[4];
#pragma unroll
            for (int i = 0; i < 4; ++i) a[i] = aL[(dt * 4 + i) * 64 + lane] + O[dt][i] * s2;
            v2u w; w.x = pk2(a[0], a[1]); w.y = pk2(a[2], a[3]); *(GAS v2u*)(ap + 16 * dt) = w; }
    }
}

struct SAttn { const bf16* Qb; const bf16 *KCs, *VCTs, *KWs, *VTWs, *KSn, *VTSn; const float *ck, *cv; const int* pt; const float* GN; bf16* Ab; };

template <class Pre>
__device__ __forceinline__ void sample_attn_unit(const SAttn& T, int unit, const LAS float* lut, LAS float* imp  , LAS int* sel  , int lane, const Pre& pre) {
    const int b = unit >> 3, kvh = (unit >> 2) & 1, qi = unit & 3, t = PAST + qi, tok = NP + b * DECS + qi, bk = b * 2 + kvh;
    const int r = lane & 15, qp = lane >> 4, g = r & 3, head = kvh * 4 + g;
    const LAS float* lutg = lut + head * 128; const float bfar = lutg[127];
    LAS float* aL = imp + 2048;
    bf16x8 qf[2];
#pragma unroll
    for (int ks = 0; ks < 2; ++ks) qf[ks] = *(const GAS bf16x8*)(T.Qb + (size_t)tok * 512 + head * 64 + 32 * ks + 8 * qp);
    const float* gp = T.GN + (size_t)tok * 32 + kvh * 12 + g * 3;
    const float g0 = gp[0], g1 = gp[1], g2 = gp[2];
    cmp_branch<256>(T.KCs + (size_t)bk * 1024 * 64, T.VCTs + (size_t)bk * 16 * 4096, 16, t, t, true, qf, lutg, bfar, g0, aL, imp, lane);
    { LAS unsigned* impk = (LAS unsigned*)imp; unsigned key[4], rank[4];
#pragma unroll
      for (int jb = 0; jb < 4; ++jb) { const int j = jb * 64 + lane; const unsigned bits = impk[j]; key[jb] = (j >= 1 && j <= 254) ? ((bits & ~255u) | (unsigned)(255 - j)) : 0u; rank[jb] = 0u; }
#pragma unroll
      for (int jb = 0; jb < 4; ++jb) impk[jb * 64 + lane] = key[jb];
      if (lane == 0) { sel[0] = 0; sel[1] = 255; sel[2] = 256; }
      LDS_WAIT(); asm volatile("" ::: "memory");
      const LAS v4u* kq = (const LAS v4u*)impk;
#pragma unroll 4
      for (int k4 = 0; k4 < 64; ++k4) { const v4u kk = kq[k4];
#pragma unroll
          for (int i = 0; i < 4; ++i) rank[i] += (kk.x > key[i] ? 1u : 0u) + (kk.y > key[i] ? 1u : 0u) + (kk.z > key[i] ? 1u : 0u) + (kk.w > key[i] ? 1u : 0u); }
      int base = 3;
#pragma unroll
      for (int jb = 0; jb < 4; ++jb) { const bool tk = key[jb] != 0u && rank[jb] < (unsigned)(NSEL - 3); const unsigned long long bm = __ballot(tk);
          if (tk) sel[base + __popcll(bm & ((1ull << lane) - 1ull))] = jb * 64 + lane;
          base += __popcll(bm); }
      LDS_WAIT(); asm volatile("" ::: "memory"); }
    {
        float m = -3.0e38f, l = 0.f; f32x4 O[4];
#pragma unroll
        for (int dt = 0; dt < 4; ++dt) O[dt] = (f32x4){0.f, 0.f, 0.f, 0.f};
        const int* ptb = T.pt + b * NPAGE;
#pragma unroll 1
        for (int i = 0; i < NSEL; ++i) { const int j = __builtin_amdgcn_readfirstlane(sel[i]);
            const AttnMaskSel mk{t - 64 * j - 4 * qp, true};
            if (j >= 256) { const SrcB src{T.KSn + (size_t)bk * 4096, T.VTSn + (size_t)bk * 4096};
                attn_block<false>(src, qf, lutg, mk, 0.f, m, l, O, r, qp); }
            else { const int page = ptb[j >> 1]; const size_t o = (((size_t)page * PAGE + (j & 1) * 64) * 2 + kvh) * 64; const SrcF src{T.ck + o, T.cv + o};
                if (j <= 253) attn_block<true>(src, qf, lutg, mk, bfar, m, l, O, r, qp);
                else attn_block<false>(src, qf, lutg, mk, 0.f, m, l, O, r, qp); } }
        const float lt = col_total(l), rl = lt > 0.f ? 1.f / lt : 0.f;
        acc_add(aL, O, g1 * rl, lane);
    }
    pre();
    {
        float m = -3.0e38f, l = 0.f; f32x4 O[4];
#pragma unroll
        for (int dt = 0; dt < 4; ++dt) O[dt] = (f32x4){0.f, 0.f, 0.f, 0.f};
        constexpr int WPOS0 = PAST + DECS - (WINL + DECS);
        { int jb = 0;
          const LaneCtx lc{t - WPOS0 - 4 * qp, bfar, 0ull, 0ull};
          auto next = [&](Blk& bl) -> bool { if (jb >= 9) return false; const int pos0 = WPOS0 + 64 * jb; bl.K = T.KWs + (size_t)(bk * 576 + 64 * jb) * 64; bl.VT = T.VTWs + (size_t)(bk * 9 + jb) * 4096; bl.j = jb;
              bl.fast = t - (pos0 + 63) >= 113 && t - pos0 < WINL; ++jb; return true; };
          run_blocks<16, 1, 64, true, false, false>(next, 9, lc, qf, lutg, m, l, O, (unsigned)lane * 16u); }
        const float lt = col_total(l), rl = lt > 0.f ? 1.f / lt : 0.f;
        bf16* ap = T.Ab + (size_t)tok * 512 + head * 64 + 4 * qp; const float s2 = g2 * rl;
#pragma unroll
        for (int dt = 0; dt < 4; ++dt) { float a[4];
#pragma unroll
            for (int i = 0; i < 4; ++i) a[i] = aL[(dt * 4 + i) * 64 + lane] + O[dt][i] * s2;
            if (r < 4) { v2u w; w.x = pk2(a[0], a[1]); w.y = pk2(a[2], a[3]); *(GAS v2u*)(ap + 16 * dt) = w; } }
    }
}


constexpr int N_PHASES = 10;
struct Args { const void* in[28]; float* out; unsigned char* ws; int ph_lo, ph_hi; };
static_assert(sizeof(Args) == 28 * 8 + 8 + 8 + 8, "Args has no padding");

__global__ void __launch_bounds__(NWAVES * 64, 2) nsa_fwd(Args args) {
    extern __shared__ __attribute__((aligned(16))) unsigned char lds_raw[];
    LAS unsigned char* lds = (LAS unsigned char*)lds_raw;
    volatile LAS unsigned* MISC = (volatile LAS unsigned*)(lds + MISC_OFF);
    const int tid = threadIdx.x;
    const int G = gridDim.x, bx = blockIdx.x, NGW = G * NWAVES;
#define PHASE_IDS() int tid_ = threadIdx.x; asm volatile("" : "+v"(tid_)); const int lane = tid_ & 63, wave = __builtin_amdgcn_readfirstlane(tid_ >> 6), gw = bx * NWAVES + wave; (void)lane; (void)gw
    unsigned char* ws = args.ws; float* out = args.out;
    gu32* ctl = (gu32*)(ws + WS_CTL);
    const float* x_prompt = (const float*)args.in[0]; const float* x_sample = (const float*)args.in[1];
    for (int u = tid; u < (LDS_BYTES - LDSCTL_OFF) / 4; u += NWAVES * 64) ((LAS unsigned*)(lds + LDSCTL_OFF))[u] = 0u;
    { const float* rel_bias = (const float*)args.in[26]; LAS float* lut = (LAS float*)(lds + LUT_OFF);
      for (int u = tid; u < 8 * 128; u += NWAVES * 64) { const int h = u >> 7, n = u & 127; int bkt = n;
          if (n >= 16) { bkt = 16; const int th[15] = {19, 21, 24, 27, 31, 35, 40, 46, 52, 59, 67, 77, 87, 99, 113};
#pragma unroll
              for (int i = 0; i < 15; ++i) bkt += (n >= th[i]) ? 1 : 0; }
          lut[u] = rel_bias[bkt * NH + h] * LOG2E; } }
    __syncthreads();
#if MK_N_LAUNCHES == 1
    XcdBarrier bar = xcd_barrier_post((unsigned*)(ctl + CW_BAR), MISC + 8);
#define GRID_BAR() xcd_barrier(bar)
#else
#define GRID_BAR() do {} while (0)
#endif
    const int lo = args.ph_lo, hi = args.ph_hi;
#ifndef PH_MASK
#define PH_MASK 0x3ff
#endif
#define IN(k) ((((PH_MASK) >> (k)) & 1) && lo <= (k) && (k) < hi)
#define BOTH(k) (IN(k) && IN((k) + 1))
#ifdef DBG_REP_PHASE
#define REP(k) ((((DBG_REP_PHASE) >> (k)) & 1) ? 2 : 1)
#else
#define REP(k) 1
#endif
    using pg8::bf16_t;
    bf16* WinT = (bf16*)(ws + WS_WIN); bf16* WnsaT = (bf16*)(ws + WS_WNSA); bf16* WconvT = (bf16*)(ws + WS_WCONV); bf16* WoT = (bf16*)(ws + WS_WO);
    bf16* WupT = (bf16*)(ws + WS_WUP); bf16* WdnT = (bf16*)(ws + WS_WDN); bf16* W1Tk = (bf16*)(ws + WS_W1K); bf16* W1Tv = (bf16*)(ws + WS_W1V);
    bf16* W2Tk = (bf16*)(ws + WS_W2K); bf16* W2Tv = (bf16*)(ws + WS_W2V); float* PE = (float*)(ws + WS_PE);
    bf16* XN = (bf16*)(ws + WS_XN); bf16* Qb = (bf16*)(ws + WS_QB); bf16* CV = (bf16*)(ws + WS_CV); bf16* GAB = (bf16*)(ws + WS_GAB); float* GN = (float*)(ws + WS_GN);
    bf16* CKp = (bf16*)(ws + WS_CKP); bf16* CVp = (bf16*)(ws + WS_CVP); bf16* KSp = (bf16*)(ws + WS_KSP); bf16* KWp = (bf16*)(ws + WS_KWP); bf16* VTs = (bf16*)(ws + WS_VTS); bf16* VTw = (bf16*)(ws + WS_VTW);
    bf16* Gp = (bf16*)(ws + WS_GP); bf16* KCp = (bf16*)(ws + WS_KCP); bf16* VCTp = (bf16*)(ws + WS_VCTP); bf16* Ab = (bf16*)(ws + WS_AB); bf16* Cb = (bf16*)(ws + WS_CB);
    float* M1 = (float*)(ws + WS_M1); bf16* Mb = (bf16*)(ws + WS_MB); float* X1 = (float*)(ws + WS_X1); bf16* X1b = (bf16*)(ws + WS_X1B); float* PSS = (float*)(ws + WS_PSS); bf16* Hb = (bf16*)(ws + WS_H);
    bf16* CKs = (bf16*)(ws + WS_CKS); bf16* CVs = (bf16*)(ws + WS_CVS); bf16* Gs = (bf16*)(ws + WS_GS); bf16* KCs = (bf16*)(ws + WS_KCS); bf16* VCTs = (bf16*)(ws + WS_VCS); bf16* KWs = (bf16*)(ws + WS_KWS); bf16* VTWs = (bf16*)(ws + WS_VTWS); float* PD = (float*)(ws + WS_PD);

    if (IN(0)) for (int rep = 0; rep < REP(0); ++rep) {
        PHASE_IDS();
        LAS float* scr = (LAS float*)(lds + RING_OFF + wave * 16384);
        constexpr int I_IN = 16 * (NIN / 32), I_NSA = 8 * 32, I_CONV = 8 * 32, I_WO = 16 * 32, I_UP = 16 * 128, I_DN = 64 * 32, I_W1 = 32 * 8, I_W2 = 4 * 2;
        constexpr int NT_ITEMS = I_IN + I_NSA + I_CONV + I_WO + I_UP + I_DN + 2 * I_W1 + 2 * I_W2;
        for (int it = gw; it < NT_ITEMS; it += NGW) {
            int r = it;
            if (r < I_IN) { p0_transpose_item<1>((const float*)args.in[11], 1024, INCOLS, NIN, WinT, nullptr, scr, r, lane); continue; } r -= I_IN;
            if (r < I_NSA) { p0_transpose_item<0>((const float*)args.in[20], 512, 1024, 1024, WnsaT, nullptr, scr, r, lane); continue; } r -= I_NSA;
            if (r < I_CONV) { p0_transpose_item<0>((const float*)args.in[21], 512, 1024, 1024, WconvT, nullptr, scr, r, lane); continue; } r -= I_CONV;
            if (r < I_WO) { p0_transpose_item<0>((const float*)args.in[22], 1024, 1024, 1024, WoT, nullptr, scr, r, lane); continue; } r -= I_WO;
            if (r < I_UP) { p0_transpose_item<0>((const float*)args.in[24], 1024, 4096, 4096, WupT, (const float*)args.in[23], scr, r, lane); continue; } r -= I_UP;
            if (r < I_DN) { p0_transpose_item<0>((const float*)args.in[25], 4096, 1024, 1024, WdnT, nullptr, scr, r, lane); continue; } r -= I_DN;
            if (r < I_W1) { p0_transpose_item<0>((const float*)args.in[13], 2048, 256, 256, W1Tk, nullptr, scr, r, lane); continue; } r -= I_W1;
            if (r < I_W1) { p0_transpose_item<0>((const float*)args.in[16], 2048, 256, 256, W1Tv, nullptr, scr, r, lane); continue; } r -= I_W1;
            if (r < I_W2) { p0_transpose_item<0>((const float*)args.in[14], 256, 64, 64, W2Tk, nullptr, scr, r, lane); continue; } r -= I_W2;
            p0_transpose_item<0>((const float*)args.in[17], 256, 64, 64, W2Tv, nullptr, scr, r, lane);
        }
        { const float* g_attn = (const float*)args.in[10];
#pragma unroll 4
          for (int m = gw; m < NP; m += NGW) rms_row_to_bf16(x_prompt + (size_t)m * DM, g_attn, XN + (size_t)m * DM, lane);
          for (int m = NP + gw; m < MTOK; m += NGW) {
              if (m < NP + NSMP) rms_row_to_bf16(x_sample + (size_t)(m - NP) * DM, g_attn, XN + (size_t)m * DM, lane);
              else { GAS v4u* o = (GAS v4u*)(XN + (size_t)m * DM) + lane; o[0] = (v4u){0u, 0u, 0u, 0u}; o[64] = (v4u){0u, 0u, 0u, 0u}; } } }
        for (int it = (wave ^ 5) * G + bx; it < 128; it += NGW) { const int kv = it >> 6, c0 = (it & 63) * 4, c = lane & 3, kp = lane >> 2;
            const float* pe = (const float*)args.in[kv ? 15 : 12]; const float* w1 = (const float*)args.in[kv ? 16 : 13];
            float s = 0.f;
#pragma unroll 32
            for (int i = 0; i < 128; ++i) { const int k = kp + 16 * i; s += pe[k] * w1[(size_t)k * 256 + c0 + c]; }
            s += __shfl_xor(s, 4); s += __shfl_xor(s, 8); s += __shfl_xor(s, 16); s += __shfl_xor(s, 32);
            if (kp == 0) PE[kv * 256 + c0 + c] = s; }
        for (int it = wave * G + bx; it < 2 * DECB * 16; it += NGW) { const int kv = it / (DECB * 16), b = (it / 16) % DECB, part = it & 15;
            const float* src = (const float*)args.in[kv ? 7 : 6] + (size_t)b * WINL * 128; float* dst = out + (kv ? O_SWV : O_SWK) + (size_t)b * WINL * 128;
            f32x4 v[16];
#pragma unroll
            for (int i = 0; i < 16; ++i) { const int j = part * 32 + 2 * i + (lane >> 5); v[i] = *(const GAS f32x4*)(src + (size_t)(j + DECS < WINL ? j + DECS : WINL - 1) * 128 + (lane & 31) * 4); }
#pragma unroll
            for (int i = 0; i < 16; ++i) { const int j = part * 32 + 2 * i + (lane >> 5); if (j < WINL - DECS) *(GAS f32x4*)(dst + (size_t)j * 128 + (lane & 31) * 4) = v[i]; } }
        if (gw < 4) { bf16* p = gw == 0 ? CKp + (size_t)4 * SEQ * 64 : gw == 1 ? CVp + (size_t)4 * SEQ * 64 : gw == 2 ? CKs + (size_t)64 * PAST * 64 : CVs + (size_t)64 * PAST * 64;
            ((GAS v4u*)p)[lane] = (v4u){0u, 0u, 0u, 0u}; ((GAS v4u*)p)[64 + lane] = (v4u){0u, 0u, 0u, 0u}; }
        if (BOTH(0)) GRID_BAR();
    }

    if (IN(1)) for (int rep = 0; rep < REP(1); ++rep) {
        if ((bx & 1) == 0) { PHASE_IDS();
          constexpr int NITEM = 2 * DECB * NPAGE * 4; const int istep = (G >> 1) * NWAVES; const int c = (lane & 31) * 4, kvh = c >> 6, d = c & 63, rsel = lane >> 5;
          const int* ptab = (const int*)args.in[9];
          auto ipage = [&](int it) -> int { const int rem = it % (DECB * NPAGE * 4), b = rem / (NPAGE * 4), pg = (rem / 4) % NPAGE; return b * NPAGE + pg; };
          auto idst = [&](int it) -> bf16* { const int kv = it / (DECB * NPAGE * 4), rem = it % (DECB * NPAGE * 4), b = rem / (NPAGE * 4), pg = (rem / 4) % NPAGE, qt = rem & 3;
              return (kv ? CVs : CKs) + ((size_t)(b * 2 + kvh) * PAST + pg * PAGE + qt * 32 + rsel) * 64 + d; };
          f32x4 va[16], vb[16];
#pragma unroll 1
          for (int itc = (bx >> 1) * NWAVES + wave; itc < NITEM; itc += 64 * istep) {
              const int itl = itc + lane * istep; const int pv = ptab[ipage(itl < NITEM ? itl : itc)];
              const int nleft = (NITEM - itc + istep - 1) / istep, n = nleft < 64 ? nleft : 64;
              auto ld = [&](f32x4 (&v)[16], int k) { const int it = itc + k * istep; const int page = __builtin_amdgcn_readlane(pv, k);
                  const float* s0 = (const float*)args.in[it >= DECB * NPAGE * 4 ? 3 : 2] + ((size_t)page * PAGE + (it & 3) * 32 + rsel) * 128 + c;
#pragma unroll
                  for (int i = 0; i < 16; ++i) v[i] = __builtin_nontemporal_load((const GAS f32x4*)(s0 + (size_t)i * 256)); };
              auto st = [&](const f32x4 (&v)[16], int k) { bf16* dp = idst(itc + k * istep);
#pragma unroll
                  for (int i = 0; i < 16; ++i) { v2u w; w.x = pk2(v[i].x, v[i].y); w.y = pk2(v[i].z, v[i].w); __builtin_nontemporal_store(w, (GAS v2u*)(dp + (size_t)i * 128)); } };
              ld(va, 0); int k = 0;
#pragma unroll 1
              for (int p = n >> 1; p > 0; --p) {
                  ld(vb, k + 1); __builtin_amdgcn_sched_barrier(0); st(va, k);
                  ld(va, k + 2 < n ? k + 2 : k + 1); __builtin_amdgcn_sched_barrier(0); st(vb, k + 1);
                  k += 2;
              }
              if (n & 1) st(va, k);
          }
        }
        { pg8::Gemm g{XN, WinT, MTOK, NIN, DM, DM, DM}; pg8::MixedOrder S; S.init(MTOK, NIN, bx, W_IN_R0);
          pg8::EpiIn E{out, Qb, CV, GAB, GN, CKp, CVp};
          pg8::gemm_phase<pg8::EpiIn, pg8::MixedOrder, true, true>(lds + RING_OFF, g, S, E); }
        GRID_BAR();
#ifndef DBG_NO_CMP
        { pg8::Gemm g{CKs, W1Tk, 65536, 512, 2048, 1024, 2048};
          struct KVOrder { pg8::StaticOrder so; __device__ __forceinline__ bool next(int i, pg8::Unit& u) const { if (!so.next(i, u)) return false; u.aoff = u.pn ? (int)(WS_CVS - WS_CKS) : 0; return true; }
              __device__ __forceinline__ void a_ready(const pg8::Unit&) const {} __device__ __forceinline__ void done(const pg8::Unit&) const {} } S; S.so.init(65536, 512, G, bx);
          pg8::EpiCmp E{Gs, PE, (size_t)65536 * 256};
          pg8::gemm_phase<pg8::EpiCmp, KVOrder, true, true>(lds + RING_OFF, g, S, E);
          { PHASE_IDS(); pg8::Unit u;
            if (S.so.next(wave >> 2, u)) { const int row0 = u.pm * 256 + (wave & 3) * 64;
                if (u.pn == 0) { const SkOutKT Ek{KCs}; skinny_unit<4, 4>(Gs, 256, W2Tk, 256, 256, row0, 0, Ek, lane); }
                else { const SkOutVT Ev{VCTs}; skinny_unit<4, 4, false>(Gs + (size_t)65536 * 256, 256, W2Tv, 256, 256, row0, 0, Ev, lane); } } } }
#endif
        { PHASE_IDS();
        for (int it = wave * G + bx; it < 2 * 64 * 8; it += NGW) { const int kv = it >> 9, rg = (it >> 3) & 63, cg = it & 7;
            const SkHid E{Gp + (size_t)kv * 2048 * 256, PE + kv * 256};
            skinny_unit<2, 2>(kv ? CVp : CKp, 1024, kv ? W1Tv : W1Tk, 2048, 2048, rg * 32, cg * 32, E, lane); }
        for (int it = (wave & 3) * G + bx + (wave < 4 ? 0 : NGW); it < 64 * 10; it += NGW) { const int bk = it / 10, jb = it % 10, b = bk >> 1, kvh = bk & 1, j = jb * 64 + lane;
            const float* kr = nullptr; const float* vr = nullptr;
            if (jb == 9) { if (lane < DECS) { const size_t o = ((size_t)(b * DECS + lane) * 2 + kvh) * 64; kr = out + O_SSK + o; vr = out + O_SSV + o; } }
            else if (j < WINL) { const size_t o = ((size_t)(b * WINL + j) * 2 + kvh) * 64; kr = (const float*)args.in[6] + o; vr = (const float*)args.in[7] + o; }
            else if (j < WINL + DECS) { const size_t o = ((size_t)(b * WINL + (WINL - DECS) + (j - WINL)) * 2 + kvh) * 64; kr = out + O_SWK + o; vr = out + O_SWV + o; }
            bf16* kd = jb == 9 ? KWs + (size_t)64 * 576 * 64 + (size_t)bk * 4096 : KWs + (size_t)(bk * 9 + jb) * 4096;
            bf16* vd = jb == 9 ? VTWs + (size_t)64 * 9 * 4096 + (size_t)bk * 4096 : VTWs + (size_t)(bk * 9 + jb) * 4096;
#pragma unroll 4
            for (int c = 0; c < 8; ++c) { f32x4 a = (f32x4){0.f, 0.f, 0.f, 0.f}, bb = a, x = a, y = a;
                if (kr) { a = *(const GAS f32x4*)(kr + 8 * c); bb = *(const GAS f32x4*)(kr + 8 * c + 4); x = *(const GAS f32x4*)(vr + 8 * c); y = *(const GAS f32x4*)(vr + 8 * c + 4); }
                v4u w; w.x = pk2(a[0], a[1]); w.y = pk2(a[2], a[3]); w.z = pk2(bb[0], bb[1]); w.w = pk2(bb[2], bb[3]); *(GAS v4u*)(kd + ktile_off(lane, 8 * c)) = w;
#pragma unroll
                for (int i = 0; i < 4; ++i) { vd[vtile_off(lane, 8 * c + i)] = f2bf_rne(x[i]); vd[vtile_off(lane, 8 * c + 4 + i)] = f2bf_rne(y[i]); } } }
        { const float* conv_w = (const float*)args.in[18]; const float* conv_b = (const float*)args.in[19]; const float* state_conv = (const float*)args.in[8];
          for (int m = wave < 4 ? NP + NSMP : (wave - 4) * G + bx; m < NP + NSMP; m += 4 * G) {
              const int d0 = lane * 8; float u0[8], u1[8], u2[8], bg[8];
              auto ld8 = [&](const bf16* p, float (&v)[8]) { const v4u w = *(const GAS v4u*)p; v[0] = bflo(w.x); v[1] = bfhi(w.x); v[2] = bflo(w.y); v[3] = bfhi(w.y); v[4] = bflo(w.z); v[5] = bfhi(w.z); v[6] = bflo(w.w); v[7] = bfhi(w.w); };
              auto urow = [&](int row, float (&u)[8]) { float a[8], c[8]; ld8(CV + (size_t)row * 1536 + 512 + d0, a); ld8(CV + (size_t)row * 1536 + 1024 + d0, c);
#pragma unroll
                  for (int i = 0; i < 8; ++i) u[i] = a[i] * c[i]; };
              auto zero8 = [&](float (&u)[8]) {
#pragma unroll
                  for (int i = 0; i < 8; ++i) u[i] = 0.f; };
              auto st8 = [&](const float* p, float (&u)[8]) { const f32x4 a = *(const GAS f32x4*)p, c = *(const GAS f32x4*)(p + 4); u[0] = a.x; u[1] = a.y; u[2] = a.z; u[3] = a.w; u[4] = c.x; u[5] = c.y; u[6] = c.z; u[7] = c.w; };
              urow(m, u2); ld8(CV + (size_t)m * 1536 + d0, bg);
              if (m < NP) { const int t = m & (SEQ - 1);
                  if (t >= 1) urow(m - 1, u1); else zero8(u1);
                  if (t >= 2) urow(m - 2, u0); else zero8(u0);
                  if (t >= SEQ - 2) { float* pc = out + O_PCONV + (size_t)((m >> 13) * 2 + (t - (SEQ - 2))) * CONVD + d0; *(GAS f32x4*)pc = (f32x4){u2[0], u2[1], u2[2], u2[3]}; *(GAS f32x4*)(pc + 4) = (f32x4){u2[4], u2[5], u2[6], u2[7]}; }
              } else { const int tk = m - NP, b = tk >> 2, s = tk & 3;
                  if (s >= 1) urow(m - 1, u1); else st8(state_conv + (size_t)(b * 2 + 1) * CONVD + d0, u1);
                  if (s >= 2) urow(m - 2, u0); else st8(state_conv + (size_t)(b * 2 + s) * CONVD + d0, u0);
                  if (s >= 2) { float* pc = out + O_SCONV + (size_t)(b * 2 + (s - 2)) * CONVD + d0; *(GAS f32x4*)pc = (f32x4){u2[0], u2[1], u2[2], u2[3]}; *(GAS f32x4*)(pc + 4) = (f32x4){u2[4], u2[5], u2[6], u2[7]}; }
              }
              float w0[8], w1[8], w2[8], cb[8]; st8(conv_w + d0, w0); st8(conv_w + CONVD + d0, w1); st8(conv_w + 2 * CONVD + d0, w2); st8(conv_b + d0, cb);
              float y[8];
#pragma unroll
              for (int i = 0; i < 8; ++i) y[i] = bg[i] * (cb[i] + w0[i] * u0[i] + w1[i] * u1[i] + w2[i] * u2[i]);
              v4u w; w.x = pk2(y[0], y[1]); w.y = pk2(y[2], y[3]); w.z = pk2(y[4], y[5]); w.w = pk2(y[6], y[7]);
              *(GAS v4u*)(Cb + (size_t)m * 512 + d0) = w; }
          for (int m = NP + NSMP + gw; m < MTOK; m += NGW) *(GAS v4u*)(Cb + (size_t)m * 512 + lane * 8) = (v4u){0u, 0u, 0u, 0u};
        }
        }
        if (BOTH(1)) GRID_BAR();
    }

    if (IN(3)) for (int rep = 0; rep < REP(3); ++rep) {
        PHASE_IDS();
        for (int it = wave * G + bx; it < 2 * 64; it += NGW) { const int kv = it >> 6, rg = it & 63;
            if (kv == 0) { const SkOutKT E{KCp}; skinny_unit<2, 4>(Gp, 256, W2Tk, 256, 256, rg * 32, 0, E, lane); }
            else { const SkOutVT E{VCTp}; skinny_unit<2, 4, false>(Gp + (size_t)2048 * 256, 256, W2Tv, 256, 256, rg * 32, 0, E, lane); } }
        if (BOTH(3)) GRID_BAR();
    }

    if (IN(4)) for (int rep = 0; rep < REP(4); ++rep) {
        PHASE_IDS();
        const LAS float* lut = (const LAS float*)(lds + LUT_OFF);
        LAS float* slog = (LAS float*)(lds + RING_OFF + wave * 16384);
        LAS float* wscr = (LAS float*)(lds + WSCR_OFF + wave * WSCR_BYTES);
        const PAttn PT{Qb, KSp, KWp, VTs, VTw, KCp, VCTp, GN, Ab};
        const SAttn ST{Qb, KCs, VCTs, KWs, VTWs, KWs + (size_t)64 * 576 * 64, VTWs + (size_t)64 * 9 * 4096, (const float*)args.in[4], (const float*)args.in[5], (const int*)args.in[9], GN, Ab};
        constexpr int NUNITS = 256 + 4 * (SEQ / 4); static_assert(NUNITS % 16 == 0, "queue shards");
#ifdef DBG_NO_ATTN
        for (int m = gw; m < NP + NSMP; m += NGW) *(GAS v4u*)(Ab + (size_t)m * 512 + lane * 8) = (v4u){0u, 0u, 0u, 0u};
#else
        int shard = (bx + wave) & 15, tried = 0, nraw = 0;
        gu32* qbase = ctl + CW_QUEUE + 1024 * rep;
        auto pop_sync = [&]() -> int {
            for (;;) { int t = 0; if (lane == 0) t = (int)__hip_atomic_fetch_add((unsigned*)(qbase + 64 * shard), 1u, RLX_AGENT);
                t = __builtin_amdgcn_readfirstlane(t);
                if (t < NUNITS / 16) return t * 16 + shard;
                if (++tried >= 16) return -1; shard = (shard + 1) & 15; } };
        auto pre = [&]() { if (lane == 0) nraw = (int)__hip_atomic_fetch_add((unsigned*)(qbase + 64 * shard), 1u, RLX_AGENT); };
        int u = pop_sync();
        while (u >= 0) {
            int ln = lane; asm volatile("" : "+v"(ln));
#ifdef DBG_REP4_MODE
            if (rep == 1 && ((DBG_REP4_MODE == 1) ? (u >= 256) : (u < 256))) pre(); else
#endif
            {
#ifndef NO_SAMPLE_ATTN
            if (u < 256) sample_attn_unit(ST, u, lut, slog, (LAS int*)(slog + 1024), ln, pre);
#else
            if (u < 256) pre();
#endif
#ifndef NO_PROMPT_ATTN
            else { const int v = u - 256, bk = v / (SEQ / 4), tg = (SEQ / 4 - 1) - (v % (SEQ / 4));
                prompt_attn_group(PT, bk >> 1, bk & 1, tg * 4, lut, slog, (LAS unsigned*)(slog + 512), ln, pre); }
#else
            else pre();
#endif
            }
            const int nt = __builtin_amdgcn_readfirstlane(nraw);
            if (nt < NUNITS / 16) u = nt * 16 + shard;
            else { if (++tried >= 16) break; shard = (shard + 1) & 15; u = pop_sync(); }
        }
#endif
        for (int m = NP + NSMP + gw; m < MTOK; m += NGW) *(GAS v4u*)(Ab + (size_t)m * 512 + lane * 8) = (v4u){0u, 0u, 0u, 0u};
        if (BOTH(4)) GRID_BAR();
    }

    if (IN(5)) for (int rep = 0; rep < REP(5); ++rep) {
        { pg8::Gemm g{Ab, WnsaT, NP, 2 * DM, 512, 512, 512};
          pg8::PairOrder S; S.init(NP, DM, G, bx, (int)(WS_CB - WS_AB));
          pg8::EpiNC E{GAB, Mb};
          pg8::gemm_phase<pg8::EpiNC, pg8::PairOrder, true, true>(lds + RING_OFF, g, S, E); }
        { PHASE_IDS();
          for (int it = wave * G + bx; it < 2 * 32; it += NGW) { const int row0 = NP + (it >> 5) * 64, col0 = (it & 31) * 32, r = lane & 15, qd = lane >> 4;
              f32x4 a1[4][2], a2[4][2];
#pragma unroll
              for (int a = 0; a < 4; ++a)
#pragma unroll
                  for (int b = 0; b < 2; ++b) { a1[a][b] = (f32x4){0.f, 0.f, 0.f, 0.f}; a2[a][b] = a1[a][b]; }
              const bf16* ap1 = Ab + (size_t)(row0 + r) * 512 + qd * 8; const bf16* ap2 = Cb + (size_t)(row0 + r) * 512 + qd * 8;
              const bf16* bp1 = WnsaT + (size_t)(col0 + r) * 512 + qd * 8; const bf16* bp2 = WconvT + (size_t)(col0 + r) * 512 + qd * 8;
#pragma unroll 2
              for (int k = 0; k < 512; k += 32) { bf16x8 f1[4], f2[4], w1[2], w2[2];
#pragma unroll
                  for (int a = 0; a < 4; ++a) { f1[a] = *(const GAS bf16x8*)(ap1 + (size_t)a * 16 * 512 + k); f2[a] = *(const GAS bf16x8*)(ap2 + (size_t)a * 16 * 512 + k); }
#pragma unroll
                  for (int b = 0; b < 2; ++b) { w1[b] = *(const GAS bf16x8*)(bp1 + (size_t)b * 16 * 512 + k); w2[b] = *(const GAS bf16x8*)(bp2 + (size_t)b * 16 * 512 + k); }
#pragma unroll
                  for (int a = 0; a < 4; ++a)
#pragma unroll
                      for (int b = 0; b < 2; ++b) { a1[a][b] = __builtin_amdgcn_mfma_f32_16x16x32_bf16(w1[b], f1[a], a1[a][b], 0, 0, 0); a2[a][b] = __builtin_amdgcn_mfma_f32_16x16x32_bf16(w2[b], f2[a], a2[a][b], 0, 0, 0); } }
#pragma unroll
              for (int a = 0; a < 4; ++a)
#pragma unroll
                  for (int b = 0; b < 2; ++b) { const int row = row0 + 16 * a + r, col = col0 + 16 * b + 4 * qd;
                      const v2u ga = *(const GAS v2u*)(GAB + (size_t)row * 2048 + col), gb = *(const GAS v2u*)(GAB + (size_t)row * 2048 + 1024 + col);
                      v2u w; w.x = pk2(bflo(ga.x) * a1[a][b][0] + bflo(gb.x) * a2[a][b][0], bfhi(ga.x) * a1[a][b][1] + bfhi(gb.x) * a2[a][b][1]);
                      w.y = pk2(bflo(ga.y) * a1[a][b][2] + bflo(gb.y) * a2[a][b][2], bfhi(ga.y) * a1[a][b][3] + bfhi(gb.y) * a2[a][b][3]);
                      *(GAS v2u*)(Mb + (size_t)row * 1024 + col) = w; } } }
        if (BOTH(5)) GRID_BAR();
    }

    if (IN(6)) for (int rep = 0; rep < REP(6); ++rep) {
        { pg8::Gemm g{Mb, WoT, NP, DM, DM, DM, DM}; pg8::StaticOrder S; S.init(NP, DM, G, bx);
          pg8::EpiWo E{x_prompt, x_sample, X1, X1b, PSS};
          pg8::gemm_phase<pg8::EpiWo, pg8::StaticOrder, false, true>(lds + RING_OFF, g, S, E); }
        { PHASE_IDS();
          for (int it = wave * G + bx; it < 8 * 16; it += NGW) { const int row0 = NP + (it >> 4) * 16, cgp = it & 15;
              const SkWo E{x_sample, X1, X1b, PSS, cgp};
              skinny_unit<1, 4>(Mb, 1024, WoT, 1024, 1024, row0, cgp * 64, E, lane); } }
        if (BOTH(6)) GRID_BAR();
    }

    if (IN(7)) for (int rep = 0; rep < REP(7); ++rep) {
        { pg8::Gemm g{X1b, WupT, NP, DFF, DM, DM, DM}; pg8::StaticOrder S; S.init(NP, DFF, G, bx);
          pg8::EpiUp E{PSS, Hb};
          pg8::gemm_phase<pg8::EpiUp, pg8::StaticOrder, true, true>(lds + RING_OFF, g, S, E); }
        { PHASE_IDS();
          for (int it = wave * G + bx; it < 8 * 64; it += NGW) { const int row0 = NP + (it >> 6) * 16, col0 = (it & 63) * 64;
              const SkUp E{PSS, Hb};
              skinny_unit<1, 4>(X1b, 1024, WupT, 1024, 1024, row0, col0, E, lane); } }
        if (BOTH(7)) GRID_BAR();
    }

    if (IN(8)) for (int rep = 0; rep < REP(8); ++rep) {
        { pg8::Gemm g{Hb, WdnT, NP, DM, DFF, DFF, DFF}; pg8::StaticOrder S; S.init(NP, DM, G, bx);
          pg8::EpiDownNorm E{X1b, out, (const float*)args.in[27], (float*)(ws + WS_PSS2), (unsigned*)(ctl + CW_PANEL), (unsigned*)(ctl + CW_TMO)};
          pg8::gemm_phase<pg8::EpiDownNorm, pg8::StaticOrder, true, true>(lds + RING_OFF, g, S, E); }
        { PHASE_IDS();
          for (int it = wave * G + bx; it < 8 * 16 * 8; it += NGW) { const int kp = it & 7, cgp = (it >> 3) & 15, row0 = NP + (it >> 7) * 16;
              const SkPart E{PD + (size_t)kp * NSMP * 1024 - (size_t)NP * 1024};
              skinny_unit<1, 4>(Hb + kp * 512, 4096, WdnT + kp * 512, 4096, 512, row0, cgp * 64, E, lane); } }
        if (BOTH(8)) GRID_BAR();
    }

#ifdef DBG_DUMP
    if (lo <= 9 && 9 < hi) {
        PHASE_IDS();
        for (int m = gw; m < NP + NSMP; m += NGW) { GAS f32x4* o = (GAS f32x4*)(out + O_YP + (size_t)m * DM) + lane;
#pragma unroll
            for (int j = 0; j < 4; ++j) { const int col = (lane + 64 * j) * 4; f32x4 v;
#if DBG_DUMP == 1
                const v2u w = *(const GAS v2u*)(Mb + (size_t)m * 1024 + col); v = (f32x4){bflo(w.x), bfhi(w.x), bflo(w.y), bfhi(w.y)};
#elif DBG_DUMP == 2
                v = *(const GAS f32x4*)(X1 + (size_t)m * 1024 + col);
#elif DBG_DUMP == 5
                if (col < 512) { const v2u w = *(const GAS v2u*)(Cb + (size_t)m * 512 + col); v = (f32x4){bflo(w.x), bfhi(w.x), bflo(w.y), bfhi(w.y)}; } else { const v2u w = *(const GAS v2u*)(Qb + (size_t)m * 512 + col - 512); v = (f32x4){bflo(w.x), bfhi(w.x), bflo(w.y), bfhi(w.y)}; }
#elif DBG_DUMP == 6
                { const v2u w = *(const GAS v2u*)(GAB + (size_t)m * 2048 + col); v = (f32x4){bflo(w.x), bfhi(w.x), bflo(w.y), bfhi(w.y)}; }
#elif DBG_DUMP == 7
                { const v2u w = *(const GAS v2u*)(GAB + (size_t)m * 2048 + 1024 + col); v = (f32x4){bflo(w.x), bfhi(w.x), bflo(w.y), bfhi(w.y)}; }
#elif DBG_DUMP == 3
                const v2u w = *(const GAS v2u*)(Hb + (size_t)m * 4096 + col); v = (f32x4){bflo(w.x), bfhi(w.x), bflo(w.y), bfhi(w.y)};
#else
                v = *(const GAS f32x4*)(M1 + (size_t)m * 1024 + col);
#endif
                o[64 * j] = v; } }
    }
#endif
    if (IN(9)) {
        PHASE_IDS();
        const float* g_final = (const float*)args.in[27];
        for (int m = NP + wave * G + bx; m < NP + NSMP; m += NGW) { GAS f32x4* xr = (GAS f32x4*)(out + O_YP + (size_t)m * DM) + lane; const GAS f32x4* gr = (const GAS f32x4*)g_final + lane;
            f32x4 v[4]; float s = 0.f;
            if (m >= NP) {
#pragma unroll
                for (int j = 0; j < 4; ++j) { v[j] = ((const GAS f32x4*)(X1 + (size_t)m * DM) + lane)[64 * j];
#pragma unroll
                    for (int kp = 0; kp < 8; ++kp) v[j] += ((const GAS f32x4*)(PD + ((size_t)kp * NSMP + (m - NP)) * DM) + lane)[64 * j]; }
            } else {
#pragma unroll
                for (int j = 0; j < 4; ++j) v[j] = xr[64 * j];
            }
#pragma unroll
            for (int j = 0; j < 4; ++j) s += (v[j].x * v[j].x + v[j].y * v[j].y) + (v[j].z * v[j].z + v[j].w * v[j].w);
            const float rstd = 1.f / sqrtf(wave_sum(s) * (1.f / 1024.f) + RMS_EPS);
#pragma unroll
            for (int j = 0; j < 4; ++j) xr[64 * j] = v[j] * rstd * gr[64 * j]; }
    }
#undef IN
#undef BOTH
}

extern "C" void kernel_launch(void* const* d_in, const int* in_sizes, int n_in, void* d_out, int out_size, void* d_ws, size_t ws_size, hipStream_t stream) {
    static int grid = 0;
    if (grid == 0) {
        if (n_in != 28 || out_size != (int)O_END || ws_size < WS_END) { fprintf(stderr, "kernel_launch: unexpected problem: n_in %d out %d ws %zu (need %zu)\n", n_in, out_size, ws_size, (size_t)WS_END); grid = -1; return; }
        int dev = 0, cus = 0, per_cu = 0;
        if (hipGetDevice(&dev) != hipSuccess || hipDeviceGetAttribute(&cus, hipDeviceAttributeMultiprocessorCount, dev) != hipSuccess) { grid = -1; return; }
        if (hipFuncSetAttribute((const void*)nsa_fwd, hipFuncAttributeMaxDynamicSharedMemorySize, LDS_BYTES) != hipSuccess) { fprintf(stderr, "kernel_launch: hipFuncSetAttribute failed\n"); grid = -1; return; }
        if (hipOccupancyMaxActiveBlocksPerMultiprocessor(&per_cu, (const void*)nsa_fwd, NWAVES * 64, LDS_BYTES) != hipSuccess || per_cu < 1) { fprintf(stderr, "kernel_launch: occupancy query says %d workgroups per CU\n", per_cu); }
        (void)hipGetLastError();
        grid = cus;
    }
    if (grid < 0) return;
    if (hipMemsetAsync((char*)d_ws + WS_CTL, 0, CTL_ZERO_BYTES, stream) != hipSuccess) return;
    Args a{};
    for (int i = 0; i < 28; ++i) a.in[i] = d_in[i];
    a.out = (float*)d_out; a.ws = (unsigned char*)d_ws;
#if MK_N_LAUNCHES == 1
    a.ph_lo = 0; a.ph_hi = N_PHASES;
    hipLaunchKernelGGL(nsa_fwd, dim3(grid), dim3(NWAVES * 64), LDS_BYTES, stream, a);
#else
    for (int p = 0; p < N_PHASES; ++p) { a.ph_lo = p; a.ph_hi = p + 1; hipLaunchKernelGGL(nsa_fwd, dim3(grid), dim3(NWAVES * 64), LDS_BYTES, stream, a); }
#endif
}
```

```cpp
#include <hip/hip_runtime.h>
#include <cstdio>
#include <cstdint>

#ifndef MK_N_LAUNCHES
#define MK_N_LAUNCHES 1
#endif

constexpr int DM = 1024, BATCH = 2, SEQ = 8192, NP = BATCH * SEQ;
constexpr int DECB = 32, DECS = 4, NSMP = DECB * DECS;
constexpr int MTOK = NP + 256;
constexpr int PAST = 16384, PAGE = 128, NPAGE = PAST / PAGE, NPHYS = 5120;
constexpr int NH = 8, HD = 64, NKV = 2, GRP = 4, NSAW = 512, KVW = 128;
constexpr int CMPH = 256, DFF = 4096, CONVD = 512, INCOLS = 4888, NIN = 5120;
constexpr int WINL = 512, NSEL = 16;
constexpr float RMS_EPS = 1e-6f;
constexpr float LOG2E = 1.4426950408889634f;
constexpr float QSCALE = 0.125f * LOG2E;

constexpr size_t O_YP = 0, O_YS = O_YP + (size_t)NP * DM;
constexpr size_t O_PCK = O_YS + (size_t)NSMP * DM, O_PCV = O_PCK + (size_t)NP * KVW, O_PSK = O_PCV + (size_t)NP * KVW, O_PSV = O_PSK + (size_t)NP * KVW;
constexpr size_t O_PWK = O_PSV + (size_t)NP * KVW, O_PWV = O_PWK + (size_t)BATCH * WINL * KVW, O_PCONV = O_PWV + (size_t)BATCH * WINL * KVW;
constexpr size_t O_SCK = O_PCONV + (size_t)BATCH * 2 * CONVD, O_SCV = O_SCK + (size_t)NSMP * KVW, O_SSK = O_SCV + (size_t)NSMP * KVW, O_SSV = O_SSK + (size_t)NSMP * KVW;
constexpr size_t O_SWK = O_SSV + (size_t)NSMP * KVW, O_SWV = O_SWK + (size_t)DECB * WINL * KVW, O_SCONV = O_SWV + (size_t)DECB * WINL * KVW;
constexpr size_t O_END = O_SCONV + (size_t)DECB * 2 * CONVD;
static_assert(O_END == 29853696, "d_out map");

constexpr size_t MiB = 1u << 20;
constexpr size_t WS_CTL = 0, CTL_ZERO_BYTES = 1 * MiB;
constexpr size_t WS_WIN = 2 * MiB;
constexpr size_t WS_WNSA = 12 * MiB;
constexpr size_t WS_WCONV = 13 * MiB;
constexpr size_t WS_WO = 14 * MiB;
constexpr size_t WS_WUP = 16 * MiB;
constexpr size_t WS_WDN = 24 * MiB;
constexpr size_t WS_W1K = 32 * MiB, WS_W1V = 33 * MiB;
constexpr size_t WS_W2K = 34 * MiB, WS_W2V = 34 * MiB + 65536;
constexpr size_t WS_PE = 34 * MiB + 131072;
constexpr size_t WS_XN = 36 * MiB;
constexpr size_t WS_QB = 70 * MiB;
constexpr size_t WS_CV = 88 * MiB;
constexpr size_t WS_GAB = 138 * MiB;
constexpr size_t WS_GN = 204 * MiB;
constexpr size_t WS_CKP = 208 * MiB, WS_KSP = 213 * MiB, WS_KWP = 218 * MiB;
constexpr size_t WS_CVP = 223 * MiB, WS_VTS = 228 * MiB, WS_VTW = 233 * MiB;
constexpr size_t KV3_STRIDE = 5 * MiB;
constexpr size_t WS_GP = 238 * MiB;
constexpr size_t WS_KCP = 240 * MiB;
constexpr size_t WS_VCTP = 241 * MiB;
constexpr size_t WS_AB = 242 * MiB;
constexpr size_t WS_CB = 259 * MiB;
constexpr size_t WS_M1 = 276 * MiB;
constexpr size_t WS_MB = 342 * MiB;
constexpr size_t WS_X1 = 375 * MiB;
constexpr size_t WS_X1B = 441 * MiB;
constexpr size_t WS_PSS = 474 * MiB;
constexpr size_t WS_H = 476 * MiB;
constexpr size_t WS_CKS = 608 * MiB, WS_CVS = 738 * MiB;
constexpr size_t WS_GS = 868 * MiB;
constexpr size_t WS_KCS = 932 * MiB, WS_VCS = 948 * MiB;
constexpr size_t WS_KWS = 964 * MiB, WS_VTWS = 970 * MiB;
constexpr size_t WS_PD = 976 * MiB;
constexpr size_t WS_PSS2 = 982 * MiB;
constexpr size_t WS_END = 984 * MiB;
constexpr int CW_TMO = 0, CW_QUEUE = 64, CW_BAR = 4096, CW_PANEL = 32768;

constexpr int RING_OFF = 0, RING_BYTES = 131072;
constexpr int LUT_OFF = RING_BYTES, LUT_BYTES = 4096;
constexpr int WSCR_OFF = LUT_OFF + LUT_BYTES, WSCR_BYTES = 2304;
constexpr int LDSCTL_OFF = WSCR_OFF + 8 * WSCR_BYTES, MISC_OFF = LDSCTL_OFF + 320;
constexpr int LDS_BYTES = 155648;
static_assert(MISC_OFF + 128 <= LDS_BYTES && LDS_BYTES <= 163840, "LDS map");
constexpr int NWAVES = 8;
#ifndef W_IN_R0
#define W_IN_R0 7
#endif

namespace pg8 {
#define PG8_LAS __attribute__((address_space(3)))
typedef unsigned short bf16_t;
typedef short bf16x8 __attribute__((ext_vector_type(8)));
typedef float f32x4 __attribute__((ext_vector_type(4)));
typedef unsigned u32x4 __attribute__((ext_vector_type(4)));
constexpr int BM = 256, BK = 64, HALF = 128, HTB = HALF * BK * 2  , STAGE_BYTES = 8 * HTB, NXCD = 8, WGM = 8;

__host__ __device__ __forceinline__ int lds_byte(int r, int c) { const int st = (r >> 4) * 2 + (c >> 5), rr = r & 15, cc = c & 31, ob = rr * 64 + cc * 2; return st * 1024 + (ob ^ (((ob >> 9) & 1) << 5)); }
__host__ __device__ __forceinline__ void stage_rc(int b, int& R, int& C) { const int st = b / 1024, sb = b % 1024, swz = sb ^ (((sb >> 9) & 1) << 5); R = (st >> 1) * 16 + swz / 64; C = (st & 1) * 32 + (swz % 64) / 2; }
__host__ __device__ __forceinline__ int perm32(int rho) { const int n = rho >> 4, i = rho & 15; return 8 * (i >> 2) + 4 * n + (i & 3); }

struct Unit { int pm, pn, aoff; };
struct Gemm { const bf16_t* A; const bf16_t* Bt; int M, N, K, lda, ldb; };

struct StaticOrder {
    int nM, nN, nwg, G, c;
    __host__ __device__ void init(int M, int N, int G_, int c_) { nM = M / BM; nN = N / BM; nwg = nM * nN; G = G_; c = c_; }
    __host__ __device__ __forceinline__ bool next(int i, Unit& u) const {
        const long L = (long)i * G + c; if (L >= nwg) return false;
        int wgid = (int)L; { const int q = nwg / NXCD, r = nwg % NXCD, xcd = wgid % NXCD, off = wgid / NXCD; wgid = (xcd < r ? xcd * (q + 1) : r * (q + 1) + (xcd - r) * q) + off; }
        const int nig = WGM * nN, gid = wgid / nig, fm = gid * WGM, gsz = (nM - fm) < WGM ? (nM - fm) : WGM;
        u.pm = fm + ((wgid % nig) % gsz); u.pn = (wgid % nig) / gsz; u.aoff = 0; return true;
    }
    __device__ __forceinline__ void a_ready(const Unit&) const {}
    __device__ __forceinline__ void done(const Unit&) const {}
};

typedef float f32x2_t __attribute__((ext_vector_type(2)));
typedef __bf16 bf16x2_t __attribute__((ext_vector_type(2)));
__device__ __forceinline__ unsigned cvt_pk_bf16(float lo, float hi) { f32x2_t v = {lo, hi}; bf16x2_t b = __builtin_convertvector(v, bf16x2_t); return __builtin_bit_cast(unsigned, b); }
struct MixedOrder {
    int nM, nN, nwg, c, R0; bool conv;
    __host__ __device__ void init(int M, int N, int c_, int R0_) { nM = M / BM; nN = N / BM; nwg = nM * nN; c = c_; R0 = R0_; conv = (c_ & 1) == 0; }
    __host__ __device__ __forceinline__ bool next(int i, Unit& u) const {
        const long L = conv ? (long)R0 * 128 + (long)i * 256 + c : (i < R0 ? (long)i * 128 + (c >> 1) : (long)R0 * 128 + (long)(i - R0) * 256 + c);
        if (L >= nwg) return false;
        int wgid = (int)L; { const int q = nwg / NXCD, r = nwg % NXCD, xcd = wgid % NXCD, off = wgid / NXCD; wgid = (xcd < r ? xcd * (q + 1) : r * (q + 1) + (xcd - r) * q) + off; }
        const int nig = WGM * nN, gid = wgid / nig, fm = gid * WGM, gsz = (nM - fm) < WGM ? (nM - fm) : WGM;
        u.pm = fm + ((wgid % nig) % gsz); u.pn = (wgid % nig) / gsz; u.aoff = 0; return true;
    }
    __device__ __forceinline__ void a_ready(const Unit&) const {}
    __device__ __forceinline__ void done(const Unit&) const {}
};
typedef unsigned u32x2 __attribute__((ext_vector_type(2)));
__device__ __forceinline__ float sigmoid_f(float x) { return __builtin_amdgcn_rcpf(1.f + __builtin_amdgcn_exp2f(x * -1.4426950408889634f)); }
__device__ __forceinline__ float gelu_tanh_f(float x) {
    const float u2 = x * (1.5957691216057308f + 0.07135481627263f * x * x);
    return x * __builtin_amdgcn_rcpf(1.f + __builtin_amdgcn_exp2f(u2 * -1.4426950408889634f));
}
__device__ __forceinline__ float bf2f(unsigned short h) { return __builtin_bit_cast(float, (unsigned)h << 16); }
__device__ __forceinline__ float bflo(unsigned w) { return __builtin_bit_cast(float, w << 16); }
__device__ __forceinline__ float bfhi(unsigned w) { return __builtin_bit_cast(float, w & 0xffff0000u); }
__device__ __forceinline__ unsigned short f2bf_rne(float f) { unsigned u = __builtin_bit_cast(unsigned, f); return (unsigned short)((u + 0x7fffu + ((u >> 16) & 1u)) >> 16); }
__device__ __forceinline__ u32x4 pack8(const f32x4& a, const f32x4& b) { u32x4 w; w.x = cvt_pk_bf16(a[0], a[1]); w.y = cvt_pk_bf16(a[2], a[3]); w.z = cvt_pk_bf16(b[0], b[1]); w.w = cvt_pk_bf16(b[2], b[3]); return w; }
__device__ __forceinline__ int kperm64(int k) { return (k & 32) + 8 * ((k >> 2) & 3) + 4 * ((k >> 4) & 1) + (k & 3); }
__device__ __forceinline__ int ktile_off(int key, int d) { return ((key >> 4) * 2 + (d >> 5)) * 512 + (((d >> 3) & 3) * 16 + (key & 15)) * 8 + (d & 7); }
__device__ __forceinline__ int vtile_off(int key, int d) { const int p = kperm64(key); return ((d >> 4) * 2 + (p >> 5)) * 512 + (((p >> 3) & 3) * 16 + (d & 15)) * 8 + (p & 7); }

#ifdef DBG_NO_SIG
#define SIGF(x) (x)
#else
#define SIGF(x) sigmoid_f(x)
#endif
__device__ __forceinline__ int vtile8_off(int key, int d) { const int p = kperm64(key); return ((d >> 4) * 64 + ((p >> 3) & 3) * 16 + (d & 15)) * 16 + (p >> 5) * 8 + (p & 7); }
__device__ __forceinline__ int ktile8_off(int key, int d) { return ((key >> 4) * 64 + ((d >> 3) & 3) * 16 + (key & 15)) * 16 + (d >> 5) * 8 + (d & 7); }
__device__ __forceinline__ unsigned char f2fp8(float x) { return (unsigned char)(__builtin_amdgcn_cvt_pk_fp8_f32(x, 0.f, 0, false) & 0xff); }
struct EpiIn {
    static constexpr bool PERM = true, AFTER_DRAIN = false;
    __device__ __forceinline__ bool reset_acc(const Unit&) const { return true; }
    float* out; bf16_t *Qb, *CV, *GAB; float* GN; bf16_t *K3, *V3;
    __device__ __forceinline__ void operator()(const f32x4 (&acc)[2][2][4][2], const Unit& u, int wr, int wc, int fr, int fq) const {
        const int pn = u.pn, rbase = u.pm * BM + wr * 64 + fr, cw = wc * 32 + fq * 8;
        if (pn < 2) {
#pragma unroll
            for (int ai = 0; ai < 2; ++ai)
#pragma unroll
                for (int m = 0; m < 4; ++m) { const int row = rbase + ai * HALF + m * 16; bf16_t* p = Qb + (size_t)row * 512 + pn * 256 + cw;
#pragma unroll
                    for (int bj = 0; bj < 2; ++bj) *(u32x4*)(p + bj * HALF) = pack8(acc[ai][bj][m][0] * QSCALE, acc[ai][bj][m][1] * QSCALE); }
        } else if (pn < 5) {
            const int kvh = wc >> 1, d0 = cw & 63;
#pragma unroll
            for (int ai = 0; ai < 2; ++ai)
#pragma unroll
                for (int m = 0; m < 4; ++m) { const int row = rbase + ai * HALF + m * 16;
                    if (row < NP) {
                        const int b = row >> 13, t = row & (SEQ - 1);
                        float *fk, *fv;
                        if (pn == 2) { fk = out + O_PCK + (size_t)row * 128; fv = out + O_PCV + (size_t)row * 128; }
                        else if (pn == 3) { fk = out + O_PSK + (size_t)row * 128; fv = out + O_PSV + (size_t)row * 128; }
                        else { const bool w = t >= SEQ - WINL; const size_t o = (size_t)(b * WINL + (t - (SEQ - WINL))) * 128; fk = w ? out + O_PWK + o : nullptr; fv = w ? out + O_PWV + o : nullptr; }
                        if (fk) { *(f32x4*)(fk + cw) = acc[ai][0][m][0]; *(f32x4*)(fk + cw + 4) = acc[ai][0][m][1]; *(f32x4*)(fv + cw) = acc[ai][1][m][0]; *(f32x4*)(fv + cw + 4) = acc[ai][1][m][1]; }
                        bf16_t* kd = K3 + (size_t)(pn - 2) * (KV3_STRIDE / 2); bf16_t* vd = V3 + (size_t)(pn - 2) * (KV3_STRIDE / 2);
                        if (pn == 2) { const size_t ro = ((size_t)(b * 2 + kvh) * SEQ + t) * 64 + d0;
                            *(u32x4*)(kd + ro) = pack8(acc[ai][0][m][0], acc[ai][0][m][1]); *(u32x4*)(vd + ro) = pack8(acc[ai][1][m][0], acc[ai][1][m][1]); }
                        else { const size_t blk = ((size_t)(b * 2 + kvh) * 128 + (t >> 6)) * 4096;
                            { const f32x4 ka = acc[ai][0][m][0], kb = acc[ai][0][m][1]; int w0 = 0, w1 = 0;
                              w0 = __builtin_amdgcn_cvt_pk_fp8_f32(ka[0], ka[1], w0, false); w0 = __builtin_amdgcn_cvt_pk_fp8_f32(ka[2], ka[3], w0, true);
                              w1 = __builtin_amdgcn_cvt_pk_fp8_f32(kb[0], kb[1], w1, false); w1 = __builtin_amdgcn_cvt_pk_fp8_f32(kb[2], kb[3], w1, true);
                              u32x2 kw; kw.x = (unsigned)w0; kw.y = (unsigned)w1; *(u32x2*)((unsigned char*)(kd + blk) + ktile8_off(t & 63, d0)) = kw; }
                            unsigned char* vt = (unsigned char*)(vd + blk);
#pragma unroll
                            for (int n = 0; n < 2; ++n)
#pragma unroll
                                for (int i = 0; i < 4; ++i) vt[vtile8_off(t & 63, d0 + n * 4 + i)] = f2fp8(acc[ai][1][m][n][i]); }
                    } else if (row < NP + NSMP) {
                        const int tk = row - NP, bs = tk >> 2, s = tk & 3;
                        float *fk, *fv;
                        if (pn == 2) { fk = out + O_SCK + (size_t)tk * 128; fv = out + O_SCV + (size_t)tk * 128; }
                        else if (pn == 3) { fk = out + O_SSK + (size_t)tk * 128; fv = out + O_SSV + (size_t)tk * 128; }
                        else { const size_t o = (size_t)(bs * WINL + (WINL - DECS) + s) * 128; fk = out + O_SWK + o; fv = out + O_SWV + o; }
                        *(f32x4*)(fk + cw) = acc[ai][0][m][0]; *(f32x4*)(fk + cw + 4) = acc[ai][0][m][1]; *(f32x4*)(fv + cw) = acc[ai][1][m][0]; *(f32x4*)(fv + cw + 4) = acc[ai][1][m][1];
                    }
                }
        } else if (pn < 11) {
#pragma unroll
            for (int ai = 0; ai < 2; ++ai)
#pragma unroll
                for (int m = 0; m < 4; ++m) { const int row = rbase + ai * HALF + m * 16; bf16_t* p = CV + (size_t)row * 1536 + (pn - 5) * 256 + cw;
#pragma unroll
                    for (int bj = 0; bj < 2; ++bj) *(u32x4*)(p + bj * HALF) = pack8(acc[ai][bj][m][0], acc[ai][bj][m][1]); }
        } else if (pn < 19) {
#pragma unroll
            for (int ai = 0; ai < 2; ++ai)
#pragma unroll
                for (int m = 0; m < 4; ++m) { const int row = rbase + ai * HALF + m * 16; bf16_t* p = GAB + (size_t)row * 2048 + (pn - 11) * 256 + cw;
#pragma unroll
                    for (int bj = 0; bj < 2; ++bj) { f32x4 a = acc[ai][bj][m][0], b = acc[ai][bj][m][1];
#pragma unroll
                        for (int i = 0; i < 4; ++i) { a[i] = SIGF(a[i]); b[i] = SIGF(b[i]); }
                        *(u32x4*)(p + bj * HALF) = pack8(a, b); } }
        } else {
            if (wc == 0 && fq < 3) {
#pragma unroll
                for (int ai = 0; ai < 2; ++ai)
#pragma unroll
                    for (int m = 0; m < 4; ++m) { const int row = rbase + ai * HALF + m * 16; float* p = GN + (size_t)row * 32 + cw;
#pragma unroll
                        for (int n = 0; n < 2; ++n) { f32x4 a = acc[ai][0][m][n];
#pragma unroll
                            for (int i = 0; i < 4; ++i) a[i] = sigmoid_f(a[i]);
                            *(f32x4*)(p + 4 * n) = a; } }
            }
        }
    }
};

struct EpiCmp {
    static constexpr bool PERM = true, AFTER_DRAIN = false;
    __device__ __forceinline__ bool reset_acc(const Unit&) const { return true; }
    bf16_t* G; const float* pe; size_t gstride;
    __device__ __forceinline__ void operator()(const f32x4 (&acc)[2][2][4][2], const Unit& u, int wr, int wc, int fr, int fq) const {
        const int rbase = u.pm * BM + wr * 64 + fr, cw = wc * 32 + fq * 8; const float* pe = this->pe + u.pn * 256; bf16_t* G = this->G + (size_t)u.pn * gstride;
        f32x4 pv[2][2];
#pragma unroll
        for (int bj = 0; bj < 2; ++bj)
#pragma unroll
            for (int n = 0; n < 2; ++n) pv[bj][n] = *(const f32x4*)(pe + bj * HALF + cw + 4 * n);
#pragma unroll
        for (int ai = 0; ai < 2; ++ai)
#pragma unroll
            for (int m = 0; m < 4; ++m) { const int row = rbase + ai * HALF + m * 16; bf16_t* p = G + (size_t)row * 256 + cw;
#pragma unroll
                for (int bj = 0; bj < 2; ++bj) { f32x4 a = acc[ai][bj][m][0] + pv[bj][0], b = acc[ai][bj][m][1] + pv[bj][1];
#pragma unroll
                    for (int i = 0; i < 4; ++i) { a[i] = gelu_tanh_f(a[i]); b[i] = gelu_tanh_f(b[i]); }
                    *(u32x4*)(p + bj * HALF) = pack8(a, b); } }
    }
};

struct PairOrder {
    StaticOrder so; int npn, aoff;
    __host__ __device__ void init(int M, int N, int G_, int c_, int aoff_) { so.init(M, N, G_, c_); npn = N / BM; aoff = aoff_; }
    __host__ __device__ __forceinline__ bool next(int i, Unit& u) const { if (i >= 2 || !so.next(0, u)) return false; if (i == 1) { u.pn += npn; u.aoff = aoff; } return true; }
    __device__ __forceinline__ void a_ready(const Unit&) const {}
    __device__ __forceinline__ void done(const Unit&) const {}
};
struct EpiNC {
    static constexpr bool PERM = true, AFTER_DRAIN = false;
    const bf16_t* GAB; bf16_t* Mb;
    __device__ __forceinline__ bool reset_acc(const Unit& u) const { return u.pn >= 4; }
    __device__ __forceinline__ void operator()(f32x4 (&acc)[2][2][4][2], const Unit& u, int wr, int wc, int fr, int fq) const {
        const bool first = u.pn < 4; const int rbase = u.pm * BM + wr * 64 + fr, c0 = (u.pn & 3) * BM + wc * 32 + fq * 8;
#pragma unroll
        for (int ai = 0; ai < 2; ++ai)
#pragma unroll
            for (int m = 0; m < 4; ++m) { const int row = rbase + ai * HALF + m * 16;
#pragma unroll
                for (int bj = 0; bj < 2; ++bj) { const int col = c0 + bj * HALF; const u32x4 gb = *(const u32x4*)(GAB + (size_t)row * 2048 + 1024 + col);
                    float sb[8] = {bflo(gb.x), bfhi(gb.x), bflo(gb.y), bfhi(gb.y), bflo(gb.z), bfhi(gb.z), bflo(gb.w), bfhi(gb.w)};
                    if (first) { const u32x4 ga = *(const u32x4*)(GAB + (size_t)row * 2048 + col);
                        const float sa[8] = {bflo(ga.x), bfhi(ga.x), bflo(ga.y), bfhi(ga.y), bflo(ga.z), bfhi(ga.z), bflo(ga.w), bfhi(ga.w)};
#pragma unroll
                        for (int i = 0; i < 4; ++i) { acc[ai][bj][m][0][i] *= sa[i] * __builtin_amdgcn_rcpf(sb[i]); acc[ai][bj][m][1][i] *= sa[4 + i] * __builtin_amdgcn_rcpf(sb[4 + i]); }
                    } else { f32x4 a = acc[ai][bj][m][0], b = acc[ai][bj][m][1];
#pragma unroll
                        for (int i = 0; i < 4; ++i) { a[i] *= sb[i]; b[i] *= sb[4 + i]; }
                        *(u32x4*)(Mb + (size_t)row * 1024 + col) = pack8(a, b); } } }
    }
};
struct EpiNsa {
    static constexpr bool PERM = true, AFTER_DRAIN = false;
    __device__ __forceinline__ bool reset_acc(const Unit&) const { return true; }
    float* M1; const bf16_t* GAB;
    __device__ __forceinline__ void operator()(const f32x4 (&acc)[2][2][4][2], const Unit& u, int wr, int wc, int fr, int fq) const {
        const int rbase = u.pm * BM + wr * 64 + fr, c0 = u.pn * BM + wc * 32 + fq * 8;
#pragma unroll
        for (int ai = 0; ai < 2; ++ai)
#pragma unroll
            for (int m = 0; m < 4; ++m) { const int row = rbase + ai * HALF + m * 16;
#pragma unroll
                for (int bj = 0; bj < 2; ++bj) { const int col = c0 + bj * HALF; const u32x4 g = *(const u32x4*)(GAB + (size_t)row * 2048 + col);
                    f32x4 a = acc[ai][bj][m][0], b = acc[ai][bj][m][1];
                    a[0] *= bflo(g.x); a[1] *= bfhi(g.x); a[2] *= bflo(g.y); a[3] *= bfhi(g.y); b[0] *= bflo(g.z); b[1] *= bfhi(g.z); b[2] *= bflo(g.w); b[3] *= bfhi(g.w);
                    float* p = M1 + (size_t)row * 1024 + col; *(f32x4*)p = a; *(f32x4*)(p + 4) = b; } }
    }
};
struct EpiConv {
    static constexpr bool PERM = true, AFTER_DRAIN = false;
    __device__ __forceinline__ bool reset_acc(const Unit&) const { return true; }
    const float* M1; const bf16_t* GAB; bf16_t* Mb;
    __device__ __forceinline__ void operator()(const f32x4 (&acc)[2][2][4][2], const Unit& u, int wr, int wc, int fr, int fq) const {
        const int rbase = u.pm * BM + wr * 64 + fr, c0 = u.pn * BM + wc * 32 + fq * 8;
#pragma unroll
        for (int ai = 0; ai < 2; ++ai)
#pragma unroll
            for (int m = 0; m < 4; ++m) { const int row = rbase + ai * HALF + m * 16;
#pragma unroll
                for (int bj = 0; bj < 2; ++bj) { const int col = c0 + bj * HALF; const u32x4 g = *(const u32x4*)(GAB + (size_t)row * 2048 + 1024 + col);
                    const float* p = M1 + (size_t)row * 1024 + col;
#ifdef DBG_NO_M1
                    f32x4 a = (f32x4){0.f, 0.f, 0.f, 0.f}, b = a; (void)p;
#else
                    f32x4 a = *(const f32x4*)p, b = *(const f32x4*)(p + 4);
#endif
                    const f32x4 x = acc[ai][bj][m][0], y = acc[ai][bj][m][1];
                    a[0] += x[0] * bflo(g.x); a[1] += x[1] * bfhi(g.x); a[2] += x[2] * bflo(g.y); a[3] += x[3] * bfhi(g.y); b[0] += y[0] * bflo(g.z); b[1] += y[1] * bfhi(g.z); b[2] += y[2] * bflo(g.w); b[3] += y[3] * bfhi(g.w);
                    *(u32x4*)(Mb + (size_t)row * 1024 + col) = pack8(a, b); } }
    }
};
struct EpiWo {
    static constexpr bool PERM = true, AFTER_DRAIN = false;
    __device__ __forceinline__ bool reset_acc(const Unit&) const { return true; }
    const float *xp, *xs; float* X1; bf16_t* X1b; float* PSS;
    __device__ __forceinline__ void operator()(const f32x4 (&acc)[2][2][4][2], const Unit& u, int wr, int wc, int fr, int fq) const {
        const int rbase = u.pm * BM + wr * 64 + fr, c0 = u.pn * BM + wc * 32 + fq * 8;
#pragma unroll
        for (int ai = 0; ai < 2; ++ai)
#pragma unroll
            for (int m = 0; m < 4; ++m) { const int row = rbase + ai * HALF + m * 16;
                const float* xr = row < NP ? xp + (size_t)row * 1024 : (row < NP + NSMP ? xs + (size_t)(row - NP) * 1024 : nullptr);
                float ss = 0.f;
#pragma unroll
                for (int bj = 0; bj < 2; ++bj) { const int col = c0 + bj * HALF;
                    f32x4 a = acc[ai][bj][m][0], b = acc[ai][bj][m][1];
                    if (xr) { a += *(const f32x4*)(xr + col); b += *(const f32x4*)(xr + col + 4); }
                    *(u32x4*)(X1b + (size_t)row * 1024 + col) = pack8(a, b);
                    ss += (a[0] * a[0] + a[1] * a[1]) + (a[2] * a[2] + a[3] * a[3]) + (b[0] * b[0] + b[1] * b[1]) + (b[2] * b[2] + b[3] * b[3]); }
                ss += __shfl_xor(ss, 16); ss += __shfl_xor(ss, 32);
                if (fq == 0) PSS[(size_t)row * 16 + u.pn * 4 + wc] = ss; }
    }
};
struct EpiUp {
    static constexpr bool PERM = true, AFTER_DRAIN = false;
    __device__ __forceinline__ bool reset_acc(const Unit&) const { return true; }
    const float* PSS; bf16_t* H;
    __device__ __forceinline__ void operator()(const f32x4 (&acc)[2][2][4][2], const Unit& u, int wr, int wc, int fr, int fq) const {
        const int rbase = u.pm * BM + wr * 64 + fr, c0 = u.pn * BM + wc * 32 + fq * 8;
#pragma unroll
        for (int ai = 0; ai < 2; ++ai)
#pragma unroll
            for (int m = 0; m < 4; ++m) { const int row = rbase + ai * HALF + m * 16;
                const f32x4* ps = (const f32x4*)(PSS + (size_t)row * 16); const f32x4 s0 = ps[0], s1 = ps[1], s2 = ps[2], s3 = ps[3];
                const float ssum = (((s0[0] + s0[1]) + (s0[2] + s0[3])) + ((s1[0] + s1[1]) + (s1[2] + s1[3]))) + (((s2[0] + s2[1]) + (s2[2] + s2[3])) + ((s3[0] + s3[1]) + (s3[2] + s3[3])));
                const float rstd = __builtin_amdgcn_rsqf(ssum * (1.f / 1024.f) + RMS_EPS);
#pragma unroll
                for (int bj = 0; bj < 2; ++bj) { f32x4 a = acc[ai][bj][m][0] * rstd, b = acc[ai][bj][m][1] * rstd;
#pragma unroll
                    for (int i = 0; i < 4; ++i) { a[i] = a[i] > 0.f ? a[i] * a[i] : 0.f; b[i] = b[i] > 0.f ? b[i] * b[i] : 0.f; }
                    *(u32x4*)(H + (size_t)row * 4096 + c0 + bj * HALF) = pack8(a, b); } }
    }
};
struct EpiDownNorm {
    static constexpr bool PERM = true, AFTER_DRAIN = false;
    __device__ __forceinline__ bool reset_acc(const Unit&) const { return true; }
    const bf16_t* X1b; float* out; const float* gf; float* PSS2; unsigned* cnt; unsigned* tmo;
    __device__ __forceinline__ void operator()(f32x4 (&acc)[2][2][4][2], const Unit& u, int wr, int wc, int fr, int fq) const {
        const int rbase = u.pm * BM + wr * 64 + fr, c0 = u.pn * BM + wc * 32 + fq * 8;
#pragma unroll
        for (int ai = 0; ai < 2; ++ai)
#pragma unroll
            for (int m = 0; m < 4; ++m) { const int row = rbase + ai * HALF + m * 16; float ss = 0.f;
#pragma unroll
                for (int bj = 0; bj < 2; ++bj) { const int col = c0 + bj * HALF; const u32x4 g = *(const u32x4*)(X1b + (size_t)row * 1024 + col);
                    f32x4 a = acc[ai][bj][m][0], b = acc[ai][bj][m][1];
                    a[0] += bflo(g.x); a[1] += bfhi(g.x); a[2] += bflo(g.y); a[3] += bfhi(g.y); b[0] += bflo(g.z); b[1] += bfhi(g.z); b[2] += bflo(g.w); b[3] += bfhi(g.w);
                    acc[ai][bj][m][0] = a; acc[ai][bj][m][1] = b;
                    ss += (a[0] * a[0] + a[1] * a[1]) + (a[2] * a[2] + a[3] * a[3]) + (b[0] * b[0] + b[1] * b[1]) + (b[2] * b[2] + b[3] * b[3]); }
                ss += __shfl_xor(ss, 16); ss += __shfl_xor(ss, 32);
                if (fq == 0) __hip_atomic_store(PSS2 + (size_t)row * 16 + u.pn * 4 + wc, ss, __ATOMIC_RELAXED, __HIP_MEMORY_SCOPE_AGENT); }
        asm volatile("s_waitcnt vmcnt(0)" ::: "memory");
        unsigned* c = cnt + 64 * u.pm;
        if ((threadIdx.x & 63) == 0) {
            (void)__hip_atomic_fetch_add(c, 1u, __ATOMIC_RELAXED, __HIP_MEMORY_SCOPE_AGENT);
            unsigned sp = 0;
            while (__hip_atomic_load(c, __ATOMIC_RELAXED, __HIP_MEMORY_SCOPE_AGENT) < 32u) { __builtin_amdgcn_s_sleep(1);
                if (++sp > (1u << 22)) { __hip_atomic_store(tmo, 1u, __ATOMIC_RELAXED, __HIP_MEMORY_SCOPE_AGENT); break; } }
        }
        __builtin_amdgcn_fence(__ATOMIC_ACQUIRE, "agent");
        asm volatile("s_waitcnt vmcnt(0)" ::: "memory");
#pragma unroll
        for (int ai = 0; ai < 2; ++ai)
#pragma unroll
            for (int m = 0; m < 4; ++m) { const int row = rbase + ai * HALF + m * 16;
                const f32x4* ps = (const f32x4*)(PSS2 + (size_t)row * 16); const f32x4 s0 = ps[0], s1 = ps[1], s2 = ps[2], s3 = ps[3];
                const float ssum = (((s0[0] + s0[1]) + (s0[2] + s0[3])) + ((s1[0] + s1[1]) + (s1[2] + s1[3]))) + (((s2[0] + s2[1]) + (s2[2] + s2[3])) + ((s3[0] + s3[1]) + (s3[2] + s3[3])));
                const float rstd = 1.f / sqrtf(ssum * (1.f / 1024.f) + RMS_EPS);
                float* orow = out + O_YP + (size_t)row * 1024;
#pragma unroll
                for (int bj = 0; bj < 2; ++bj) { const int col = c0 + bj * HALF; const f32x4 g0 = *(const f32x4*)(gf + col), g1 = *(const f32x4*)(gf + col + 4);
                    *(f32x4*)(orow + col) = acc[ai][bj][m][0] * rstd * g0; *(f32x4*)(orow + col + 4) = acc[ai][bj][m][1] * rstd * g1; } }
    }
};
struct EpiDown {
    static constexpr bool PERM = true, AFTER_DRAIN = false;
    __device__ __forceinline__ bool reset_acc(const Unit&) const { return true; }
    const bf16_t* X1b; float* out;
    __device__ __forceinline__ void operator()(const f32x4 (&acc)[2][2][4][2], const Unit& u, int wr, int wc, int fr, int fq) const {
        const int rbase = u.pm * BM + wr * 64 + fr, c0 = u.pn * BM + wc * 32 + fq * 8;
#pragma unroll
        for (int ai = 0; ai < 2; ++ai)
#pragma unroll
            for (int m = 0; m < 4; ++m) { const int row = rbase + ai * HALF + m * 16;
                if (row < NP) { float* orow = out + O_YP + (size_t)row * 1024;
#pragma unroll
                    for (int bj = 0; bj < 2; ++bj) { const int col = c0 + bj * HALF; const u32x4 g = *(const u32x4*)(X1b + (size_t)row * 1024 + col);
                        f32x4 a = acc[ai][bj][m][0], b = acc[ai][bj][m][1];
                        a[0] += bflo(g.x); a[1] += bfhi(g.x); a[2] += bflo(g.y); a[3] += bfhi(g.y); b[0] += bflo(g.z); b[1] += bfhi(g.z); b[2] += bflo(g.w); b[3] += bfhi(g.w);
                        *(f32x4*)(orow + col) = a; *(f32x4*)(orow + col + 4) = b; } } }
    }
};
template <class Epi, class Sched, bool ALIGN_EPI = false, bool SP2 = false>
__device__ __forceinline__ void gemm_phase(PG8_LAS unsigned char* lds, const Gemm g, const Sched& S, const Epi& E) {
    const int tid = threadIdx.x, wid = __builtin_amdgcn_readfirstlane(tid >> 6), lane = tid & 63, wr = wid >> 2, wc = wid & 3, fr = lane & 15, fq = lane >> 4;
    const int K = g.K, nt = K / BK;
    unsigned voffA[2], voffB[2];
#pragma unroll
    for (int i = 0; i < 2; ++i) { int R, C; stage_rc(tid * 16 + i * 8192, R, C); const int Rb = Epi::PERM ? ((R & ~31) + perm32(R & 31)) : R;
        voffA[i] = (unsigned)(R * g.lda + C) * 2u; voffB[i] = (unsigned)(Rb * g.ldb + C) * 2u; }
    const size_t kstep = (size_t)(BK * 2);
    const size_t hstepA = (size_t)HALF * g.lda * 2, hstepB = (size_t)HALF * g.ldb * 2;
    const size_t tstepA = 2 * hstepA, tstepB = 2 * hstepB;
    const unsigned ldsw = (unsigned)wid * 1024u;
    const int aoff = lds_byte(wr * 64 + fr, fq * 8), boff = lds_byte(wc * 32 + fr, fq * 8);
#define PG8_SA(b, h) (((b) * 2 + (h)) * HTB)
#define PG8_SB(b, h) ((4 + (b) * 2 + (h)) * HTB)
#define PG8_STAGE(bufoff, gbase, voff) do { _Pragma("unroll") for (int _i = 0; _i < 2; ++_i) \
        __builtin_amdgcn_global_load_lds((const unsigned*)((const char*)(gbase) + (voff)[_i]), (PG8_LAS unsigned*)(lds + (bufoff) + ldsw + _i * 8192), 16, 0, 0); } while (0)
#define PG8_LDA(dst, b, h) do { _Pragma("unroll") for (int m = 0; m < 4; ++m) _Pragma("unroll") for (int k = 0; k < 2; ++k) dst[m][k] = *(const PG8_LAS bf16x8*)(lds + PG8_SA(b, h) + aoff + m * 2048 + k * 1024); } while (0)
#define PG8_LDB(dst, b, h) do { _Pragma("unroll") for (int n = 0; n < 2; ++n) _Pragma("unroll") for (int k = 0; k < 2; ++k) dst[n][k] = *(const PG8_LAS bf16x8*)(lds + PG8_SB(b, h) + boff + n * 2048 + k * 1024); } while (0)
#define PG8_MMA(ai, bj, At, Bt) do { __builtin_amdgcn_s_setprio(1); _Pragma("unroll") for (int m = 0; m < 4; ++m) _Pragma("unroll") for (int n = 0; n < 2; ++n) _Pragma("unroll") for (int k = 0; k < 2; ++k) \
        acc[ai][bj][m][n] = __builtin_amdgcn_mfma_f32_16x16x32_bf16(Bt[n][k], At[m][k], acc[ai][bj][m][n], 0, 0, 0); __builtin_amdgcn_s_setprio(0); } while (0)
#define PG8_WAIT_V(n) asm volatile("s_waitcnt vmcnt(" #n ")" ::: "memory")
#define PG8_WAIT_L(n) asm volatile("s_waitcnt lgkmcnt(" #n ")" ::: "memory")
#define PG8_BAR __builtin_amdgcn_s_barrier()
#define PG8_SCHED __builtin_amdgcn_sched_barrier(0)
    Unit cur, nxt; int ui = 0;
    if (!S.next(0, cur)) return;
    f32x4 acc[2][2][4][2];
#pragma unroll
    for (int a = 0; a < 2; ++a)
#pragma unroll
        for (int b = 0; b < 2; ++b)
#pragma unroll
            for (int m = 0; m < 4; ++m)
#pragma unroll
                for (int n = 0; n < 2; ++n) acc[a][b][m][n] = (f32x4){0.f, 0.f, 0.f, 0.f};
    bf16x8 At[4][2], B0[2][2], B1[2][2];
    const char* cA = (const char*)g.A + (size_t)cur.pm * tstepA + cur.aoff; const char* cB = (const char*)g.Bt + (size_t)cur.pn * tstepB;
    S.a_ready(cur);
    if constexpr (SP2) {
        PG8_STAGE(PG8_SB(0, 0), cB, voffB); PG8_STAGE(PG8_SB(0, 1), cB + hstepB, voffB); PG8_STAGE(PG8_SA(0, 0), cA, voffA); PG8_STAGE(PG8_SA(0, 1), cA + hstepA, voffA);
        if (wr == 1) PG8_BAR;
        PG8_WAIT_V(2); PG8_BAR;
        PG8_STAGE(PG8_SB(1, 0), cB + kstep, voffB); PG8_STAGE(PG8_SA(1, 0), cA + kstep, voffA); PG8_STAGE(PG8_SB(1, 1), cB + hstepB + kstep, voffB);
        PG8_WAIT_V(6); PG8_BAR;
    } else {
        PG8_STAGE(PG8_SB(0, 0), cB, voffB); PG8_STAGE(PG8_SA(0, 0), cA, voffA); PG8_STAGE(PG8_SB(0, 1), cB + hstepB, voffB); PG8_STAGE(PG8_SA(0, 1), cA + hstepA, voffA);
        if (wr == 1) PG8_BAR;
        PG8_WAIT_V(4); PG8_BAR;
        PG8_STAGE(PG8_SB(1, 0), cB + kstep, voffB); PG8_STAGE(PG8_SA(1, 0), cA + kstep, voffA); PG8_STAGE(PG8_SB(1, 1), cB + hstepB + kstep, voffB);
        PG8_WAIT_V(6); PG8_BAR;
    }
    for (;;) {
        const bool has_next = S.next(ui + 1, nxt);
        const char* nA = has_next ? (const char*)g.A + (size_t)nxt.pm * tstepA + nxt.aoff : cA; const char* nB = has_next ? (const char*)g.Bt + (size_t)nxt.pn * tstepB : cB;
        for (int t = 0; t < nt; t += 2) {
            const bool last = (t == nt - 2);
            const char* a1 = cA + (size_t)(t + 1) * kstep;
            const char* a2 = last ? nA : cA + (size_t)(t + 2) * kstep; const char* b2 = last ? nB : cB + (size_t)(t + 2) * kstep;
            const char* a3 = a2 + kstep; const char* b3 = b2 + kstep;
            if (last && has_next) S.a_ready(nxt);
            if constexpr (SP2) {
            PG8_LDB(B0, 0, 0); PG8_LDB(B1, 0, 1); PG8_SCHED; PG8_LDA(At, 0, 0); PG8_STAGE(PG8_SA(1, 1), a1 + hstepA, voffA);
            PG8_WAIT_V(8); PG8_WAIT_L(0); PG8_BAR; PG8_MMA(0, 0, At, B0); PG8_MMA(0, 1, At, B1); PG8_BAR; PG8_SCHED;
            PG8_LDA(At, 0, 1); PG8_STAGE(PG8_SB(0, 0), b2, voffB); PG8_STAGE(PG8_SB(0, 1), b2 + hstepB, voffB); PG8_STAGE(PG8_SA(0, 0), a2, voffA);
            PG8_WAIT_V(8); PG8_WAIT_L(0); PG8_BAR; PG8_MMA(1, 0, At, B0); PG8_MMA(1, 1, At, B1); PG8_BAR; PG8_SCHED;
            PG8_LDB(B0, 1, 0); PG8_LDB(B1, 1, 1); PG8_SCHED; PG8_LDA(At, 1, 0); PG8_STAGE(PG8_SA(0, 1), a2 + hstepA, voffA);
            PG8_WAIT_V(8); PG8_WAIT_L(0); PG8_BAR; PG8_MMA(0, 0, At, B0); PG8_MMA(0, 1, At, B1); PG8_BAR; PG8_SCHED;
            PG8_LDA(At, 1, 1); PG8_STAGE(PG8_SB(1, 0), b3, voffB); PG8_STAGE(PG8_SB(1, 1), b3 + hstepB, voffB); PG8_STAGE(PG8_SA(1, 0), a3, voffA);
            PG8_WAIT_V(8); PG8_WAIT_L(0); PG8_BAR; PG8_MMA(1, 0, At, B0); PG8_MMA(1, 1, At, B1); PG8_BAR; PG8_SCHED;
            } else {
            PG8_LDB(B0, 0, 0); PG8_SCHED; PG8_LDA(At, 0, 0); PG8_STAGE(PG8_SA(1, 1), a1 + hstepA, voffA);
            PG8_WAIT_L(8); PG8_BAR; PG8_WAIT_L(0); PG8_MMA(0, 0, At, B0); PG8_BAR; PG8_SCHED;
            PG8_LDB(B1, 0, 1); PG8_STAGE(PG8_SB(0, 0), b2, voffB);
            PG8_BAR; PG8_WAIT_L(0); PG8_MMA(0, 1, At, B1); PG8_BAR;
            PG8_LDA(At, 0, 1); PG8_STAGE(PG8_SA(0, 0), a2, voffA);
            PG8_BAR; PG8_WAIT_L(0); PG8_MMA(1, 0, At, B0); PG8_BAR; PG8_SCHED;
            PG8_STAGE(PG8_SB(0, 1), b2 + hstepB, voffB);
            PG8_WAIT_V(6); PG8_BAR; PG8_MMA(1, 1, At, B1); PG8_BAR;
            PG8_LDB(B0, 1, 0); PG8_SCHED; PG8_LDA(At, 1, 0); PG8_STAGE(PG8_SA(0, 1), a2 + hstepA, voffA);
            PG8_WAIT_L(8); PG8_BAR; PG8_WAIT_L(0); PG8_MMA(0, 0, At, B0); PG8_BAR; PG8_SCHED;
            PG8_LDB(B1, 1, 1); PG8_STAGE(PG8_SB(1, 0), b3, voffB);
            PG8_BAR; PG8_WAIT_L(0); PG8_MMA(0, 1, At, B1); PG8_BAR;
            PG8_LDA(At, 1, 1); PG8_STAGE(PG8_SA(1, 0), a3, voffA);
            PG8_BAR; PG8_WAIT_L(0); PG8_MMA(1, 0, At, B0); PG8_BAR; PG8_SCHED;
            PG8_STAGE(PG8_SB(1, 1), b3 + hstepB, voffB);
            PG8_WAIT_V(6); PG8_BAR; PG8_MMA(1, 1, At, B1); PG8_BAR;
            }
        }
        if constexpr (ALIGN_EPI) { if (wr == 0) PG8_BAR; }
        if constexpr (!Epi::AFTER_DRAIN) { E(acc, cur, wr, wc, fr, fq); S.done(cur); }
        if (!has_next) break;
        if (E.reset_acc(cur)) {
#pragma unroll
        for (int a = 0; a < 2; ++a)
#pragma unroll
            for (int b = 0; b < 2; ++b)
#pragma unroll
                for (int m = 0; m < 4; ++m)
#pragma unroll
                    for (int n = 0; n < 2; ++n) acc[a][b][m][n] = (f32x4){0.f, 0.f, 0.f, 0.f};
        }
        cur = nxt; cA = nA; cB = nB; ++ui;
        if constexpr (ALIGN_EPI) { if (wr == 1) PG8_BAR; }
    }
    PG8_WAIT_V(0);
    if constexpr (!ALIGN_EPI) { if (wr == 0) PG8_BAR; }
    PG8_BAR;
    if constexpr (Epi::AFTER_DRAIN) { E.fused(acc, cur, wr, wc, fr, fq, lds, wid, lane); S.done(cur); }
#undef PG8_SA
#undef PG8_SB
#undef PG8_STAGE
#undef PG8_LDA
#undef PG8_LDB
#undef PG8_MMA
#undef PG8_WAIT_V
#undef PG8_WAIT_L
#undef PG8_BAR
#undef PG8_SCHED
}
}

#define GAS __attribute__((address_space(1)))
#define LAS __attribute__((address_space(3)))
typedef unsigned short bf16;
typedef unsigned v4u __attribute__((ext_vector_type(4)));
typedef unsigned v2u __attribute__((ext_vector_type(2)));
typedef float f32x4 __attribute__((ext_vector_type(4)));
typedef short bf16x8 __attribute__((ext_vector_type(8)));
typedef GAS unsigned gu32;
#define RLX_AGENT __ATOMIC_RELAXED, __HIP_MEMORY_SCOPE_AGENT
#define LDS_WAIT() asm volatile("s_waitcnt lgkmcnt(0)" ::: "memory")
#define VM_WAIT() asm volatile("s_waitcnt vmcnt(0)" ::: "memory")
using pg8::bf2f; using pg8::bflo; using pg8::bfhi; using pg8::f2bf_rne; using pg8::kperm64; using pg8::ktile_off; using pg8::vtile_off; using pg8::vtile8_off; using pg8::ktile8_off; using pg8::sigmoid_f; using pg8::gelu_tanh_f; using pg8::cvt_pk_bf16;
__device__ __forceinline__ unsigned pk2(float lo, float hi) { return cvt_pk_bf16(lo, hi); }

#define XB_TMO      128
#define XB_XCNT(j)  (256  + 64 * (j))
#define XB_XSUB(j)  (1280 + 64 * (j))
#define XB_XGEN(j)  (2304 + 64 * (j))
#define XB_TOP      3328
#define XB_TOPGEN   3392
#define XCD_BAR_WORDS 3456
#define XB_SPIN_CAP (1u << 18)

__device__ __forceinline__ unsigned xb_ld(unsigned* p)              { return __hip_atomic_load(p, __ATOMIC_RELAXED, __HIP_MEMORY_SCOPE_AGENT); }
__device__ __forceinline__ unsigned xb_add(unsigned* p, unsigned v) { return __hip_atomic_fetch_add(p, v, __ATOMIC_RELAXED, __HIP_MEMORY_SCOPE_AGENT); }
__device__ __forceinline__ unsigned xb_xcc_id() { return (unsigned)__builtin_amdgcn_s_getreg((3 << 11) | 20) & 0xFu; }
#define XB_SPIN(cond, bar) do { unsigned _sp = 0; while (cond) { __builtin_amdgcn_s_sleep(1); \
    if ((++_sp & 255u) == 0u) { if (xb_ld(&(bar)[XB_TMO])) break; if (_sp > XB_SPIN_CAP) { atomicAdd(&(bar)[XB_TMO], 1u); break; } } } } while (0)

struct XcdBarrier {
    unsigned* bar; unsigned x;
    volatile LAS unsigned* st;
};

__device__ __forceinline__ XcdBarrier xcd_barrier_post(unsigned* bar, volatile LAS unsigned* st) {
    XcdBarrier b; b.bar = bar; b.x = xb_xcc_id(); b.st = st;
    if (threadIdx.x == 0) (void)xb_add(&bar[XB_XCNT(b.x)], 1u);
    return b;
}
__device__ __forceinline__ void xcd_barrier_complete(unsigned* bar, unsigned x, unsigned& nloc, unsigned& nx) {
    const unsigned G = gridDim.x * gridDim.y * gridDim.z;
    unsigned sum, cnt, mine, sp = 0u;
    for (;;) {
        sum = 0u; cnt = 0u; mine = 0u;
#pragma unroll
        for (unsigned j = 0; j < 16; ++j) { const unsigned c = xb_ld(&bar[XB_XCNT(j)]); sum += c; cnt += (c > 0u) ? 1u : 0u; mine = (j == x) ? c : mine; }
        if (sum == G) break;
        __builtin_amdgcn_s_sleep(1);
        if ((++sp & 255u) == 0u) { if (xb_ld(&bar[XB_TMO])) break; if (sp > XB_SPIN_CAP) { atomicAdd(&bar[XB_TMO], 1u); break; } }
    }
    nloc = mine > 0u ? mine : 1u; nx = cnt > 0u ? cnt : 1u;
}

__device__ __forceinline__ void xcd_barrier(const XcdBarrier& b) {
    asm volatile("s_waitcnt vmcnt(0)" ::: "memory");
    __syncthreads();
    if (threadIdx.x == 0) {
        unsigned* bar = b.bar;
        __builtin_amdgcn_s_waitcnt(0);
        unsigned nloc = b.st[0], nx = b.st[1];
        if (nloc == 0u) { xcd_barrier_complete(bar, b.x, nloc, nx); b.st[0] = nloc; b.st[1] = nx; }
        const unsigned old = xb_add(&bar[XB_XSUB(b.x)], 1u);
        const unsigned gen = old / nloc;
        if (old + 1u == (gen + 1u) * nloc) {
            __builtin_amdgcn_fence(__ATOMIC_RELEASE, "agent");
            asm volatile("s_waitcnt vmcnt(0)" ::: "memory");
            const unsigned og = xb_add(&bar[XB_TOP], 1u);
            const unsigned tg = og / nx;
            if (og + 1u == (tg + 1u) * nx) xb_add(&bar[XB_TOPGEN], 1u);
            else XB_SPIN(xb_ld(&bar[XB_TOPGEN]) == tg, bar);
            __builtin_amdgcn_fence(__ATOMIC_ACQUIRE, "agent");
            xb_add(&bar[XB_XGEN(b.x)], 1u);
            asm volatile("s_waitcnt vmcnt(0)" ::: "memory");
        } else {
            XB_SPIN(xb_ld(&bar[XB_XGEN(b.x)]) == gen, bar);
            __builtin_amdgcn_fence(__ATOMIC_ACQUIRE, "agent");
            asm volatile("s_waitcnt vmcnt(0)" ::: "memory");
        }
    }
    __syncthreads();
}

__device__ __forceinline__ float wave_sum(float v) {
#pragma unroll
    for (int o = 1; o < 64; o <<= 1) v += __shfl_xor(v, o);
    return v;
}
__device__ __forceinline__ float wave_max(float v) {
#pragma unroll
    for (int o = 1; o < 64; o <<= 1) v = fmaxf(v, __shfl_xor(v, o));
    return v;
}
__device__ __forceinline__ int colmap_in(int n) { return n < 1280 ? n : (n < 4864 ? n + 24 : (n < 4888 ? n - 4864 + 1280 : -1)); }

template <int MODE>
__device__ __forceinline__ void p0_transpose_item(const float* W, int K, int N, int Nout, bf16* WT, const float* kscale, LAS float* scr, int item, int lane) {
    const int nblk = Nout / 32, kb = item / nblk, nb = item % nblk, k0 = 64 * kb, n0 = 32 * nb;
    const int col = MODE ? colmap_in(n0 + (lane & 31)) : n0 + (lane & 31);
    float wv[32];
#pragma unroll
    for (int i = 0; i < 32; ++i) { const int kk = 2 * i + (lane >> 5); wv[i] = col >= 0 ? W[(size_t)(k0 + kk) * N + col] : 0.f; }
#pragma unroll
    for (int i = 0; i < 32; ++i) { const int kk = 2 * i + (lane >> 5); float v = wv[i]; if (kscale) v *= kscale[k0 + kk]; scr[kk * 33 + (lane & 31)] = v; }
    LDS_WAIT(); asm volatile("" ::: "memory");
    const int c = lane & 7;
#pragma unroll
    for (int j = 0; j < 4; ++j) { const int n = (lane >> 3) + 8 * j; const LAS float* s = scr + (8 * c) * 33 + n;
        v4u o; o.x = pk2(s[0 * 33], s[1 * 33]); o.y = pk2(s[2 * 33], s[3 * 33]); o.z = pk2(s[4 * 33], s[5 * 33]); o.w = pk2(s[6 * 33], s[7 * 33]);
        *(GAS v4u*)(WT + (size_t)(n0 + n) * K + k0 + 8 * c) = o; }
    LDS_WAIT(); asm volatile("" ::: "memory");
}
__device__ __forceinline__ void rms_row_to_bf16(const float* xrow, const float* g, bf16* orow, int lane) {
    const GAS f32x4* xr = (const GAS f32x4*)xrow + lane; const GAS f32x4* gr = (const GAS f32x4*)g + lane;
    f32x4 v[4]; float s = 0.f;
#pragma unroll
    for (int j = 0; j < 4; ++j) { v[j] = xr[64 * j]; s += (v[j].x * v[j].x + v[j].y * v[j].y) + (v[j].z * v[j].z + v[j].w * v[j].w); }
    const float rstd = 1.f / sqrtf(wave_sum(s) * (1.f / 1024.f) + RMS_EPS);
    GAS v2u* o8 = (GAS v2u*)orow + lane;
#pragma unroll
    for (int j = 0; j < 4; ++j) { const f32x4 gg = gr[64 * j]; v2u w; w.x = pk2(v[j].x * rstd * gg.x, v[j].y * rstd * gg.y); w.y = pk2(v[j].z * rstd * gg.z, v[j].w * rstd * gg.w); o8[64 * j] = w; }
}

template <int RT, int CT, bool TR = true, class Epi>
__device__ __forceinline__ void skinny_unit(const bf16* A, int lda, const bf16* Bt, int ldb, int K, int row0, int col0, const Epi& E, int lane) {
    const int r = lane & 15, q = lane >> 4;
    f32x4 acc[RT][CT];
#pragma unroll
    for (int a = 0; a < RT; ++a)
#pragma unroll
        for (int b = 0; b < CT; ++b) acc[a][b] = (f32x4){0.f, 0.f, 0.f, 0.f};
    const bf16* ap = A + (size_t)(row0 + r) * lda + q * 8;
    const bf16* bp = Bt + (size_t)(col0 + r) * ldb + q * 8;
#pragma unroll 8
    for (int k = 0; k < K; k += 32) {
        bf16x8 af[RT], bfr[CT];
#pragma unroll
        for (int a = 0; a < RT; ++a) af[a] = *(const GAS bf16x8*)(ap + (size_t)a * 16 * lda + k);
#pragma unroll
        for (int b = 0; b < CT; ++b) bfr[b] = *(const GAS bf16x8*)(bp + (size_t)b * 16 * ldb + k);
#pragma unroll
        for (int a = 0; a < RT; ++a)
#pragma unroll
            for (int b = 0; b < CT; ++b) acc[a][b] = TR ? __builtin_amdgcn_mfma_f32_16x16x32_bf16(bfr[b], af[a], acc[a][b], 0, 0, 0) : __builtin_amdgcn_mfma_f32_16x16x32_bf16(af[a], bfr[b], acc[a][b], 0, 0, 0);
    }
    E(acc, row0, col0, r, q);
}
struct SkHid {
    bf16* G; const float* pe;
    template <int RT, int CT> __device__ __forceinline__ void operator()(const f32x4 (&acc)[RT][CT], int row0, int col0, int r, int q) const {
#pragma unroll
        for (int b = 0; b < CT; ++b) { const int col = col0 + 16 * b + 4 * q; const f32x4 pv = *(const f32x4*)(pe + col);
#pragma unroll
            for (int a = 0; a < RT; ++a) { f32x4 v = acc[a][b] + pv;
#pragma unroll
                for (int i = 0; i < 4; ++i) v[i] = gelu_tanh_f(v[i]);
                v2u w; w.x = pk2(v[0], v[1]); w.y = pk2(v[2], v[3]); *(GAS v2u*)(G + (size_t)(row0 + 16 * a + r) * 256 + col) = w; } }
    }
};
struct SkOutF32 {
    float* O;
    template <int RT, int CT> __device__ __forceinline__ void operator()(const f32x4 (&acc)[RT][CT], int row0, int col0, int r, int q) const {
#pragma unroll
        for (int a = 0; a < RT; ++a)
#pragma unroll
            for (int b = 0; b < CT; ++b) *(GAS f32x4*)(O + (size_t)(row0 + 16 * a + r) * 64 + col0 + 16 * b + 4 * q) = acc[a][b];
    }
};
struct SkOutKT {
    bf16* O;
    template <int RT, int CT> __device__ __forceinline__ void operator()(const f32x4 (&acc)[RT][CT], int row0, int col0, int r, int q) const {
#pragma unroll
        for (int a = 0; a < RT; ++a) { const int row = row0 + 16 * a + r; bf16* base = O + (size_t)(row >> 6) * 4096;
#pragma unroll
            for (int b = 0; b < CT; ++b) { v2u w; w.x = pk2(acc[a][b][0], acc[a][b][1]); w.y = pk2(acc[a][b][2], acc[a][b][3]); *(GAS v2u*)(base + ktile_off(row & 63, col0 + 16 * b + 4 * q)) = w; } }
    }
};
struct SkOutVT {
    bf16* VT;
    template <int RT, int CT> __device__ __forceinline__ void operator()(const f32x4 (&acc)[RT][CT], int row0, int col0, int r, int q) const {
#pragma unroll
        for (int a = 0; a < RT; ++a) { const int row = row0 + 16 * a + 4 * q; bf16* base = VT + (size_t)(row >> 6) * 4096;
#pragma unroll
            for (int b = 0; b < CT; ++b) { v2u w; w.x = pk2(acc[a][b][0], acc[a][b][1]); w.y = pk2(acc[a][b][2], acc[a][b][3]); *(GAS v2u*)(base + vtile_off(row & 63, col0 + 16 * b + r)) = w; } }
    }
};
struct SkWo {
    const float* xs; float* X1; bf16* X1b; float* PSS; int slot;
    template <int RT, int CT> __device__ __forceinline__ void operator()(const f32x4 (&acc)[RT][CT], int row0, int col0, int r, int q) const {
#pragma unroll
        for (int a = 0; a < RT; ++a) { const int row = row0 + 16 * a + r; float ss = 0.f;
#pragma unroll
            for (int b = 0; b < CT; ++b) { const int col = col0 + 16 * b + 4 * q; const f32x4 v = acc[a][b] + *(const GAS f32x4*)(xs + (size_t)(row - NP) * 1024 + col);
                *(GAS f32x4*)(X1 + (size_t)row * 1024 + col) = v; v2u w; w.x = pk2(v[0], v[1]); w.y = pk2(v[2], v[3]); *(GAS v2u*)(X1b + (size_t)row * 1024 + col) = w;
                ss += (v[0] * v[0] + v[1] * v[1]) + (v[2] * v[2] + v[3] * v[3]); }
            ss += __shfl_xor(ss, 16); ss += __shfl_xor(ss, 32);
            if (q == 0) PSS[(size_t)row * 16 + slot] = ss; }
    }
};
struct SkUp {
    const float* PSS; bf16* H;
    template <int RT, int CT> __device__ __forceinline__ void operator()(const f32x4 (&acc)[RT][CT], int row0, int col0, int r, int q) const {
#pragma unroll
        for (int a = 0; a < RT; ++a) { const int row = row0 + 16 * a + r;
            const GAS f32x4* ps = (const GAS f32x4*)(PSS + (size_t)row * 16); const f32x4 s0 = ps[0], s1 = ps[1], s2 = ps[2], s3 = ps[3];
            const float ssum = (((s0[0] + s0[1]) + (s0[2] + s0[3])) + ((s1[0] + s1[1]) + (s1[2] + s1[3]))) + (((s2[0] + s2[1]) + (s2[2] + s2[3])) + ((s3[0] + s3[1]) + (s3[2] + s3[3])));
            const float rstd = __builtin_amdgcn_rsqf(ssum * (1.f / 1024.f) + RMS_EPS);
#pragma unroll
            for (int b = 0; b < CT; ++b) { f32x4 v = acc[a][b] * rstd;
#pragma unroll
                for (int i = 0; i < 4; ++i) v[i] = v[i] > 0.f ? v[i] * v[i] : 0.f;
                v2u w; w.x = pk2(v[0], v[1]); w.y = pk2(v[2], v[3]); *(GAS v2u*)(H + (size_t)row * 4096 + col0 + 16 * b + 4 * q) = w; } }
    }
};
struct SkPart {
    float* P;
    template <int RT, int CT> __device__ __forceinline__ void operator()(const f32x4 (&acc)[RT][CT], int row0, int col0, int r, int q) const {
#pragma unroll
        for (int a = 0; a < RT; ++a)
#pragma unroll
            for (int b = 0; b < CT; ++b) *(GAS f32x4*)(P + (size_t)(row0 + 16 * a + r) * 1024 + col0 + 16 * b + 4 * q) = acc[a][b];
    }
};

struct AttnMaskSel { int d0; bool sel; static constexpr int KS = 16, IS = 1; __device__ __forceinline__ bool ok(int d) const { return sel && d >= 0; } };
struct AttnMaskWin { int d0; static constexpr int KS = 16, IS = 1; __device__ __forceinline__ bool ok(int d) const { return d >= 0 && d < WINL; } };
struct AttnMaskCmp { int d0; static constexpr int KS = 256, IS = 16; __device__ __forceinline__ bool ok(int d) const { return d >= 0; } };

struct SrcB {
    static constexpr bool LATE_V = true;
    const bf16* Kb; const bf16* VTb;
    __device__ __forceinline__ bf16x8 kfrag(int kt, int ks, int r, int qp) const { return *(const GAS bf16x8*)(Kb + ((kt * 2 + ks) * 64 + qp * 16 + r) * 8); }
    __device__ __forceinline__ bf16x8 vfrag(int dt, int k2, int r, int qp) const { return *(const GAS bf16x8*)(VTb + ((dt * 2 + k2) * 64 + qp * 16 + r) * 8); }
};
struct SrcF {
    static constexpr bool LATE_V = true;
    const float* Kp; const float* Vp;
    __device__ __forceinline__ bf16x8 kfrag(int kt, int ks, int r, int qp) const {
        const GAS f32x4* p = (const GAS f32x4*)(Kp + (size_t)(16 * kt + r) * 128 + 32 * ks + 8 * qp); const f32x4 a = p[0], b = p[1];
        v4u w; w.x = pk2(a[0], a[1]); w.y = pk2(a[2], a[3]); w.z = pk2(b[0], b[1]); w.w = pk2(b[2], b[3]); return __builtin_bit_cast(bf16x8, w); }
    __device__ __forceinline__ bf16x8 vfrag(int dt, int k2, int r, int qp) const { float v[8]; const GAS float* p = (const GAS float*)(Vp + (size_t)(4 * qp) * 128 + r);
#pragma unroll
        for (int j = 0; j < 8; ++j) v[j] = p[(32 * k2 + (j < 4 ? j : 12 + j)) * 128 + 16 * dt];
        v4u w; w.x = pk2(v[0], v[1]); w.y = pk2(v[2], v[3]); w.z = pk2(v[4], v[5]); w.w = pk2(v[6], v[7]); return __builtin_bit_cast(bf16x8, w); }
};

template <bool FAST, class Src, class Mask>
__device__ __forceinline__ void attn_scores(const Src& src, const bf16x8 (&qf)[2], const LAS float* lutg, const Mask& mk, float ini, f32x4 (&S)[4], int r, int qp) {
    bf16x8 kf[4][2];
#pragma unroll
    for (int kt = 0; kt < 4; ++kt)
#pragma unroll
        for (int ks = 0; ks < 2; ++ks) kf[kt][ks] = src.kfrag(kt, ks, r, qp);
#pragma unroll
    for (int kt = 0; kt < 4; ++kt) {
        S[kt] = __builtin_amdgcn_mfma_f32_16x16x32_bf16(kf[kt][0], qf[0], (f32x4){ini, ini, ini, ini}, 0, 0, 0);
        S[kt] = __builtin_amdgcn_mfma_f32_16x16x32_bf16(kf[kt][1], qf[1], S[kt], 0, 0, 0);
    }
    if (!FAST) {
        int d0 = mk.d0; asm volatile("" : "+v"(d0));
        float bvv[4][4];
#pragma unroll
        for (int kt = 0; kt < 4; ++kt)
#pragma unroll
            for (int i = 0; i < 4; ++i) { const int d = d0 - Mask::KS * kt - Mask::IS * i; const int dc = d < 0 ? 0 : (d > 127 ? 127 : d); bvv[kt][i] = lutg[dc]; }
#pragma unroll
        for (int kt = 0; kt < 4; ++kt) asm volatile("" : "+v"(bvv[kt][0]), "+v"(bvv[kt][1]), "+v"(bvv[kt][2]), "+v"(bvv[kt][3]));
#pragma unroll
        for (int kt = 0; kt < 4; ++kt)
#pragma unroll
            for (int i = 0; i < 4; ++i) { const int d = d0 - Mask::KS * kt - Mask::IS * i; S[kt][i] = mk.ok(d) ? S[kt][i] + bvv[kt][i] : -1.0e30f; }
    }
}
template <bool FAST, class Src, class Mask>
__device__ __forceinline__ void attn_block(const Src& src, const bf16x8 (&qf)[2], const LAS float* lutg, const Mask& mk, float bcol, float& m, float& l, f32x4 (&O)[4], int r, int qp) {
    bf16x8 vf[4][2];
    if constexpr (!Src::LATE_V) {
#pragma unroll
        for (int dt = 0; dt < 4; ++dt)
#pragma unroll
            for (int k2 = 0; k2 < 2; ++k2) vf[dt][k2] = src.vfrag(dt, k2, r, qp);
    }
    const bool have = m > -1.0e29f; const float off = have ? m : 0.f;
    f32x4 S[4];
    attn_scores<FAST>(src, qf, lutg, mk, FAST ? bcol - off : -off, S, r, qp);
    if constexpr (Src::LATE_V) {
        asm volatile("" ::: "memory");
#pragma unroll
        for (int dt = 0; dt < 4; ++dt)
#pragma unroll
            for (int k2 = 0; k2 < 2; ++k2) vf[dt][k2] = src.vfrag(dt, k2, r, qp);
    }
    float mx = fmaxf(fmaxf(fmaxf(S[0][0], S[0][1]), fmaxf(S[0][2], S[0][3])), fmaxf(fmaxf(S[1][0], S[1][1]), fmaxf(S[1][2], S[1][3])));
    mx = fmaxf(mx, fmaxf(fmaxf(fmaxf(S[2][0], S[2][1]), fmaxf(S[2][2], S[2][3])), fmaxf(fmaxf(S[3][0], S[3][1]), fmaxf(S[3][2], S[3][3]))));
    if (__any(have ? (mx > 8.f) : (mx > -1.0e29f))) {
        mx = fmaxf(mx, __shfl_xor(mx, 16)); mx = fmaxf(mx, __shfl_xor(mx, 32));
        const bool need = have ? (mx > 8.f) : (mx > -1.0e29f);
        const float delta = need ? mx : 0.f, sc = __builtin_amdgcn_exp2f(-delta);
        l *= sc; m = need ? off + mx : m;
#pragma unroll
        for (int dt = 0; dt < 4; ++dt) O[dt] = O[dt] * sc;
#pragma unroll
        for (int kt = 0; kt < 4; ++kt) S[kt] = S[kt] - delta;
    }
    float ps = 0.f;
#pragma unroll
    for (int kt = 0; kt < 4; ++kt)
#pragma unroll
        for (int i = 0; i < 4; ++i) { const float p = __builtin_amdgcn_exp2f(S[kt][i]); S[kt][i] = p; ps += p; }
    l += ps;
    bf16x8 pf[2];
#pragma unroll
    for (int k2 = 0; k2 < 2; ++k2) { v4u w; w.x = pk2(S[2 * k2][0], S[2 * k2][1]); w.y = pk2(S[2 * k2][2], S[2 * k2][3]); w.z = pk2(S[2 * k2 + 1][0], S[2 * k2 + 1][1]); w.w = pk2(S[2 * k2 + 1][2], S[2 * k2 + 1][3]);
        pf[k2] = __builtin_bit_cast(bf16x8, w); }
#pragma unroll
    for (int dt = 0; dt < 4; ++dt) {
        O[dt] = __builtin_amdgcn_mfma_f32_16x16x32_bf16(vf[dt][0], pf[0], O[dt], 0, 0, 0);
        O[dt] = __builtin_amdgcn_mfma_f32_16x16x32_bf16(vf[dt][1], pf[1], O[dt], 0, 0, 0); }
}
__device__ __forceinline__ float quad_xor1(float v) { return __builtin_bit_cast(float, __builtin_amdgcn_mov_dpp(__builtin_bit_cast(int, v), 0xB1, 0xF, 0xF, true)); }
__device__ __forceinline__ float quad_xor2(float v) { return __builtin_bit_cast(float, __builtin_amdgcn_mov_dpp(__builtin_bit_cast(int, v), 0x4E, 0xF, 0xF, true)); }
__device__ __forceinline__ float col_total(float l) { float lt = l + __shfl_xor(l, 16); lt += __shfl_xor(lt, 32); return lt; }

__device__ __forceinline__ float max16(const f32x4 (&S)[4]) {
    const float a = fmaxf(fmaxf(S[0][0], S[0][1]), S[0][2]), b = fmaxf(fmaxf(S[0][3], S[1][0]), S[1][1]), c = fmaxf(fmaxf(S[1][2], S[1][3]), S[2][0]);
    const float d = fmaxf(fmaxf(S[2][1], S[2][2]), S[2][3]), e = fmaxf(fmaxf(S[3][0], S[3][1]), S[3][2]);
    return fmaxf(fmaxf(fmaxf(a, b), c), fmaxf(fmaxf(d, e), S[3][3])); }
__device__ __forceinline__ float max2(float a, float b) { return fmaxf(a, b); }
struct Blk { const bf16* K; const bf16* VT; int j; bool fast; };
struct LaneCtx { int dbase; float bfar; unsigned long long mlo, mhi; };
template <bool VF8>
__device__ __forceinline__ void load_block(v4u (&kf)[8], v4u (&vf)[8], const Blk& bl, unsigned lane16) {
    const GAS unsigned char* kb = (const GAS unsigned char*)bl.K; const GAS unsigned char* vb = (const GAS unsigned char*)bl.VT;
    if (VF8) {
#pragma unroll
        for (int kt = 0; kt < 4; ++kt) kf[kt] = *(const GAS v4u*)(kb + (size_t)lane16 + kt * 1024);
#pragma unroll
        for (int dt = 0; dt < 4; ++dt) vf[dt] = *(const GAS v4u*)(vb + (size_t)lane16 + dt * 1024);
    } else {
#pragma unroll
        for (int f = 0; f < 8; ++f) kf[f] = *(const GAS v4u*)(kb + (size_t)lane16 + f * 1024);
#pragma unroll
        for (int f = 0; f < 8; ++f) vf[f] = *(const GAS v4u*)(vb + (size_t)lane16 + f * 1024);
    }
}
template <int KS, int IS, int DSTEP, bool WIN, bool VF8, bool MASKED>
__device__ __forceinline__ void compute_block(const v4u (&kf)[8], const v4u (&vf)[8], const Blk& bl, const LaneCtx& lc, const bf16x8 (&qf)[2], const long (&qf8)[2], const LAS float* lutg, float& m, float& l, f32x4 (&O)[4]) {
    const bool have = m > -1.0e29f; const float off = have ? m : 0.f;
    bool sel = true;
    if (MASKED) { const unsigned long long mq = (bl.j & 64) ? lc.mhi : lc.mlo; sel = ((mq >> (bl.j & 63)) & 1ull) != 0ull; }
    const float bcol = sel ? lc.bfar : -1.0e30f;
    const float ini = bl.fast ? bcol - off : -off;
    f32x4 S[4];
#pragma unroll
    for (int kt = 0; kt < 4; ++kt) {
        if (VF8) { const long k0 = (long)(((unsigned long long)kf[kt].y << 32) | (unsigned long long)kf[kt].x), k1 = (long)(((unsigned long long)kf[kt].w << 32) | (unsigned long long)kf[kt].z);
            S[kt] = __builtin_amdgcn_mfma_f32_16x16x32_fp8_fp8(k0, qf8[0], (f32x4){ini, ini, ini, ini}, 0, 0, 0);
            S[kt] = __builtin_amdgcn_mfma_f32_16x16x32_fp8_fp8(k1, qf8[1], S[kt], 0, 0, 0);
        } else {
            S[kt] = __builtin_amdgcn_mfma_f32_16x16x32_bf16(__builtin_bit_cast(bf16x8, kf[kt * 2]), qf[0], (f32x4){ini, ini, ini, ini}, 0, 0, 0);
            S[kt] = __builtin_amdgcn_mfma_f32_16x16x32_bf16(__builtin_bit_cast(bf16x8, kf[kt * 2 + 1]), qf[1], S[kt], 0, 0, 0); }
    }
    if (!bl.fast) {
        int d0 = lc.dbase - DSTEP * bl.j; asm volatile("" : "+v"(d0));
        float bv[4][4];
#pragma unroll
        for (int kt = 0; kt < 4; ++kt)
#pragma unroll
            for (int i = 0; i < 4; ++i) { const int d = d0 - KS * kt - IS * i; const int dc = d < 0 ? 0 : (d > 127 ? 127 : d); bv[kt][i] = lutg[dc]; }
#pragma unroll
        for (int kt = 0; kt < 4; ++kt) asm volatile("" : "+v"(bv[kt][0]), "+v"(bv[kt][1]), "+v"(bv[kt][2]), "+v"(bv[kt][3]));
#pragma unroll
        for (int kt = 0; kt < 4; ++kt)
#pragma unroll
            for (int i = 0; i < 4; ++i) { const int d = d0 - KS * kt - IS * i; const bool ok = sel && d >= 0 && (!WIN || d < WINL);
                S[kt][i] = ok ? S[kt][i] + bv[kt][i] : -1.0e30f; }
    }
    float mx = max16(S);
    const float thr = have ? 8.f : -1.0e29f;
    if (__builtin_amdgcn_ballot_w64(mx > thr) != 0ull) {
        mx = max2(mx, __shfl_xor(mx, 16)); mx = max2(mx, __shfl_xor(mx, 32));
        const bool need = mx > thr;
        const float delta = need ? mx : 0.f, sc = __builtin_amdgcn_exp2f(-delta);
        l *= sc; m = need ? off + mx : m;
#pragma unroll
        for (int dt = 0; dt < 4; ++dt) O[dt] = O[dt] * sc;
#pragma unroll
        for (int kt = 0; kt < 4; ++kt) S[kt] = S[kt] - delta;
    }
#pragma unroll
    for (int kt = 0; kt < 4; ++kt)
#pragma unroll
        for (int i = 0; i < 4; ++i) S[kt][i] = __builtin_amdgcn_exp2f(S[kt][i]);
    { const f32x4 t = (S[0] + S[1]) + (S[2] + S[3]); l += (t[0] + t[1]) + (t[2] + t[3]); }
    if (VF8) {
        long pf8[2];
#pragma unroll
        for (int k2 = 0; k2 < 2; ++k2) { int w0 = __builtin_bit_cast(int, S[2 * k2][0]), w1 = __builtin_bit_cast(int, S[2 * k2 + 1][0]);
            w0 = __builtin_amdgcn_cvt_pk_fp8_f32(S[2 * k2][0], S[2 * k2][1], w0, false); w0 = __builtin_amdgcn_cvt_pk_fp8_f32(S[2 * k2][2], S[2 * k2][3], w0, true);
            w1 = __builtin_amdgcn_cvt_pk_fp8_f32(S[2 * k2 + 1][0], S[2 * k2 + 1][1], w1, false); w1 = __builtin_amdgcn_cvt_pk_fp8_f32(S[2 * k2 + 1][2], S[2 * k2 + 1][3], w1, true);
            pf8[k2] = (long)(((unsigned long long)(unsigned)w1 << 32) | (unsigned long long)(unsigned)w0); }
#pragma unroll
        for (int dt = 0; dt < 4; ++dt) {
            const long v0 = (long)(((unsigned long long)vf[dt].y << 32) | (unsigned long long)vf[dt].x), v1 = (long)(((unsigned long long)vf[dt].w << 32) | (unsigned long long)vf[dt].z);
            O[dt] = __builtin_amdgcn_mfma_f32_16x16x32_fp8_fp8(v0, pf8[0], O[dt], 0, 0, 0);
            O[dt] = __builtin_amdgcn_mfma_f32_16x16x32_fp8_fp8(v1, pf8[1], O[dt], 0, 0, 0); }
    } else {
        bf16x8 pf[2];
#pragma unroll
        for (int k2 = 0; k2 < 2; ++k2) { v4u w; w.x = pk2(S[2 * k2][0], S[2 * k2][1]); w.y = pk2(S[2 * k2][2], S[2 * k2][3]); w.z = pk2(S[2 * k2 + 1][0], S[2 * k2 + 1][1]); w.w = pk2(S[2 * k2 + 1][2], S[2 * k2 + 1][3]);
            pf[k2] = __builtin_bit_cast(bf16x8, w); }
#pragma unroll
        for (int dt = 0; dt < 4; ++dt) {
            O[dt] = __builtin_amdgcn_mfma_f32_16x16x32_bf16(__builtin_bit_cast(bf16x8, vf[dt * 2]), pf[0], O[dt], 0, 0, 0);
            O[dt] = __builtin_amdgcn_mfma_f32_16x16x32_bf16(__builtin_bit_cast(bf16x8, vf[dt * 2 + 1]), pf[1], O[dt], 0, 0, 0); }
    }
}
__device__ __forceinline__ void loadK8(v4u (&kf)[4], const Blk& bl, unsigned lane16) { const GAS unsigned char* kb = (const GAS unsigned char*)bl.K;
#pragma unroll
    for (int kt = 0; kt < 4; ++kt) kf[kt] = *(const GAS v4u*)(kb + (size_t)lane16 + kt * 1024); }
__device__ __forceinline__ void loadV8(v4u (&vf)[4], const Blk& bl, unsigned lane16) { const GAS unsigned char* vb = (const GAS unsigned char*)bl.VT;
#pragma unroll
    for (int dt = 0; dt < 4; ++dt) vf[dt] = *(const GAS v4u*)(vb + (size_t)lane16 + dt * 1024); }
template <bool MASKED>
__device__ __forceinline__ bool lane_sel(const Blk& bl, const LaneCtx& lc) { if (!MASKED) return true; const unsigned long long mq = (bl.j & 64) ? lc.mhi : lc.mlo; return ((mq >> (bl.j & 63)) & 1ull) != 0ull; }
__device__ __forceinline__ void softmax_pv8(f32x4 (&S0)[4], const v4u (&vf)[4], float& l, f32x4 (&O)[4]) {
#pragma unroll
    for (int kt = 0; kt < 4; ++kt)
#pragma unroll
        for (int i = 0; i < 4; ++i) S0[kt][i] = __builtin_amdgcn_exp2f(S0[kt][i]);
    { const f32x4 t = (S0[0] + S0[1]) + (S0[2] + S0[3]); l += (t[0] + t[1]) + (t[2] + t[3]); }
    long pf8[2];
#pragma unroll
    for (int k2 = 0; k2 < 2; ++k2) { int w0 = __builtin_bit_cast(int, S0[2 * k2][0]), w1 = __builtin_bit_cast(int, S0[2 * k2 + 1][0]);
        w0 = __builtin_amdgcn_cvt_pk_fp8_f32(S0[2 * k2][0], S0[2 * k2][1], w0, false); w0 = __builtin_amdgcn_cvt_pk_fp8_f32(S0[2 * k2][2], S0[2 * k2][3], w0, true);
        w1 = __builtin_amdgcn_cvt_pk_fp8_f32(S0[2 * k2 + 1][0], S0[2 * k2 + 1][1], w1, false); w1 = __builtin_amdgcn_cvt_pk_fp8_f32(S0[2 * k2 + 1][2], S0[2 * k2 + 1][3], w1, true);
        pf8[k2] = (long)(((unsigned long long)(unsigned)w1 << 32) | (unsigned long long)(unsigned)w0); }
#pragma unroll
    for (int dt = 0; dt < 4; ++dt) {
        const long v0 = (long)(((unsigned long long)vf[dt].y << 32) | (unsigned long long)vf[dt].x), v1 = (long)(((unsigned long long)vf[dt].w << 32) | (unsigned long long)vf[dt].z);
        O[dt] = __builtin_amdgcn_mfma_f32_16x16x32_fp8_fp8(v0, pf8[0], O[dt], 0, 0, 0);
        O[dt] = __builtin_amdgcn_mfma_f32_16x16x32_fp8_fp8(v1, pf8[1], O[dt], 0, 0, 0); }
}
template <bool MASKED>
__device__ __forceinline__ void qk8(const v4u (&kf)[4], const Blk& bl, const LaneCtx& lc, const long (&qf8)[2], float m, f32x4 (&S1)[4]) {
    const bool have = m > -1.0e29f; const float off = have ? m : 0.f;
    const float bcol = lane_sel<MASKED>(bl, lc) ? lc.bfar : -1.0e30f;
    const float ini = bl.fast ? bcol - off : -off;
#pragma unroll
    for (int kt = 0; kt < 4; ++kt) { const long k0 = (long)(((unsigned long long)kf[kt].y << 32) | (unsigned long long)kf[kt].x), k1 = (long)(((unsigned long long)kf[kt].w << 32) | (unsigned long long)kf[kt].z);
        S1[kt] = __builtin_amdgcn_mfma_f32_16x16x32_fp8_fp8(k0, qf8[0], (f32x4){ini, ini, ini, ini}, 0, 0, 0);
        S1[kt] = __builtin_amdgcn_mfma_f32_16x16x32_fp8_fp8(k1, qf8[1], S1[kt], 0, 0, 0); }
}
template <int KS, int IS, int DSTEP, bool WIN, bool MASKED>
__device__ __forceinline__ void post8(f32x4 (&S)[4], const Blk& bl, const LaneCtx& lc, const LAS float* lutg, float& m, float& l, f32x4 (&O)[4]) {
    const bool have = m > -1.0e29f; const float off = have ? m : 0.f;
    if (!bl.fast) {
        const bool sel = lane_sel<MASKED>(bl, lc);
        int d0 = lc.dbase - DSTEP * bl.j; asm volatile("" : "+v"(d0));
        float bv[4][4];
#pragma unroll
        for (int kt = 0; kt < 4; ++kt)
#pragma unroll
            for (int i = 0; i < 4; ++i) { const int d = d0 - KS * kt - IS * i; const int dc = d < 0 ? 0 : (d > 127 ? 127 : d); bv[kt][i] = lutg[dc]; }
#pragma unroll
        for (int kt = 0; kt < 4; ++kt) asm volatile("" : "+v"(bv[kt][0]), "+v"(bv[kt][1]), "+v"(bv[kt][2]), "+v"(bv[kt][3]));
#pragma unroll
        for (int kt = 0; kt < 4; ++kt)
#pragma unroll
            for (int i = 0; i < 4; ++i) { const int d = d0 - KS * kt - IS * i; const bool ok = sel && d >= 0 && (!WIN || d < WINL);
                S[kt][i] = ok ? S[kt][i] + bv[kt][i] : -1.0e30f; }
    }
    float mx = max16(S);
    const float thr = have ? 8.f : -1.0e29f;
    if (__builtin_amdgcn_ballot_w64(mx > thr) != 0ull) {
        mx = max2(mx, __shfl_xor(mx, 16)); mx = max2(mx, __shfl_xor(mx, 32));
        const bool need = mx > thr;
        const float delta = need ? mx : 0.f, sc = __builtin_amdgcn_exp2f(-delta);
        l *= sc; m = need ? off + mx : m;
#pragma unroll
        for (int dt = 0; dt < 4; ++dt) O[dt] = O[dt] * sc;
#pragma unroll
        for (int kt = 0; kt < 4; ++kt) S[kt] = S[kt] - delta;
    }
}
template <int KS, int IS, int DSTEP, bool WIN, bool MASKED, class Next>
__device__ __forceinline__ void run_blocks8(Next& next, int n, const LaneCtx& lc, const long (&qf8)[2], const LAS float* lutg, float& m, float& l, f32x4 (&O)[4], unsigned lane16) {
    Blk bX, bY, bN; v4u kX[4], vX[4], kY[4], vY[4]; f32x4 S0[4], S1[4];
    (void)next(bX); loadK8(kX, bX, lane16); loadV8(vX, bX, lane16);
    bY = bX; (void)next(bY); loadK8(kY, bY, lane16); loadV8(vY, bY, lane16);
    qk8<MASKED>(kX, bX, lc, qf8, m, S0);
    post8<KS, IS, DSTEP, WIN, MASKED>(S0, bX, lc, lutg, m, l, O);
#pragma unroll 1
    for (int p = n >> 1; p > 0; --p) {
        bN = bY; (void)next(bN); loadK8(kX, bN, lane16); __builtin_amdgcn_sched_barrier(0);
        qk8<MASKED>(kY, bY, lc, qf8, m, S1); softmax_pv8(S0, vX, l, O);
        post8<KS, IS, DSTEP, WIN, MASKED>(S1, bY, lc, lutg, m, l, O);
        loadV8(vX, bN, lane16); bX = bN;
        bN = bX; (void)next(bN); loadK8(kY, bN, lane16); __builtin_amdgcn_sched_barrier(0);
        qk8<MASKED>(kX, bX, lc, qf8, m, S0); softmax_pv8(S1, vY, l, O);
        post8<KS, IS, DSTEP, WIN, MASKED>(S0, bX, lc, lutg, m, l, O);
        loadV8(vY, bN, lane16); bY = bN;
    }
    if (n & 1) softmax_pv8(S0, vX, l, O);
}
template <int KS, int IS, int DSTEP, bool WIN, bool VF8, bool MASKED, class Next>
__device__ __forceinline__ void run_blocks(Next& next, int n, const LaneCtx& lc, const bf16x8 (&qf)[2], const LAS float* lutg, float& m, float& l, f32x4 (&O)[4], unsigned lane16) {
    Blk b0, b1; v4u kA[8], kB[8], vA[8], vB[8];
    long qf8[2] = {0, 0};
    if (VF8) {
#pragma unroll
        for (int ks = 0; ks < 2; ++ks) { const v4u w = __builtin_bit_cast(v4u, qf[ks]); int a = 0, b = 0;
            a = __builtin_amdgcn_cvt_pk_fp8_f32(bflo(w.x), bfhi(w.x), a, false); a = __builtin_amdgcn_cvt_pk_fp8_f32(bflo(w.y), bfhi(w.y), a, true);
            b = __builtin_amdgcn_cvt_pk_fp8_f32(bflo(w.z), bfhi(w.z), b, false); b = __builtin_amdgcn_cvt_pk_fp8_f32(bflo(w.w), bfhi(w.w), b, true);
            qf8[ks] = (long)(((unsigned long long)(unsigned)b << 32) | (unsigned long long)(unsigned)a); } }
    if (n <= 0) return;
    if (VF8) { run_blocks8<KS, IS, DSTEP, WIN, MASKED>(next, n, lc, qf8, lutg, m, l, O, lane16); return; }
    (void)next(b0);
    load_block<VF8>(kA, vA, b0, lane16);
#pragma unroll 1
    for (int p = n >> 1; p > 0; --p) {
        b1 = b0; (void)next(b1);
        load_block<VF8>(kB, vB, b1, lane16); __builtin_amdgcn_sched_barrier(0);
        compute_block<KS, IS, DSTEP, WIN, VF8, MASKED>(kA, vA, b0, lc, qf, qf8, lutg, m, l, O);
        b0 = b1; (void)next(b0);
        load_block<VF8>(kA, vA, b0, lane16); __builtin_amdgcn_sched_barrier(0);
        compute_block<KS, IS, DSTEP, WIN, VF8, MASKED>(kB, vB, b1, lc, qf, qf8, lutg, m, l, O);
    }
    if (n & 1) compute_block<KS, IS, DSTEP, WIN, VF8, MASKED>(kA, vA, b0, lc, qf, qf8, lutg, m, l, O);
}

__device__ __forceinline__ void acc_set(LAS float* aL, const f32x4 (&O)[4], float s, int lane) {
#pragma unroll
    for (int dt = 0; dt < 4; ++dt)
#pragma unroll
        for (int i = 0; i < 4; ++i) aL[(dt * 4 + i) * 64 + lane] = O[dt][i] * s; }
__device__ __forceinline__ void acc_add(LAS float* aL, const f32x4 (&O)[4], float s, int lane) {
#pragma unroll
    for (int dt = 0; dt < 4; ++dt)
#pragma unroll
        for (int i = 0; i < 4; ++i) aL[(dt * 4 + i) * 64 + lane] += O[dt][i] * s; }
template <int NSBP>
__device__ __forceinline__ void cmp_branch(const bf16* KC, const bf16* VCT, int ncb, int tcol, int t0, bool want_imp, const bf16x8 (&qf)[2], const LAS float* lutg, float bfar, float gate, LAS float* aL, LAS float* imp, int lane) {
    const int r = lane & 15, qp = lane >> 4, slot = r >> 2, g = r & 3;
    float m = -3.0e38f, l = 0.f; f32x4 O[4];
#pragma unroll
    for (int dt = 0; dt < 4; ++dt) O[dt] = (f32x4){0.f, 0.f, 0.f, 0.f};
    { int cb = 0;
      const LaneCtx lc{tcol - 31 - 64 * qp, bfar, 0ull, 0ull};
      auto next = [&](Blk& bl) -> bool { if (cb >= ncb) return false; bl.K = KC + (size_t)cb * 4096; bl.VT = VCT + (size_t)cb * 4096; bl.j = cb;
          bl.fast = t0 - (1024 * cb + 1039) >= 113; ++cb; return true; };
      run_blocks<256, 16, 1024, false, false, false>(next, ncb, lc, qf, lutg, m, l, O, (unsigned)lane * 16u); }
    const float lt = col_total(l), rl = lt > 0.f ? 1.f / lt : 0.f;
    acc_set(aL, O, gate * rl, lane);
    if (want_imp) {
        float hprev = 0.f; const int src_lane = (lane + 48) & 63; const float mm = m > -1.0e29f ? m : 0.f;
        bf16x8 kA[4][2], kB[4][2];
        auto ldk = [&](bf16x8 (&kf)[4][2], int cb) { const bf16* K = KC + (size_t)cb * 4096;
#pragma unroll
            for (int kt = 0; kt < 4; ++kt)
#pragma unroll
                for (int ks = 0; ks < 2; ++ks) kf[kt][ks] = *(const GAS bf16x8*)(K + ((kt * 2 + ks) * 64 + lane) * 8); };
        auto score = [&](const bf16x8 (&kf)[4][2], int cb) {
            const bool fast = t0 - (1024 * cb + 1039) >= 113; const float ini = fast ? bfar - mm : -mm; f32x4 S[4];
#pragma unroll
            for (int kt = 0; kt < 4; ++kt) { S[kt] = __builtin_amdgcn_mfma_f32_16x16x32_bf16(kf[kt][0], qf[0], (f32x4){ini, ini, ini, ini}, 0, 0, 0); S[kt] = __builtin_amdgcn_mfma_f32_16x16x32_bf16(kf[kt][1], qf[1], S[kt], 0, 0, 0); }
            if (!fast) { int d0 = tcol - 31 - 16 * (64 * cb + 4 * qp); asm volatile("" : "+v"(d0)); float b2[4][4];
#pragma unroll
                for (int kt = 0; kt < 4; ++kt)
#pragma unroll
                    for (int i = 0; i < 4; ++i) { const int d = d0 - 256 * kt - 16 * i; const int dc = d < 0 ? 0 : (d > 127 ? 127 : d); b2[kt][i] = lutg[dc]; }
#pragma unroll
                for (int kt = 0; kt < 4; ++kt) asm volatile("" : "+v"(b2[kt][0]), "+v"(b2[kt][1]), "+v"(b2[kt][2]), "+v"(b2[kt][3]));
#pragma unroll
                for (int kt = 0; kt < 4; ++kt)
#pragma unroll
                    for (int i = 0; i < 4; ++i) { const int d = d0 - 256 * kt - 16 * i; S[kt][i] = d >= 0 ? S[kt][i] + b2[kt][i] : -1.0e30f; } }
#pragma unroll
            for (int kt = 0; kt < 4; ++kt) { float pr[4];
#pragma unroll
                for (int i = 0; i < 4; ++i) pr[i] = __builtin_amdgcn_exp2f(S[kt][i]) * rl;
                const float h = 0.5f * pr[3]; const float a = (pr[0] + pr[1]) + (pr[2] + h);
                const float r1 = __shfl(hprev, src_lane), r2 = __shfl(h, src_lane);
                float v = a + (qp == 0 ? r1 : r2);
                v += quad_xor1(v); v += quad_xor2(v);
                const int j = 16 * cb + 4 * kt + qp;
                if (g == 0 && j < NSBP) imp[slot * NSBP + j] = v;
                hprev = h; } };
        if (ncb > 0) { ldk(kA, 0); int cb = 0;
#pragma unroll 1
            for (int p = ncb >> 1; p > 0; --p) {
                ldk(kB, cb + 1); score(kA, cb); ++cb;
                ldk(kA, cb + 1 < ncb ? cb + 1 : cb); score(kB, cb); ++cb;
            }
            if (ncb & 1) score(kA, cb); }
        LDS_WAIT(); asm volatile("" ::: "memory");
    }
}
struct PAttn { const bf16 *Qb, *KSp, *KWp, *VTs, *VTw, *KCp, *VCTp; const float* GN; bf16* Ab; };

template <class Pre>
__device__ __forceinline__ void prompt_attn_group(const PAttn& T, int b, int kvh, int t0, const LAS float* lut, LAS float* imp  , LAS unsigned* selm  , int lane, const Pre& pre) {
    const int r = lane & 15, qp = lane >> 4, qi = r >> 2, g = r & 3;
    const int tcol = t0 + qi, tok = b * SEQ + tcol, head = kvh * 4 + g, bk = b * 2 + kvh, cur = t0 >> 6;
    const LAS float* lutg = lut + head * 128; const float bfar = lutg[127];
    LAS float* aL = imp + 2048;
    bf16x8 qf[2];
#pragma unroll
    for (int ks = 0; ks < 2; ++ks) qf[ks] = *(const GAS bf16x8*)(T.Qb + (size_t)tok * 512 + head * 64 + 32 * ks + 8 * qp);
    const float* gp = T.GN + (size_t)tok * 32 + kvh * 12 + g * 3;
    const float g0 = gp[0], g1 = gp[1], g2 = gp[2];
    unsigned mym[4], un[4];
    const int tmax = t0 + 3;
    const int ncb = tmax >= 31 ? (((tmax - 31) >> 4) >> 6) + 1 : 0;
    cmp_branch<128>(T.KCp + (size_t)bk * 512 * 64, T.VCTp + (size_t)bk * 8 * 4096, ncb, tcol, t0, cur >= 16, qf, lutg, bfar, g0, aL, imp, lane);
    if (cur >= 16) {
        { const int qs = lane >> 4, e = lane & 15; int io = qs * 128 + e; asm volatile("" : "+v"(io));
            LAS unsigned* impk = (LAS unsigned*)imp; unsigned key[8], rank[8];
#pragma unroll
            for (int i = 0; i < 8; ++i) { const int j = e + 16 * i; const unsigned bits = impk[io + 16 * i]; key[i] = (j >= 1 && j <= cur - 2) ? ((bits & ~127u) | (unsigned)(127 - j)) : 0u; rank[i] = 0u; }
#pragma unroll
            for (int i = 0; i < 8; ++i) impk[io + 16 * i] = key[i];
            if (e < 4) selm[qs * 4 + e] = 0u;
            LDS_WAIT(); asm volatile("" ::: "memory");
            const LAS v4u* kq = (const LAS v4u*)(impk + qs * 128);
            const int nk4 = (cur + 2) >> 2;
#pragma unroll 4
            for (int k4 = 0; k4 < nk4; ++k4) { const v4u kk = kq[k4];
#pragma unroll
                for (int i = 0; i < 8; ++i) rank[i] += (kk.x > key[i] ? 1u : 0u) + (kk.y > key[i] ? 1u : 0u) + (kk.z > key[i] ? 1u : 0u) + (kk.w > key[i] ? 1u : 0u); }
            unsigned mk4[4] = {0u, 0u, 0u, 0u};
#pragma unroll
            for (int i = 0; i < 8; ++i) { const int j = e + 16 * i; const bool tk = key[i] != 0u && rank[i] < (unsigned)(NSEL - 3);
#pragma unroll
                for (int w = 0; w < 4; ++w) mk4[w] |= (tk && w == (j >> 5)) ? (1u << (j & 31)) : 0u; }
            if (e == 0) {
#pragma unroll
                for (int w = 0; w < 4; ++w) { unsigned f = 0u; if (w == 0) f |= 1u; if (w == (cur >> 5)) f |= 1u << (cur & 31); if (w == ((cur - 1) >> 5)) f |= 1u << ((cur - 1) & 31); mk4[w] |= f; } }
#pragma unroll
            for (int w = 0; w < 4; ++w) if (mk4[w]) (void)__hip_atomic_fetch_or(selm + qs * 4 + w, mk4[w], __ATOMIC_RELAXED, __HIP_MEMORY_SCOPE_WORKGROUP);
        }
        LDS_WAIT(); asm volatile("" ::: "memory");
#pragma unroll
        for (int w = 0; w < 4; ++w) { mym[w] = selm[qi * 4 + w]; const unsigned u = selm[w] | selm[4 + w] | selm[8 + w] | selm[12 + w]; un[w] = (unsigned)__builtin_amdgcn_readfirstlane((int)u); }
        LDS_WAIT(); asm volatile("" ::: "memory");
    } else {
        mym[0] = (2u << cur) - 1u; mym[1] = 0u; mym[2] = 0u; mym[3] = 0u;
#pragma unroll
        for (int w = 0; w < 4; ++w) un[w] = mym[w];
    }
    {
        float m = -3.0e38f, l = 0.f; f32x4 O[4];
#pragma unroll
        for (int dt = 0; dt < 4; ++dt) O[dt] = (f32x4){0.f, 0.f, 0.f, 0.f};
        { unsigned long long ulo = ((unsigned long long)un[1] << 32) | un[0], uhi = ((unsigned long long)un[3] << 32) | un[2];
          const LaneCtx lc{tcol - 4 * qp, bfar, ((unsigned long long)mym[1] << 32) | mym[0], ((unsigned long long)mym[3] << 32) | mym[2]};
          auto next = [&](Blk& bl) -> bool {
              if ((ulo | uhi) == 0ull) return false;
              const bool inlo = ulo != 0ull; const unsigned long long u = inlo ? ulo : uhi;
              const int j = (inlo ? 0 : 64) + __builtin_ctzll(u); const unsigned long long u2 = u & (u - 1ull);
              ulo = inlo ? u2 : ulo; uhi = inlo ? uhi : u2;
              bl.K = T.KSp + (size_t)(bk * SEQ + 64 * j) * 64; bl.VT = T.VTs + (size_t)(bk * 128 + j) * 4096; bl.j = j; bl.fast = j <= cur - 3; return true; };
          run_blocks<16, 1, 64, false, true, true>(next, __builtin_popcountll(ulo) + __builtin_popcountll(uhi), lc, qf, lutg, m, l, O, (unsigned)lane * 16u); }
        const float lt = col_total(l), rl = lt > 0.f ? 1.f / lt : 0.f;
        acc_add(aL, O, g1 * rl, lane);
    }
    pre();
    {
        float m = -3.0e38f, l = 0.f; f32x4 O[4];
#pragma unroll
        for (int dt = 0; dt < 4; ++dt) O[dt] = (f32x4){0.f, 0.f, 0.f, 0.f};
        const int jlo = t0 >= WINL - 1 ? (t0 - (WINL - 1)) >> 6 : 0;
        { int j = jlo;
          const LaneCtx lc{tcol - 4 * qp, bfar, 0ull, 0ull};
          auto next = [&](Blk& bl) -> bool { if (j > cur) return false; bl.K = T.KWp + (size_t)(bk * SEQ + 64 * j) * 64; bl.VT = T.VTw + (size_t)(bk * 128 + j) * 4096; bl.j = j;
              bl.fast = t0 - (64 * j + 63) >= 113 && t0 + 3 - 64 * j < WINL; ++j; return true; };
          run_blocks<16, 1, 64, true, true, false>(next, cur - jlo + 1, lc, qf, lutg, m, l, O, (unsigned)lane * 16u); }
        const float lt = col_total(l), rl = lt > 0.f ? 1.f / lt : 0.f;
        bf16* ap = T.Ab + (size_t)tok * 512 + head * 64 + 4 * qp; const float s2 = g2 * rl;
#pragma unroll
        for (int dt = 0; dt < 4; ++dt) { float a[4];
#pragma unroll
            for (int i = 0; i < 4; ++i) a[i] = aL[(dt * 4 + i) * 64 + lane] + O[dt][i] * s2;
            v2u w; w.x = pk2(a[0], a[1]); w.y = pk2(a[2], a[3]); *(GAS v2u*)(ap + 16 * dt) = w; }
    }
}

struct SAttn { const bf16* Qb; const bf16 *KCs, *VCTs, *KWs, *VTWs, *KSn, *VTSn; const float *ck, *cv; const int* pt; const float* GN; bf16* Ab; };

template <class Pre>
__device__ __forceinline__ void sample_attn_unit(const SAttn& T, int unit, const LAS float* lut, LAS float* imp  , LAS int* sel  , int lane, const Pre& pre) {
    const int b = unit >> 3, kvh = (unit >> 2) & 1, qi = unit & 3, t = PAST + qi, tok = NP + b * DECS + qi, bk = b * 2 + kvh;
    const int r = lane & 15, qp = lane >> 4, g = r & 3, head = kvh * 4 + g;
    const LAS float* lutg = lut + head * 128; const float bfar = lutg[127];
    LAS float* aL = imp + 2048;
    bf16x8 qf[2];
#pragma unroll
    for (int ks = 0; ks < 2; ++ks) qf[ks] = *(const GAS bf16x8*)(T.Qb + (size_t)tok * 512 + head * 64 + 32 * ks + 8 * qp);
    const float* gp = T.GN + (size_t)tok * 32 + kvh * 12 + g * 3;
    const float g0 = gp[0], g1 = gp[1], g2 = gp[2];
    cmp_branch<256>(T.KCs + (size_t)bk * 1024 * 64, T.VCTs + (size_t)bk * 16 * 4096, 16, t, t, true, qf, lutg, bfar, g0, aL, imp, lane);
    { LAS unsigned* impk = (LAS unsigned*)imp; unsigned key[4], rank[4];
#pragma unroll
      for (int jb = 0; jb < 4; ++jb) { const int j = jb * 64 + lane; const unsigned bits = impk[j]; key[jb] = (j >= 1 && j <= 254) ? ((bits & ~255u) | (unsigned)(255 - j)) : 0u; rank[jb] = 0u; }
#pragma unroll
      for (int jb = 0; jb < 4; ++jb) impk[jb * 64 + lane] = key[jb];
      if (lane == 0) { sel[0] = 0; sel[1] = 255; sel[2] = 256; }
      LDS_WAIT(); asm volatile("" ::: "memory");
      const LAS v4u* kq = (const LAS v4u*)impk;
#pragma unroll 4
      for (int k4 = 0; k4 < 64; ++k4) { const v4u kk = kq[k4];
#pragma unroll
          for (int i = 0; i < 4; ++i) rank[i] += (kk.x > key[i] ? 1u : 0u) + (kk.y > key[i] ? 1u : 0u) + (kk.z > key[i] ? 1u : 0u) + (kk.w > key[i] ? 1u : 0u); }
      int base = 3;
#pragma unroll
      for (int jb = 0; jb < 4; ++jb) { const bool tk = key[jb] != 0u && rank[jb] < (unsigned)(NSEL - 3); const unsigned long long bm = __ballot(tk);
          if (tk) sel[base + __popcll(bm & ((1ull << lane) - 1ull))] = jb * 64 + lane;
          base += __popcll(bm); }
      LDS_WAIT(); asm volatile("" ::: "memory"); }
    {
        float m = -3.0e38f, l = 0.f; f32x4 O[4];
#pragma unroll
        for (int dt = 0; dt < 4; ++dt) O[dt] = (f32x4){0.f, 0.f, 0.f, 0.f};
        const int* ptb = T.pt + b * NPAGE;
#pragma unroll 1
        for (int i = 0; i < NSEL; ++i) { const int j = __builtin_amdgcn_readfirstlane(sel[i]);
            const AttnMaskSel mk{t - 64 * j - 4 * qp, true};
            if (j >= 256) { const SrcB src{T.KSn + (size_t)bk * 4096, T.VTSn + (size_t)bk * 4096};
                attn_block<false>(src, qf, lutg, mk, 0.f, m, l, O, r, qp); }
            else { const int page = ptb[j >> 1]; const size_t o = (((size_t)page * PAGE + (j & 1) * 64) * 2 + kvh) * 64; const SrcF src{T.ck + o, T.cv + o};
                if (j <= 253) attn_block<true>(src, qf, lutg, mk, bfar, m, l, O, r, qp);
                else attn_block<false>(src, qf, lutg, mk, 0.f, m, l, O, r, qp); } }
        const float lt = col_total(l), rl = lt > 0.f ? 1.f / lt : 0.f;
        acc_add(aL, O, g1 * rl, lane);
    }
    pre();
    {
        float m = -3.0e38f, l = 0.f; f32x4 O[4];
#pragma unroll
        for (int dt = 0; dt < 4; ++dt) O[dt] = (f32x4){0.f, 0.f, 0.f, 0.f};
        constexpr int WPOS0 = PAST + DECS - (WINL + DECS);
        { int jb = 0;
          const LaneCtx lc{t - WPOS0 - 4 * qp, bfar, 0ull, 0ull};
          auto next = [&](Blk& bl) -> bool { if (jb >= 9) return false; const int pos0 = WPOS0 + 64 * jb; bl.K = T.KWs + (size_t)(bk * 576 + 64 * jb) * 64; bl.VT = T.VTWs + (size_t)(bk * 9 + jb) * 4096; bl.j = jb;
              bl.fast = t - (pos0 + 63) >= 113 && t - pos0 < WINL; ++jb; return true; };
          run_blocks<16, 1, 64, true, false, false>(next, 9, lc, qf, lutg, m, l, O, (unsigned)lane * 16u); }
        const float lt = col_total(l), rl = lt > 0.f ? 1.f / lt : 0.f;
        bf16* ap = T.Ab + (size_t)tok * 512 + head * 64 + 4 * qp; const float s2 = g2 * rl;
#pragma unroll
        for (int dt = 0; dt < 4; ++dt) { float a[4];
#pragma unroll
            for (int i = 0; i < 4; ++i) a[i] = aL[(dt * 4 + i) * 64 + lane] + O[dt][i] * s2;
            if (r < 4) { v2u w; w.x = pk2(a[0], a[1]); w.y = pk2(a[2], a[3]); *(GAS v2u*)(ap + 16 * dt) = w; } }
    }
}


constexpr int N_PHASES = 10;
struct Args { const void* in[28]; float* out; unsigned char* ws; int ph_lo, ph_hi; };
static_assert(sizeof(Args) == 28 * 8 + 8 + 8 + 8, "Args has no padding");

__global__ void __launch_bounds__(NWAVES * 64, 2) nsa_fwd(Args args) {
    extern __shared__ __attribute__((aligned(16))) unsigned char lds_raw[];
    LAS unsigned char* lds = (LAS unsigned char*)lds_raw;
    volatile LAS unsigned* MISC = (volatile LAS unsigned*)(lds + MISC_OFF);
    const int tid = threadIdx.x;
    const int G = gridDim.x, bx = blockIdx.x, NGW = G * NWAVES;
#define PHASE_IDS() int tid_ = threadIdx.x; asm volatile("" : "+v"(tid_)); const int lane = tid_ & 63, wave = __builtin_amdgcn_readfirstlane(tid_ >> 6), gw = bx * NWAVES + wave; (void)lane; (void)gw
    unsigned char* ws = args.ws; float* out = args.out;
    gu32* ctl = (gu32*)(ws + WS_CTL);
    const float* x_prompt = (const float*)args.in[0]; const float* x_sample = (const float*)args.in[1];
    for (int u = tid; u < (LDS_BYTES - LDSCTL_OFF) / 4; u += NWAVES * 64) ((LAS unsigned*)(lds + LDSCTL_OFF))[u] = 0u;
    { const float* rel_bias = (const float*)args.in[26]; LAS float* lut = (LAS float*)(lds + LUT_OFF);
      for (int u = tid; u < 8 * 128; u += NWAVES * 64) { const int h = u >> 7, n = u & 127; int bkt = n;
          if (n >= 16) { bkt = 16; const int th[15] = {19, 21, 24, 27, 31, 35, 40, 46, 52, 59, 67, 77, 87, 99, 113};
#pragma unroll
              for (int i = 0; i < 15; ++i) bkt += (n >= th[i]) ? 1 : 0; }
          lut[u] = rel_bias[bkt * NH + h] * LOG2E; } }
    __syncthreads();
#if MK_N_LAUNCHES == 1
    XcdBarrier bar = xcd_barrier_post((unsigned*)(ctl + CW_BAR), MISC + 8);
#define GRID_BAR() xcd_barrier(bar)
#else
#define GRID_BAR() do {} while (0)
#endif
    const int lo = args.ph_lo, hi = args.ph_hi;
#ifndef PH_MASK
#define PH_MASK 0x3ff
#endif
#define IN(k) ((((PH_MASK) >> (k)) & 1) && lo <= (k) && (k) < hi)
#define BOTH(k) (IN(k) && IN((k) + 1))
#ifdef DBG_REP_PHASE
#define REP(k) ((((DBG_REP_PHASE) >> (k)) & 1) ? 2 : 1)
#else
#define REP(k) 1
#endif
    using pg8::bf16_t;
    bf16* WinT = (bf16*)(ws + WS_WIN); bf16* WnsaT = (bf16*)(ws + WS_WNSA); bf16* WconvT = (bf16*)(ws + WS_WCONV); bf16* WoT = (bf16*)(ws + WS_WO);
    bf16* WupT = (bf16*)(ws + WS_WUP); bf16* WdnT = (bf16*)(ws + WS_WDN); bf16* W1Tk = (bf16*)(ws + WS_W1K); bf16* W1Tv = (bf16*)(ws + WS_W1V);
    bf16* W2Tk = (bf16*)(ws + WS_W2K); bf16* W2Tv = (bf16*)(ws + WS_W2V); float* PE = (float*)(ws + WS_PE);
    bf16* XN = (bf16*)(ws + WS_XN); bf16* Qb = (bf16*)(ws + WS_QB); bf16* CV = (bf16*)(ws + WS_CV); bf16* GAB = (bf16*)(ws + WS_GAB); float* GN = (float*)(ws + WS_GN);
    bf16* CKp = (bf16*)(ws + WS_CKP); bf16* CVp = (bf16*)(ws + WS_CVP); bf16* KSp = (bf16*)(ws + WS_KSP); bf16* KWp = (bf16*)(ws + WS_KWP); bf16* VTs = (bf16*)(ws + WS_VTS); bf16* VTw = (bf16*)(ws + WS_VTW);
    bf16* Gp = (bf16*)(ws + WS_GP); bf16* KCp = (bf16*)(ws + WS_KCP); bf16* VCTp = (bf16*)(ws + WS_VCTP); bf16* Ab = (bf16*)(ws + WS_AB); bf16* Cb = (bf16*)(ws + WS_CB);
    float* M1 = (float*)(ws + WS_M1); bf16* Mb = (bf16*)(ws + WS_MB); float* X1 = (float*)(ws + WS_X1); bf16* X1b = (bf16*)(ws + WS_X1B); float* PSS = (float*)(ws + WS_PSS); bf16* Hb = (bf16*)(ws + WS_H);
    bf16* CKs = (bf16*)(ws + WS_CKS); bf16* CVs = (bf16*)(ws + WS_CVS); bf16* Gs = (bf16*)(ws + WS_GS); bf16* KCs = (bf16*)(ws + WS_KCS); bf16* VCTs = (bf16*)(ws + WS_VCS); bf16* KWs = (bf16*)(ws + WS_KWS); bf16* VTWs = (bf16*)(ws + WS_VTWS); float* PD = (float*)(ws + WS_PD);

    if (IN(0)) for (int rep = 0; rep < REP(0); ++rep) {
        PHASE_IDS();
        LAS float* scr = (LAS float*)(lds + RING_OFF + wave * 16384);
        constexpr int I_IN = 16 * (NIN / 32), I_NSA = 8 * 32, I_CONV = 8 * 32, I_WO = 16 * 32, I_UP = 16 * 128, I_DN = 64 * 32, I_W1 = 32 * 8, I_W2 = 4 * 2;
        constexpr int NT_ITEMS = I_IN + I_NSA + I_CONV + I_WO + I_UP + I_DN + 2 * I_W1 + 2 * I_W2;
        for (int it = gw; it < NT_ITEMS; it += NGW) {
            int r = it;
            if (r < I_IN) { p0_transpose_item<1>((const float*)args.in[11], 1024, INCOLS, NIN, WinT, nullptr, scr, r, lane); continue; } r -= I_IN;
            if (r < I_NSA) { p0_transpose_item<0>((const float*)args.in[20], 512, 1024, 1024, WnsaT, nullptr, scr, r, lane); continue; } r -= I_NSA;
            if (r < I_CONV) { p0_transpose_item<0>((const float*)args.in[21], 512, 1024, 1024, WconvT, nullptr, scr, r, lane); continue; } r -= I_CONV;
            if (r < I_WO) { p0_transpose_item<0>((const float*)args.in[22], 1024, 1024, 1024, WoT, nullptr, scr, r, lane); continue; } r -= I_WO;
            if (r < I_UP) { p0_transpose_item<0>((const float*)args.in[24], 1024, 4096, 4096, WupT, (const float*)args.in[23], scr, r, lane); continue; } r -= I_UP;
            if (r < I_DN) { p0_transpose_item<0>((const float*)args.in[25], 4096, 1024, 1024, WdnT, nullptr, scr, r, lane); continue; } r -= I_DN;
            if (r < I_W1) { p0_transpose_item<0>((const float*)args.in[13], 2048, 256, 256, W1Tk, nullptr, scr, r, lane); continue; } r -= I_W1;
            if (r < I_W1) { p0_transpose_item<0>((const float*)args.in[16], 2048, 256, 256, W1Tv, nullptr, scr, r, lane); continue; } r -= I_W1;
            if (r < I_W2) { p0_transpose_item<0>((const float*)args.in[14], 256, 64, 64, W2Tk, nullptr, scr, r, lane); continue; } r -= I_W2;
            p0_transpose_item<0>((const float*)args.in[17], 256, 64, 64, W2Tv, nullptr, scr, r, lane);
        }
        { const float* g_attn = (const float*)args.in[10];
#pragma unroll 4
          for (int m = gw; m < NP; m += NGW) rms_row_to_bf16(x_prompt + (size_t)m * DM, g_attn, XN + (size_t)m * DM, lane);
          for (int m = NP + gw; m < MTOK; m += NGW) {
              if (m < NP + NSMP) rms_row_to_bf16(x_sample + (size_t)(m - NP) * DM, g_attn, XN + (size_t)m * DM, lane);
              else { GAS v4u* o = (GAS v4u*)(XN + (size_t)m * DM) + lane; o[0] = (v4u){0u, 0u, 0u, 0u}; o[64] = (v4u){0u, 0u, 0u, 0u}; } } }
        for (int it = (wave ^ 5) * G + bx; it < 128; it += NGW) { const int kv = it >> 6, c0 = (it & 63) * 4, c = lane & 3, kp = lane >> 2;
            const float* pe = (const float*)args.in[kv ? 15 : 12]; const float* w1 = (const float*)args.in[kv ? 16 : 13];
            float s = 0.f;
#pragma unroll 32
            for (int i = 0; i < 128; ++i) { const int k = kp + 16 * i; s += pe[k] * w1[(size_t)k * 256 + c0 + c]; }
            s += __shfl_xor(s, 4); s += __shfl_xor(s, 8); s += __shfl_xor(s, 16); s += __shfl_xor(s, 32);
            if (kp == 0) PE[kv * 256 + c0 + c] = s; }
        for (int it = wave * G + bx; it < 2 * DECB * 16; it += NGW) { const int kv = it / (DECB * 16), b = (it / 16) % DECB, part = it & 15;
            const float* src = (const float*)args.in[kv ? 7 : 6] + (size_t)b * WINL * 128; float* dst = out + (kv ? O_SWV : O_SWK) + (size_t)b * WINL * 128;
            f32x4 v[16];
#pragma unroll
            for (int i = 0; i < 16; ++i) { const int j = part * 32 + 2 * i + (lane >> 5); v[i] = *(const GAS f32x4*)(src + (size_t)(j + DECS < WINL ? j + DECS : WINL - 1) * 128 + (lane & 31) * 4); }
#pragma unroll
            for (int i = 0; i < 16; ++i) { const int j = part * 32 + 2 * i + (lane >> 5); if (j < WINL - DECS) *(GAS f32x4*)(dst + (size_t)j * 128 + (lane & 31) * 4) = v[i]; } }
        if (gw < 4) { bf16* p = gw == 0 ? CKp + (size_t)4 * SEQ * 64 : gw == 1 ? CVp + (size_t)4 * SEQ * 64 : gw == 2 ? CKs + (size_t)64 * PAST * 64 : CVs + (size_t)64 * PAST * 64;
            ((GAS v4u*)p)[lane] = (v4u){0u, 0u, 0u, 0u}; ((GAS v4u*)p)[64 + lane] = (v4u){0u, 0u, 0u, 0u}; }
        if (BOTH(0)) GRID_BAR();
    }

    if (IN(1)) for (int rep = 0; rep < REP(1); ++rep) {
        if ((bx & 1) == 0) { PHASE_IDS();
          constexpr int NITEM = 2 * DECB * NPAGE * 4; const int istep = (G >> 1) * NWAVES; const int c = (lane & 31) * 4, kvh = c >> 6, d = c & 63, rsel = lane >> 5;
          const int* ptab = (const int*)args.in[9];
          auto ipage = [&](int it) -> int { const int rem = it % (DECB * NPAGE * 4), b = rem / (NPAGE * 4), pg = (rem / 4) % NPAGE; return b * NPAGE + pg; };
          auto idst = [&](int it) -> bf16* { const int kv = it / (DECB * NPAGE * 4), rem = it % (DECB * NPAGE * 4), b = rem / (NPAGE * 4), pg = (rem / 4) % NPAGE, qt = rem & 3;
              return (kv ? CVs : CKs) + ((size_t)(b * 2 + kvh) * PAST + pg * PAGE + qt * 32 + rsel) * 64 + d; };
          f32x4 va[16], vb[16];
#pragma unroll 1
          for (int itc = (bx >> 1) * NWAVES + wave; itc < NITEM; itc += 64 * istep) {
              const int itl = itc + lane * istep; const int pv = ptab[ipage(itl < NITEM ? itl : itc)];
              const int nleft = (NITEM - itc + istep - 1) / istep, n = nleft < 64 ? nleft : 64;
              auto ld = [&](f32x4 (&v)[16], int k) { const int it = itc + k * istep; const int page = __builtin_amdgcn_readlane(pv, k);
                  const float* s0 = (const float*)args.in[it >= DECB * NPAGE * 4 ? 3 : 2] + ((size_t)page * PAGE + (it & 3) * 32 + rsel) * 128 + c;
#pragma unroll
                  for (int i = 0; i < 16; ++i) v[i] = __builtin_nontemporal_load((const GAS f32x4*)(s0 + (size_t)i * 256)); };
              auto st = [&](const f32x4 (&v)[16], int k) { bf16* dp = idst(itc + k * istep);
#pragma unroll
                  for (int i = 0; i < 16; ++i) { v2u w; w.x = pk2(v[i].x, v[i].y); w.y = pk2(v[i].z, v[i].w); __builtin_nontemporal_store(w, (GAS v2u*)(dp + (size_t)i * 128)); } };
              ld(va, 0); int k = 0;
#pragma unroll 1
              for (int p = n >> 1; p > 0; --p) {
                  ld(vb, k + 1); __builtin_amdgcn_sched_barrier(0); st(va, k);
                  ld(va, k + 2 < n ? k + 2 : k + 1); __builtin_amdgcn_sched_barrier(0); st(vb, k + 1);
                  k += 2;
              }
              if (n & 1) st(va, k);
          }
        }
        { pg8::Gemm g{XN, WinT, MTOK, NIN, DM, DM, DM}; pg8::MixedOrder S; S.init(MTOK, NIN, bx, W_IN_R0);
          pg8::EpiIn E{out, Qb, CV, GAB, GN, CKp, CVp};
          pg8::gemm_phase<pg8::EpiIn, pg8::MixedOrder, true, true>(lds + RING_OFF, g, S, E); }
        GRID_BAR();
#ifndef DBG_NO_CMP
        { pg8::Gemm g{CKs, W1Tk, 65536, 512, 2048, 1024, 2048};
          struct KVOrder { pg8::StaticOrder so; __device__ __forceinline__ bool next(int i, pg8::Unit& u) const { if (!so.next(i, u)) return false; u.aoff = u.pn ? (int)(WS_CVS - WS_CKS) : 0; return true; }
              __device__ __forceinline__ void a_ready(const pg8::Unit&) const {} __device__ __forceinline__ void done(const pg8::Unit&) const {} } S; S.so.init(65536, 512, G, bx);
          pg8::EpiCmp E{Gs, PE, (size_t)65536 * 256};
          pg8::gemm_phase<pg8::EpiCmp, KVOrder, true, true>(lds + RING_OFF, g, S, E);
          { PHASE_IDS(); pg8::Unit u;
            if (S.so.next(wave >> 2, u)) { const int row0 = u.pm * 256 + (wave & 3) * 64;
                if (u.pn == 0) { const SkOutKT Ek{KCs}; skinny_unit<4, 4>(Gs, 256, W2Tk, 256, 256, row0, 0, Ek, lane); }
                else { const SkOutVT Ev{VCTs}; skinny_unit<4, 4, false>(Gs + (size_t)65536 * 256, 256, W2Tv, 256, 256, row0, 0, Ev, lane); } } } }
#endif
        { PHASE_IDS();
        for (int it = wave * G + bx; it < 2 * 64 * 8; it += NGW) { const int kv = it >> 9, rg = (it >> 3) & 63, cg = it & 7;
            const SkHid E{Gp + (size_t)kv * 2048 * 256, PE + kv * 256};
            skinny_unit<2, 2>(kv ? CVp : CKp, 1024, kv ? W1Tv : W1Tk, 2048, 2048, rg * 32, cg * 32, E, lane); }
        for (int it = (wave & 3) * G + bx + (wave < 4 ? 0 : NGW); it < 64 * 10; it += NGW) { const int bk = it / 10, jb = it % 10, b = bk >> 1, kvh = bk & 1, j = jb * 64 + lane;
            const float* kr = nullptr; const float* vr = nullptr;
            if (jb == 9) { if (lane < DECS) { const size_t o = ((size_t)(b * DECS + lane) * 2 + kvh) * 64; kr = out + O_SSK + o; vr = out + O_SSV + o; } }
            else if (j < WINL) { const size_t o = ((size_t)(b * WINL + j) * 2 + kvh) * 64; kr = (const float*)args.in[6] + o; vr = (const float*)args.in[7] + o; }
            else if (j < WINL + DECS) { const size_t o = ((size_t)(b * WINL + (WINL - DECS) + (j - WINL)) * 2 + kvh) * 64; kr = out + O_SWK + o; vr = out + O_SWV + o; }
            bf16* kd = jb == 9 ? KWs + (size_t)64 * 576 * 64 + (size_t)bk * 4096 : KWs + (size_t)(bk * 9 + jb) * 4096;
            bf16* vd = jb == 9 ? VTWs + (size_t)64 * 9 * 4096 + (size_t)bk * 4096 : VTWs + (size_t)(bk * 9 + jb) * 4096;
#pragma unroll 4
            for (int c = 0; c < 8; ++c) { f32x4 a = (f32x4){0.f, 0.f, 0.f, 0.f}, bb = a, x = a, y = a;
                if (kr) { a = *(const GAS f32x4*)(kr + 8 * c); bb = *(const GAS f32x4*)(kr + 8 * c + 4); x = *(const GAS f32x4*)(vr + 8 * c); y = *(const GAS f32x4*)(vr + 8 * c + 4); }
                v4u w; w.x = pk2(a[0], a[1]); w.y = pk2(a[2], a[3]); w.z = pk2(bb[0], bb[1]); w.w = pk2(bb[2], bb[3]); *(GAS v4u*)(kd + ktile_off(lane, 8 * c)) = w;
#pragma unroll
                for (int i = 0; i < 4; ++i) { vd[vtile_off(lane, 8 * c + i)] = f2bf_rne(x[i]); vd[vtile_off(lane, 8 * c + 4 + i)] = f2bf_rne(y[i]); } } }
        { const float* conv_w = (const float*)args.in[18]; const float* conv_b = (const float*)args.in[19]; const float* state_conv = (const float*)args.in[8];
          for (int m = wave < 4 ? NP + NSMP : (wave - 4) * G + bx; m < NP + NSMP; m += 4 * G) {
              const int d0 = lane * 8; float u0[8], u1[8], u2[8], bg[8];
              auto ld8 = [&](const bf16* p, float (&v)[8]) { const v4u w = *(const GAS v4u*)p; v[0] = bflo(w.x); v[1] = bfhi(w.x); v[2] = bflo(w.y); v[3] = bfhi(w.y); v[4] = bflo(w.z); v[5] = bfhi(w.z); v[6] = bflo(w.w); v[7] = bfhi(w.w); };
              auto urow = [&](int row, float (&u)[8]) { float a[8], c[8]; ld8(CV + (size_t)row * 1536 + 512 + d0, a); ld8(CV + (size_t)row * 1536 + 1024 + d0, c);
#pragma unroll
                  for (int i = 0; i < 8; ++i) u[i] = a[i] * c[i]; };
              auto zero8 = [&](float (&u)[8]) {
#pragma unroll
                  for (int i = 0; i < 8; ++i) u[i] = 0.f; };
              auto st8 = [&](const float* p, float (&u)[8]) { const f32x4 a = *(const GAS f32x4*)p, c = *(const GAS f32x4*)(p + 4); u[0] = a.x; u[1] = a.y; u[2] = a.z; u[3] = a.w; u[4] = c.x; u[5] = c.y; u[6] = c.z; u[7] = c.w; };
              urow(m, u2); ld8(CV + (size_t)m * 1536 + d0, bg);
              if (m < NP) { const int t = m & (SEQ - 1);
                  if (t >= 1) urow(m - 1, u1); else zero8(u1);
                  if (t >= 2) urow(m - 2, u0); else zero8(u0);
                  if (t >= SEQ - 2) { float* pc = out + O_PCONV + (size_t)((m >> 13) * 2 + (t - (SEQ - 2))) * CONVD + d0; *(GAS f32x4*)pc = (f32x4){u2[0], u2[1], u2[2], u2[3]}; *(GAS f32x4*)(pc + 4) = (f32x4){u2[4], u2[5], u2[6], u2[7]}; }
              } else { const int tk = m - NP, b = tk >> 2, s = tk & 3;
                  if (s >= 1) urow(m - 1, u1); else st8(state_conv + (size_t)(b * 2 + 1) * CONVD + d0, u1);
                  if (s >= 2) urow(m - 2, u0); else st8(state_conv + (size_t)(b * 2 + s) * CONVD + d0, u0);
                  if (s >= 2) { float* pc = out + O_SCONV + (size_t)(b * 2 + (s - 2)) * CONVD + d0; *(GAS f32x4*)pc = (f32x4){u2[0], u2[1], u2[2], u2[3]}; *(GAS f32x4*)(pc + 4) = (f32x4){u2[4], u2[5], u2[6], u2[7]}; }
              }
              float w0[8], w1[8], w2[8], cb[8]; st8(conv_w + d0, w0); st8(conv_w + CONVD + d0, w1); st8(conv_w + 2 * CONVD + d0, w2); st8(conv_b + d0, cb);
              float y[8];
#pragma unroll
              for (int i = 0; i < 8; ++i) y[i] = bg[i] * (cb[i] + w0[i] * u0[i] + w1[i] * u1[i] + w2[i] * u2[i]);
              v4u w; w.x = pk2(y[0], y[1]); w.y = pk2(y[2], y[3]); w.z = pk2(y[4], y[5]); w.w = pk2(y[6], y[7]);
              *(GAS v4u*)(Cb + (size_t)m * 512 + d0) = w; }
          for (int m = NP + NSMP + gw; m < MTOK; m += NGW) *(GAS v4u*)(Cb + (size_t)m * 512 + lane * 8) = (v4u){0u, 0u, 0u, 0u};
        }
        }
        if (BOTH(1)) GRID_BAR();
    }

    if (IN(3)) for (int rep = 0; rep < REP(3); ++rep) {
        PHASE_IDS();
        for (int it = wave * G + bx; it < 2 * 64; it += NGW) { const int kv = it >> 6, rg = it & 63;
            if (kv == 0) { const SkOutKT E{KCp}; skinny_unit<2, 4>(Gp, 256, W2Tk, 256, 256, rg * 32, 0, E, lane); }
            else { const SkOutVT E{VCTp}; skinny_unit<2, 4, false>(Gp + (size_t)2048 * 256, 256, W2Tv, 256, 256, rg * 32, 0, E, lane); } }
        if (BOTH(3)) GRID_BAR();
    }

    if (IN(4)) for (int rep = 0; rep < REP(4); ++rep) {
        PHASE_IDS();
        const LAS float* lut = (const LAS float*)(lds + LUT_OFF);
        LAS float* slog = (LAS float*)(lds + RING_OFF + wave * 16384);
        LAS float* wscr = (LAS float*)(lds + WSCR_OFF + wave * WSCR_BYTES);
        const PAttn PT{Qb, KSp, KWp, VTs, VTw, KCp, VCTp, GN, Ab};
        const SAttn ST{Qb, KCs, VCTs, KWs, VTWs, KWs + (size_t)64 * 576 * 64, VTWs + (size_t)64 * 9 * 4096, (const float*)args.in[4], (const float*)args.in[5], (const int*)args.in[9], GN, Ab};
        constexpr int NUNITS = 256 + 4 * (SEQ / 4); static_assert(NUNITS % 16 == 0, "queue shards");
#ifdef DBG_NO_ATTN
        for (int m = gw; m < NP + NSMP; m += NGW) *(GAS v4u*)(Ab + (size_t)m * 512 + lane * 8) = (v4u){0u, 0u, 0u, 0u};
#else
        int shard = (bx + wave) & 15, tried = 0, nraw = 0;
        gu32* qbase = ctl + CW_QUEUE + 1024 * rep;
        auto pop_sync = [&]() -> int {
            for (;;) { int t = 0; if (lane == 0) t = (int)__hip_atomic_fetch_add((unsigned*)(qbase + 64 * shard), 1u, RLX_AGENT);
                t = __builtin_amdgcn_readfirstlane(t);
                if (t < NUNITS / 16) return t * 16 + shard;
                if (++tried >= 16) return -1; shard = (shard + 1) & 15; } };
        auto pre = [&]() { if (lane == 0) nraw = (int)__hip_atomic_fetch_add((unsigned*)(qbase + 64 * shard), 1u, RLX_AGENT); };
        int u = pop_sync();
        while (u >= 0) {
            int ln = lane; asm volatile("" : "+v"(ln));
#ifdef DBG_REP4_MODE
            if (rep == 1 && ((DBG_REP4_MODE == 1) ? (u >= 256) : (u < 256))) pre(); else
#endif
            {
#ifndef NO_SAMPLE_ATTN
            if (u < 256) sample_attn_unit(ST, u, lut, slog, (LAS int*)(slog + 1024), ln, pre);
#else
            if (u < 256) pre();
#endif
#ifndef NO_PROMPT_ATTN
            else { const int v = u - 256, bk = v / (SEQ / 4), tg = (SEQ / 4 - 1) - (v % (SEQ / 4));
                prompt_attn_group(PT, bk >> 1, bk & 1, tg * 4, lut, slog, (LAS unsigned*)(slog + 512), ln, pre); }
#else
            else pre();
#endif
            }
            const int nt = __builtin_amdgcn_readfirstlane(nraw);
            if (nt < NUNITS / 16) u = nt * 16 + shard;
            else { if (++tried >= 16) break; shard = (shard + 1) & 15; u = pop_sync(); }
        }
#endif
        for (int m = NP + NSMP + gw; m < MTOK; m += NGW) *(GAS v4u*)(Ab + (size_t)m * 512 + lane * 8) = (v4u){0u, 0u, 0u, 0u};
        if (BOTH(4)) GRID_BAR();
    }

    if (IN(5)) for (int rep = 0; rep < REP(5); ++rep) {
        { pg8::Gemm g{Ab, WnsaT, NP, 2 * DM, 512, 512, 512};
          pg8::PairOrder S; S.init(NP, DM, G, bx, (int)(WS_CB - WS_AB));
          pg8::EpiNC E{GAB, Mb};
          pg8::gemm_phase<pg8::EpiNC, pg8::PairOrder, true, true>(lds + RING_OFF, g, S, E); }
        { PHASE_IDS();
          for (int it = wave * G + bx; it < 2 * 32; it += NGW) { const int row0 = NP + (it >> 5) * 64, col0 = (it & 31) * 32, r = lane & 15, qd = lane >> 4;
              f32x4 a1[4][2], a2[4][2];
#pragma unroll
              for (int a = 0; a < 4; ++a)
#pragma unroll
                  for (int b = 0; b < 2; ++b) { a1[a][b] = (f32x4){0.f, 0.f, 0.f, 0.f}; a2[a][b] = a1[a][b]; }
              const bf16* ap1 = Ab + (size_t)(row0 + r) * 512 + qd * 8; const bf16* ap2 = Cb + (size_t)(row0 + r) * 512 + qd * 8;
              const bf16* bp1 = WnsaT + (size_t)(col0 + r) * 512 + qd * 8; const bf16* bp2 = WconvT + (size_t)(col0 + r) * 512 + qd * 8;
#pragma unroll 2
              for (int k = 0; k < 512; k += 32) { bf16x8 f1[4], f2[4], w1[2], w2[2];
#pragma unroll
                  for (int a = 0; a < 4; ++a) { f1[a] = *(const GAS bf16x8*)(ap1 + (size_t)a * 16 * 512 + k); f2[a] = *(const GAS bf16x8*)(ap2 + (size_t)a * 16 * 512 + k); }
#pragma unroll
                  for (int b = 0; b < 2; ++b) { w1[b] = *(const GAS bf16x8*)(bp1 + (size_t)b * 16 * 512 + k); w2[b] = *(const GAS bf16x8*)(bp2 + (size_t)b * 16 * 512 + k); }
#pragma unroll
                  for (int a = 0; a < 4; ++a)
#pragma unroll
                      for (int b = 0; b < 2; ++b) { a1[a][b] = __builtin_amdgcn_mfma_f32_16x16x32_bf16(w1[b], f1[a], a1[a][b], 0, 0, 0); a2[a][b] = __builtin_amdgcn_mfma_f32_16x16x32_bf16(w2[b], f2[a], a2[a][b], 0, 0, 0); } }
#pragma unroll
              for (int a = 0; a < 4; ++a)
#pragma unroll
                  for (int b = 0; b < 2; ++b) { const int row = row0 + 16 * a + r, col = col0 + 16 * b + 4 * qd;
                      const v2u ga = *(const GAS v2u*)(GAB + (size_t)row * 2048 + col), gb = *(const GAS v2u*)(GAB + (size_t)row * 2048 + 1024 + col);
                      v2u w; w.x = pk2(bflo(ga.x) * a1[a][b][0] + bflo(gb.x) * a2[a][b][0], bfhi(ga.x) * a1[a][b][1] + bfhi(gb.x) * a2[a][b][1]);
                      w.y = pk2(bflo(ga.y) * a1[a][b][2] + bflo(gb.y) * a2[a][b][2], bfhi(ga.y) * a1[a][b][3] + bfhi(gb.y) * a2[a][b][3]);
                      *(GAS v2u*)(Mb + (size_t)row * 1024 + col) = w; } } }
        if (BOTH(5)) GRID_BAR();
    }

    if (IN(6)) for (int rep = 0; rep < REP(6); ++rep) {
        { pg8::Gemm g{Mb, WoT, NP, DM, DM, DM, DM}; pg8::StaticOrder S; S.init(NP, DM, G, bx);
          pg8::EpiWo E{x_prompt, x_sample, X1, X1b, PSS};
          pg8::gemm_phase<pg8::EpiWo, pg8::StaticOrder, false, true>(lds + RING_OFF, g, S, E); }
        { PHASE_IDS();
          for (int it = wave * G + bx; it < 8 * 16; it += NGW) { const int row0 = NP + (it >> 4) * 16, cgp = it & 15;
              const SkWo E{x_sample, X1, X1b, PSS, cgp};
              skinny_unit<1, 4>(Mb, 1024, WoT, 1024, 1024, row0, cgp * 64, E, lane); } }
        if (BOTH(6)) GRID_BAR();
    }

    if (IN(7)) for (int rep = 0; rep < REP(7); ++rep) {
        { pg8::Gemm g{X1b, WupT, NP, DFF, DM, DM, DM}; pg8::StaticOrder S; S.init(NP, DFF, G, bx);
          pg8::EpiUp E{PSS, Hb};
          pg8::gemm_phase<pg8::EpiUp, pg8::StaticOrder, true, true>(lds + RING_OFF, g, S, E); }
        { PHASE_IDS();
          for (int it = wave * G + bx; it < 8 * 64; it += NGW) { const int row0 = NP + (it >> 6) * 16, col0 = (it & 63) * 64;
              const SkUp E{PSS, Hb};
              skinny_unit<1, 4>(X1b, 1024, WupT, 1024, 1024, row0, col0, E, lane); } }
        if (BOTH(7)) GRID_BAR();
    }

    if (IN(8)) for (int rep = 0; rep < REP(8); ++rep) {
        { pg8::Gemm g{Hb, WdnT, NP, DM, DFF, DFF, DFF}; pg8::StaticOrder S; S.init(NP, DM, G, bx);
          pg8::EpiDownNorm E{X1b, out, (const float*)args.in[27], (float*)(ws + WS_PSS2), (unsigned*)(ctl + CW_PANEL), (unsigned*)(ctl + CW_TMO)};
          pg8::gemm_phase<pg8::EpiDownNorm, pg8::StaticOrder, true, true>(lds + RING_OFF, g, S, E); }
        { PHASE_IDS();
          for (int it = wave * G + bx; it < 8 * 16 * 8; it += NGW) { const int kp = it & 7, cgp = (it >> 3) & 15, row0 = NP + (it >> 7) * 16;
              const SkPart E{PD + (size_t)kp * NSMP * 1024 - (size_t)NP * 1024};
              skinny_unit<1, 4>(Hb + kp * 512, 4096, WdnT + kp * 512, 4096, 512, row0, cgp * 64, E, lane); } }
        if (BOTH(8)) GRID_BAR();
    }

#ifdef DBG_DUMP
    if (lo <= 9 && 9 < hi) {
        PHASE_IDS();
        for (int m = gw; m < NP + NSMP; m += NGW) { GAS f32x4* o = (GAS f32x4*)(out + O_YP + (size_t)m * DM) + lane;
#pragma unroll
            for (int j = 0; j < 4; ++j) { const int col = (lane + 64 * j) * 4; f32x4 v;
#if DBG_DUMP == 1
                const v2u w = *(const GAS v2u*)(Mb + (size_t)m * 1024 + col); v = (f32x4){bflo(w.x), bfhi(w.x), bflo(w.y), bfhi(w.y)};
#elif DBG_DUMP == 2
                v = *(const GAS f32x4*)(X1 + (size_t)m * 1024 + col);
#elif DBG_DUMP == 5
                if (col < 512) { const v2u w = *(const GAS v2u*)(Cb + (size_t)m * 512 + col); v = (f32x4){bflo(w.x), bfhi(w.x), bflo(w.y), bfhi(w.y)}; } else { const v2u w = *(const GAS v2u*)(Qb + (size_t)m * 512 + col - 512); v = (f32x4){bflo(w.x), bfhi(w.x), bflo(w.y), bfhi(w.y)}; }
#elif DBG_DUMP == 6
                { const v2u w = *(const GAS v2u*)(GAB + (size_t)m * 2048 + col); v = (f32x4){bflo(w.x), bfhi(w.x), bflo(w.y), bfhi(w.y)}; }
#elif DBG_DUMP == 7
                { const v2u w = *(const GAS v2u*)(GAB + (size_t)m * 2048 + 1024 + col); v = (f32x4){bflo(w.x), bfhi(w.x), bflo(w.y), bfhi(w.y)}; }
#elif DBG_DUMP == 3
                const v2u w = *(const GAS v2u*)(Hb + (size_t)m * 4096 + col); v = (f32x4){bflo(w.x), bfhi(w.x), bflo(w.y), bfhi(w.y)};
#else
                v = *(const GAS f32x4*)(M1 + (size_t)m * 1024 + col);
#endif
                o[64 * j] = v; } }
    }
#endif
    if (IN(9)) {
        PHASE_IDS();
        const float* g_final = (const float*)args.in[27];
        for (int m = NP + wave * G + bx; m < NP + NSMP; m += NGW) { GAS f32x4* xr = (GAS f32x4*)(out + O_YP + (size_t)m * DM) + lane; const GAS f32x4* gr = (const GAS f32x4*)g_final + lane;
            f32x4 v[4]; float s = 0.f;
            if (m >= NP) {
#pragma unroll
                for (int j = 0; j < 4; ++j) { v[j] = ((const GAS f32x4*)(X1 + (size_t)m * DM) + lane)[64 * j];
#pragma unroll
                    for (int kp = 0; kp < 8; ++kp) v[j] += ((const GAS f32x4*)(PD + ((size_t)kp * NSMP + (m - NP)) * DM) + lane)[64 * j]; }
            } else {
#pragma unroll
                for (int j = 0; j < 4; ++j) v[j] = xr[64 * j];
            }
#pragma unroll
            for (int j = 0; j < 4; ++j) s += (v[j].x * v[j].x + v[j].y * v[j].y) + (v[j].z * v[j].z + v[j].w * v[j].w);
            const float rstd = 1.f / sqrtf(wave_sum(s) * (1.f / 1024.f) + RMS_EPS);
#pragma unroll
            for (int j = 0; j < 4; ++j) xr[64 * j] = v[j] * rstd * gr[64 * j]; }
    }
#undef IN
#undef BOTH
}

extern "C" void kernel_launch(void* const* d_in, const int* in_sizes, int n_in, void* d_out, int out_size, void* d_ws, size_t ws_size, hipStream_t stream) {
    static int grid = 0;
    if (grid == 0) {
        if (n_in != 28 || out_size != (int)O_END || ws_size < WS_END) { fprintf(stderr, "kernel_launch: unexpected problem: n_in %d out %d ws %zu (need %zu)\n", n_in, out_size, ws_size, (size_t)WS_END); grid = -1; return; }
        int dev = 0, cus = 0, per_cu = 0;
        if (hipGetDevice(&dev) != hipSuccess || hipDeviceGetAttribute(&cus, hipDeviceAttributeMultiprocessorCount, dev) != hipSuccess) { grid = -1; return; }
        if (hipFuncSetAttribute((const void*)nsa_fwd, hipFuncAttributeMaxDynamicSharedMemorySize, LDS_BYTES) != hipSuccess) { fprintf(stderr, "kernel_launch: hipFuncSetAttribute failed\n"); grid = -1; return; }
        if (hipOccupancyMaxActiveBlocksPerMultiprocessor(&per_cu, (const void*)nsa_fwd, NWAVES * 64, LDS_BYTES) != hipSuccess || per_cu < 1) { fprintf(stderr, "kernel_launch: occupancy query says %d workgroups per CU\n", per_cu); }
        (void)hipGetLastError();
        grid = cus;
    }
    if (grid < 0) return;
    if (hipMemsetAsync((char*)d_ws + WS_CTL, 0, CTL_ZERO_BYTES, stream) != hipSuccess) return;
    Args a{};
    for (int i = 0; i < 28; ++i) a.in[i] = d_in[i];
    a.out = (float*)d_out; a.ws = (unsigned char*)d_ws;
#if MK_N_LAUNCHES == 1
    a.ph_lo = 0; a.ph_hi = N_PHASES;
    hipLaunchKernelGGL(nsa_fwd, dim3(grid), dim3(NWAVES * 64), LDS_BYTES, stream, a);
#else
    for (int p = 0; p < N_PHASES; ++p) { a.ph_lo = p; a.ph_hi = p + 1; hipLaunchKernelGGL(nsa_fwd, dim3(grid), dim3(NWAVES * 64), LDS_BYTES, stream, a); }
#endif
}
```

```cpp
#include <hip/hip_runtime.h>
#include <cstdio>
#include <cstdint>

#ifndef MK_N_LAUNCHES
#define MK_N_LAUNCHES 1
#endif

constexpr int DM = 1024, BATCH = 2, SEQ = 8192, NP = BATCH * SEQ;
constexpr int DECB = 32, DECS = 4, NSMP = DECB * DECS;
constexpr int MTOK = NP + 256;
constexpr int PAST = 16384, PAGE = 128, NPAGE = PAST / PAGE, NPHYS = 5120;
constexpr int NH = 8, HD = 64, NKV = 2, GRP = 4, NSAW = 512, KVW = 128;
constexpr int CMPH = 256, DFF = 4096, CONVD = 512, INCOLS = 4888, NIN = 5120;
constexpr int WINL = 512, NSEL = 16;
constexpr float RMS_EPS = 1e-6f;
constexpr float LOG2E = 1.4426950408889634f;
constexpr float QSCALE = 0.125f * LOG2E;

constexpr size_t O_YP = 0, O_YS = O_YP + (size_t)NP * DM;
constexpr size_t O_PCK = O_YS + (size_t)NSMP * DM, O_PCV = O_PCK + (size_t)NP * KVW, O_PSK = O_PCV + (size_t)NP * KVW, O_PSV = O_PSK + (size_t)NP * KVW;
constexpr size_t O_PWK = O_PSV + (size_t)NP * KVW, O_PWV = O_PWK + (size_t)BATCH * WINL * KVW, O_PCONV = O_PWV + (size_t)BATCH * WINL * KVW;
constexpr size_t O_SCK = O_PCONV + (size_t)BATCH * 2 * CONVD, O_SCV = O_SCK + (size_t)NSMP * KVW, O_SSK = O_SCV + (size_t)NSMP * KVW, O_SSV = O_SSK + (size_t)NSMP * KVW;
constexpr size_t O_SWK = O_SSV + (size_t)NSMP * KVW, O_SWV = O_SWK + (size_t)DECB * WINL * KVW, O_SCONV = O_SWV + (size_t)DECB * WINL * KVW;
constexpr size_t O_END = O_SCONV + (size_t)DECB * 2 * CONVD;
static_assert(O_END == 29853696, "d_out map");

constexpr size_t MiB = 1u << 20;
constexpr size_t WS_CTL = 0, CTL_ZERO_BYTES = 1 * MiB;
constexpr size_t WS_WIN = 2 * MiB;
constexpr size_t WS_WNSA = 12 * MiB;
constexpr size_t WS_WCONV = 13 * MiB;
constexpr size_t WS_WO = 14 * MiB;
constexpr size_t WS_WUP = 16 * MiB;
constexpr size_t WS_WDN = 24 * MiB;
constexpr size_t WS_W1K = 32 * MiB, WS_W1V = 33 * MiB;
constexpr size_t WS_W2K = 34 * MiB, WS_W2V = 34 * MiB + 65536;
constexpr size_t WS_PE = 34 * MiB + 131072;
constexpr size_t WS_XN = 36 * MiB;
constexpr size_t WS_QB = 70 * MiB;
constexpr size_t WS_CV = 88 * MiB;
constexpr size_t WS_GAB = 138 * MiB;
constexpr size_t WS_GN = 204 * MiB;
constexpr size_t WS_CKP = 208 * MiB, WS_KSP = 213 * MiB, WS_KWP = 218 * MiB;
constexpr size_t WS_CVP = 223 * MiB, WS_VTS = 228 * MiB, WS_VTW = 233 * MiB;
constexpr size_t KV3_STRIDE = 5 * MiB;
constexpr size_t WS_GP = 238 * MiB;
constexpr size_t WS_KCP = 240 * MiB;
constexpr size_t WS_VCTP = 241 * MiB;
constexpr size_t WS_AB = 242 * MiB;
constexpr size_t WS_CB = 259 * MiB;
constexpr size_t WS_M1 = 276 * MiB;
constexpr size_t WS_MB = 342 * MiB;
constexpr size_t WS_X1 = 375 * MiB;
constexpr size_t WS_X1B = 441 * MiB;
constexpr size_t WS_PSS = 474 * MiB;
constexpr size_t WS_H = 476 * MiB;
constexpr size_t WS_CKS = 608 * MiB, WS_CVS = 738 * MiB;
constexpr size_t WS_GS = 868 * MiB;
constexpr size_t WS_KCS = 932 * MiB, WS_VCS = 948 * MiB;
constexpr size_t WS_KWS = 964 * MiB, WS_VTWS = 970 * MiB;
constexpr size_t WS_PD = 976 * MiB;
constexpr size_t WS_PSS2 = 982 * MiB;
constexpr size_t WS_END = 984 * MiB;
constexpr int CW_TMO = 0, CW_QUEUE = 64, CW_BAR = 4096, CW_PANEL = 32768;

constexpr int RING_OFF = 0, RING_BYTES = 131072;
constexpr int LUTS = 324, LUT0 = 67;
constexpr int LUT_OFF = RING_BYTES, LUT_BYTES = 8 * LUTS * 4;
constexpr int WSCR_OFF = LUT_OFF + LUT_BYTES, WSCR_BYTES = 2304;
constexpr int LDSCTL_OFF = WSCR_OFF + 8 * WSCR_BYTES, MISC_OFF = LDSCTL_OFF + 320;
constexpr int LDS_BYTES = 160768;
static_assert(MISC_OFF + 128 <= LDS_BYTES && LDS_BYTES <= 163840, "LDS map");
constexpr int NWAVES = 8;
#ifndef W_IN_R0
#define W_IN_R0 7
#endif

namespace pg8 {
#define PG8_LAS __attribute__((address_space(3)))
typedef unsigned short bf16_t;
typedef short bf16x8 __attribute__((ext_vector_type(8)));
typedef float f32x4 __attribute__((ext_vector_type(4)));
typedef unsigned u32x4 __attribute__((ext_vector_type(4)));
constexpr int BM = 256, BK = 64, HALF = 128, HTB = HALF * BK * 2  , STAGE_BYTES = 8 * HTB, NXCD = 8, WGM = 8;

__host__ __device__ __forceinline__ int lds_byte(int r, int c) { const int st = (r >> 4) * 2 + (c >> 5), rr = r & 15, cc = c & 31, ob = rr * 64 + cc * 2; return st * 1024 + (ob ^ (((ob >> 9) & 1) << 5)); }
__host__ __device__ __forceinline__ void stage_rc(int b, int& R, int& C) { const int st = b / 1024, sb = b % 1024, swz = sb ^ (((sb >> 9) & 1) << 5); R = (st >> 1) * 16 + swz / 64; C = (st & 1) * 32 + (swz % 64) / 2; }
__host__ __device__ __forceinline__ int perm32(int rho) { const int n = rho >> 4, i = rho & 15; return 8 * (i >> 2) + 4 * n + (i & 3); }

struct Unit { int pm, pn, aoff; };
struct Gemm { const bf16_t* A; const bf16_t* Bt; int M, N, K, lda, ldb; };

struct StaticOrder {
    int nM, nN, nwg, G, c;
    __host__ __device__ void init(int M, int N, int G_, int c_) { nM = M / BM; nN = N / BM; nwg = nM * nN; G = G_; c = c_; }
    __host__ __device__ __forceinline__ bool next(int i, Unit& u) const {
        const long L = (long)i * G + c; if (L >= nwg) return false;
        int wgid = (int)L; { const int q = nwg / NXCD, r = nwg % NXCD, xcd = wgid % NXCD, off = wgid / NXCD; wgid = (xcd < r ? xcd * (q + 1) : r * (q + 1) + (xcd - r) * q) + off; }
        const int nig = WGM * nN, gid = wgid / nig, fm = gid * WGM, gsz = (nM - fm) < WGM ? (nM - fm) : WGM;
        u.pm = fm + ((wgid % nig) % gsz); u.pn = (wgid % nig) / gsz; u.aoff = 0; return true;
    }
    __device__ __forceinline__ void a_ready(const Unit&) const {}
    __device__ __forceinline__ void done(const Unit&) const {}
};

typedef float f32x2_t __attribute__((ext_vector_type(2)));
typedef __bf16 bf16x2_t __attribute__((ext_vector_type(2)));
__device__ __forceinline__ unsigned cvt_pk_bf16(float lo, float hi) { f32x2_t v = {lo, hi}; bf16x2_t b = __builtin_convertvector(v, bf16x2_t); return __builtin_bit_cast(unsigned, b); }
struct MixedOrder {
    int nM, nN, nwg, c, R0; bool conv;
    __host__ __device__ void init(int M, int N, int c_, int R0_) { nM = M / BM; nN = N / BM; nwg = nM * nN; c = c_; R0 = R0_; conv = (c_ & 1) == 0; }
    __host__ __device__ __forceinline__ bool next(int i, Unit& u) const {
        const long L = conv ? (long)R0 * 128 + (long)i * 256 + c : (i < R0 ? (long)i * 128 + (c >> 1) : (long)R0 * 128 + (long)(i - R0) * 256 + c);
        if (L >= nwg) return false;
        int wgid = (int)L; { const int q = nwg / NXCD, r = nwg % NXCD, xcd = wgid % NXCD, off = wgid / NXCD; wgid = (xcd < r ? xcd * (q + 1) : r * (q + 1) + (xcd - r) * q) + off; }
        const int nig = WGM * nN, gid = wgid / nig, fm = gid * WGM, gsz = (nM - fm) < WGM ? (nM - fm) : WGM;
        u.pm = fm + ((wgid % nig) % gsz); u.pn = (wgid % nig) / gsz; u.aoff = 0; return true;
    }
    __device__ __forceinline__ void a_ready(const Unit&) const {}
    __device__ __forceinline__ void done(const Unit&) const {}
};
typedef unsigned u32x2 __attribute__((ext_vector_type(2)));
__device__ __forceinline__ float sigmoid_f(float x) { return __builtin_amdgcn_rcpf(1.f + __builtin_amdgcn_exp2f(x * -1.4426950408889634f)); }
__device__ __forceinline__ float gelu_tanh_f(float x) {
    const float u2 = x * (1.5957691216057308f + 0.07135481627263f * x * x);
    return x * __builtin_amdgcn_rcpf(1.f + __builtin_amdgcn_exp2f(u2 * -1.4426950408889634f));
}
__device__ __forceinline__ float bf2f(unsigned short h) { return __builtin_bit_cast(float, (unsigned)h << 16); }
__device__ __forceinline__ float bflo(unsigned w) { return __builtin_bit_cast(float, w << 16); }
__device__ __forceinline__ float bfhi(unsigned w) { return __builtin_bit_cast(float, w & 0xffff0000u); }
__device__ __forceinline__ unsigned short f2bf_rne(float f) { unsigned u = __builtin_bit_cast(unsigned, f); return (unsigned short)((u + 0x7fffu + ((u >> 16) & 1u)) >> 16); }
__device__ __forceinline__ u32x4 pack8(const f32x4& a, const f32x4& b) { u32x4 w; w.x = cvt_pk_bf16(a[0], a[1]); w.y = cvt_pk_bf16(a[2], a[3]); w.z = cvt_pk_bf16(b[0], b[1]); w.w = cvt_pk_bf16(b[2], b[3]); return w; }
__device__ __forceinline__ int kperm64(int k) { return (k & 32) + 8 * ((k >> 2) & 3) + 4 * ((k >> 4) & 1) + (k & 3); }
__device__ __forceinline__ int ktile_off(int key, int d) { return ((key >> 4) * 2 + (d >> 5)) * 512 + (((d >> 3) & 3) * 16 + (key & 15)) * 8 + (d & 7); }
__device__ __forceinline__ int vtile_off(int key, int d) { const int p = kperm64(key); return ((d >> 4) * 2 + (p >> 5)) * 512 + (((p >> 3) & 3) * 16 + (d & 15)) * 8 + (p & 7); }

#ifdef DBG_NO_SIG
#define SIGF(x) (x)
#else
#define SIGF(x) sigmoid_f(x)
#endif
__device__ __forceinline__ int vtile8_off(int key, int d) { const int p = kperm64(key); return ((d >> 4) * 64 + ((p >> 3) & 3) * 16 + (d & 15)) * 16 + (p >> 5) * 8 + (p & 7); }
__device__ __forceinline__ int ktile8_off(int key, int d) { return ((key >> 4) * 64 + ((d >> 3) & 3) * 16 + (key & 15)) * 16 + (d >> 5) * 8 + (d & 7); }
__device__ __forceinline__ unsigned char f2fp8(float x) { return (unsigned char)(__builtin_amdgcn_cvt_pk_fp8_f32(x, 0.f, 0, false) & 0xff); }
struct EpiIn {
    static constexpr bool PERM = true, AFTER_DRAIN = false;
    __device__ __forceinline__ bool reset_acc(const Unit&) const { return true; }
    float* out; bf16_t *Qb, *CV, *GAB; float* GN; bf16_t *K3, *V3;
    __device__ __forceinline__ void operator()(const f32x4 (&acc)[2][2][4][2], const Unit& u, int wr, int wc, int fr, int fq) const {
        const int pn = u.pn, rbase = u.pm * BM + wr * 64 + fr, cw = wc * 32 + fq * 8;
        if (pn < 2) {
#pragma unroll
            for (int ai = 0; ai < 2; ++ai)
#pragma unroll
                for (int m = 0; m < 4; ++m) { const int row = rbase + ai * HALF + m * 16; bf16_t* p = Qb + (size_t)row * 512 + pn * 256 + cw;
#pragma unroll
                    for (int bj = 0; bj < 2; ++bj) *(u32x4*)(p + bj * HALF) = pack8(acc[ai][bj][m][0] * QSCALE, acc[ai][bj][m][1] * QSCALE); }
        } else if (pn < 5) {
            const int kvh = wc >> 1, d0 = cw & 63;
#pragma unroll
            for (int ai = 0; ai < 2; ++ai)
#pragma unroll
                for (int m = 0; m < 4; ++m) { const int row = rbase + ai * HALF + m * 16;
                    if (row < NP) {
                        const int b = row >> 13, t = row & (SEQ - 1);
                        float *fk, *fv;
                        if (pn == 2) { fk = out + O_PCK + (size_t)row * 128; fv = out + O_PCV + (size_t)row * 128; }
                        else if (pn == 3) { fk = out + O_PSK + (size_t)row * 128; fv = out + O_PSV + (size_t)row * 128; }
                        else { const bool w = t >= SEQ - WINL; const size_t o = (size_t)(b * WINL + (t - (SEQ - WINL))) * 128; fk = w ? out + O_PWK + o : nullptr; fv = w ? out + O_PWV + o : nullptr; }
                        if (fk) { *(f32x4*)(fk + cw) = acc[ai][0][m][0]; *(f32x4*)(fk + cw + 4) = acc[ai][0][m][1]; *(f32x4*)(fv + cw) = acc[ai][1][m][0]; *(f32x4*)(fv + cw + 4) = acc[ai][1][m][1]; }
                        bf16_t* kd = K3 + (size_t)(pn - 2) * (KV3_STRIDE / 2); bf16_t* vd = V3 + (size_t)(pn - 2) * (KV3_STRIDE / 2);
                        if (pn == 2) { const size_t ro = ((size_t)(b * 2 + kvh) * SEQ + t) * 64 + d0;
                            *(u32x4*)(kd + ro) = pack8(acc[ai][0][m][0], acc[ai][0][m][1]); *(u32x4*)(vd + ro) = pack8(acc[ai][1][m][0], acc[ai][1][m][1]); }
                        else { const size_t blk = ((size_t)(b * 2 + kvh) * 128 + (t >> 6)) * 4096;
                            { const f32x4 ka = acc[ai][0][m][0], kb = acc[ai][0][m][1]; int w0 = 0, w1 = 0;
                              w0 = __builtin_amdgcn_cvt_pk_fp8_f32(ka[0], ka[1], w0, false); w0 = __builtin_amdgcn_cvt_pk_fp8_f32(ka[2], ka[3], w0, true);
                              w1 = __builtin_amdgcn_cvt_pk_fp8_f32(kb[0], kb[1], w1, false); w1 = __builtin_amdgcn_cvt_pk_fp8_f32(kb[2], kb[3], w1, true);
                              u32x2 kw; kw.x = (unsigned)w0; kw.y = (unsigned)w1; *(u32x2*)((unsigned char*)(kd + blk) + ktile8_off(t & 63, d0)) = kw; }
                            unsigned char* vt = (unsigned char*)(vd + blk);
#pragma unroll
                            for (int n = 0; n < 2; ++n)
#pragma unroll
                                for (int i = 0; i < 4; ++i) vt[vtile8_off(t & 63, d0 + n * 4 + i)] = f2fp8(acc[ai][1][m][n][i]); }
                    } else if (row < NP + NSMP) {
                        const int tk = row - NP, bs = tk >> 2, s = tk & 3;
                        float *fk, *fv;
                        if (pn == 2) { fk = out + O_SCK + (size_t)tk * 128; fv = out + O_SCV + (size_t)tk * 128; }
                        else if (pn == 3) { fk = out + O_SSK + (size_t)tk * 128; fv = out + O_SSV + (size_t)tk * 128; }
                        else { const size_t o = (size_t)(bs * WINL + (WINL - DECS) + s) * 128; fk = out + O_SWK + o; fv = out + O_SWV + o; }
                        *(f32x4*)(fk + cw) = acc[ai][0][m][0]; *(f32x4*)(fk + cw + 4) = acc[ai][0][m][1]; *(f32x4*)(fv + cw) = acc[ai][1][m][0]; *(f32x4*)(fv + cw + 4) = acc[ai][1][m][1];
                    }
                }
        } else if (pn < 11) {
#pragma unroll
            for (int ai = 0; ai < 2; ++ai)
#pragma unroll
                for (int m = 0; m < 4; ++m) { const int row = rbase + ai * HALF + m * 16; bf16_t* p = CV + (size_t)row * 1536 + (pn - 5) * 256 + cw;
#pragma unroll
                    for (int bj = 0; bj < 2; ++bj) *(u32x4*)(p + bj * HALF) = pack8(acc[ai][bj][m][0], acc[ai][bj][m][1]); }
        } else if (pn < 19) {
#pragma unroll
            for (int ai = 0; ai < 2; ++ai)
#pragma unroll
                for (int m = 0; m < 4; ++m) { const int row = rbase + ai * HALF + m * 16; bf16_t* p = GAB + (size_t)row * 2048 + (pn - 11) * 256 + cw;
#pragma unroll
                    for (int bj = 0; bj < 2; ++bj) { f32x4 a = acc[ai][bj][m][0], b = acc[ai][bj][m][1];
#pragma unroll
                        for (int i = 0; i < 4; ++i) { a[i] = SIGF(a[i]); b[i] = SIGF(b[i]); }
                        *(u32x4*)(p + bj * HALF) = pack8(a, b); } }
        } else {
            if (wc == 0 && fq < 3) {
#pragma unroll
                for (int ai = 0; ai < 2; ++ai)
#pragma unroll
                    for (int m = 0; m < 4; ++m) { const int row = rbase + ai * HALF + m * 16; float* p = GN + (size_t)row * 32 + cw;
#pragma unroll
                        for (int n = 0; n < 2; ++n) { f32x4 a = acc[ai][0][m][n];
#pragma unroll
                            for (int i = 0; i < 4; ++i) a[i] = sigmoid_f(a[i]);
                            *(f32x4*)(p + 4 * n) = a; } }
            }
        }
    }
};

struct EpiCmp {
    static constexpr bool PERM = true, AFTER_DRAIN = false;
    __device__ __forceinline__ bool reset_acc(const Unit&) const { return true; }
    bf16_t* G; const float* pe; size_t gstride;
    __device__ __forceinline__ void operator()(const f32x4 (&acc)[2][2][4][2], const Unit& u, int wr, int wc, int fr, int fq) const {
        const int rbase = u.pm * BM + wr * 64 + fr, cw = wc * 32 + fq * 8; const float* pe = this->pe + u.pn * 256; bf16_t* G = this->G + (size_t)u.pn * gstride;
        f32x4 pv[2][2];
#pragma unroll
        for (int bj = 0; bj < 2; ++bj)
#pragma unroll
            for (int n = 0; n < 2; ++n) pv[bj][n] = *(const f32x4*)(pe + bj * HALF + cw + 4 * n);
#pragma unroll
        for (int ai = 0; ai < 2; ++ai)
#pragma unroll
            for (int m = 0; m < 4; ++m) { const int row = rbase + ai * HALF + m * 16; bf16_t* p = G + (size_t)row * 256 + cw;
#pragma unroll
                for (int bj = 0; bj < 2; ++bj) { f32x4 a = acc[ai][bj][m][0] + pv[bj][0], b = acc[ai][bj][m][1] + pv[bj][1];
#pragma unroll
                    for (int i = 0; i < 4; ++i) { a[i] = gelu_tanh_f(a[i]); b[i] = gelu_tanh_f(b[i]); }
                    *(u32x4*)(p + bj * HALF) = pack8(a, b); } }
    }
};

struct PairOrder {
    StaticOrder so; int npn, aoff;
    __host__ __device__ void init(int M, int N, int G_, int c_, int aoff_) { so.init(M, N, G_, c_); npn = N / BM; aoff = aoff_; }
    __host__ __device__ __forceinline__ bool next(int i, Unit& u) const { if (i >= 2 || !so.next(0, u)) return false; if (i == 1) { u.pn += npn; u.aoff = aoff; } return true; }
    __device__ __forceinline__ void a_ready(const Unit&) const {}
    __device__ __forceinline__ void done(const Unit&) const {}
};
struct EpiNC {
    static constexpr bool PERM = true, AFTER_DRAIN = false;
    const bf16_t* GAB; bf16_t* Mb;
    __device__ __forceinline__ bool reset_acc(const Unit& u) const { return u.pn >= 4; }
    __device__ __forceinline__ void operator()(f32x4 (&acc)[2][2][4][2], const Unit& u, int wr, int wc, int fr, int fq) const {
        const bool first = u.pn < 4; const int rbase = u.pm * BM + wr * 64 + fr, c0 = (u.pn & 3) * BM + wc * 32 + fq * 8;
#pragma unroll
        for (int ai = 0; ai < 2; ++ai)
#pragma unroll
            for (int m = 0; m < 4; ++m) { const int row = rbase + ai * HALF + m * 16;
#pragma unroll
                for (int bj = 0; bj < 2; ++bj) { const int col = c0 + bj * HALF; const u32x4 gb = *(const u32x4*)(GAB + (size_t)row * 2048 + 1024 + col);
                    float sb[8] = {bflo(gb.x), bfhi(gb.x), bflo(gb.y), bfhi(gb.y), bflo(gb.z), bfhi(gb.z), bflo(gb.w), bfhi(gb.w)};
                    if (first) { const u32x4 ga = *(const u32x4*)(GAB + (size_t)row * 2048 + col);
                        const float sa[8] = {bflo(ga.x), bfhi(ga.x), bflo(ga.y), bfhi(ga.y), bflo(ga.z), bfhi(ga.z), bflo(ga.w), bfhi(ga.w)};
#pragma unroll
                        for (int i = 0; i < 4; ++i) { acc[ai][bj][m][0][i] *= sa[i] * __builtin_amdgcn_rcpf(sb[i]); acc[ai][bj][m][1][i] *= sa[4 + i] * __builtin_amdgcn_rcpf(sb[4 + i]); }
                    } else { f32x4 a = acc[ai][bj][m][0], b = acc[ai][bj][m][1];
#pragma unroll
                        for (int i = 0; i < 4; ++i) { a[i] *= sb[i]; b[i] *= sb[4 + i]; }
                        *(u32x4*)(Mb + (size_t)row * 1024 + col) = pack8(a, b); } } }
    }
};
struct EpiNsa {
    static constexpr bool PERM = true, AFTER_DRAIN = false;
    __device__ __forceinline__ bool reset_acc(const Unit&) const { return true; }
    float* M1; const bf16_t* GAB;
    __device__ __forceinline__ void operator()(const f32x4 (&acc)[2][2][4][2], const Unit& u, int wr, int wc, int fr, int fq) const {
        const int rbase = u.pm * BM + wr * 64 + fr, c0 = u.pn * BM + wc * 32 + fq * 8;
#pragma unroll
        for (int ai = 0; ai < 2; ++ai)
#pragma unroll
            for (int m = 0; m < 4; ++m) { const int row = rbase + ai * HALF + m * 16;
#pragma unroll
                for (int bj = 0; bj < 2; ++bj) { const int col = c0 + bj * HALF; const u32x4 g = *(const u32x4*)(GAB + (size_t)row * 2048 + col);
                    f32x4 a = acc[ai][bj][m][0], b = acc[ai][bj][m][1];
                    a[0] *= bflo(g.x); a[1] *= bfhi(g.x); a[2] *= bflo(g.y); a[3] *= bfhi(g.y); b[0] *= bflo(g.z); b[1] *= bfhi(g.z); b[2] *= bflo(g.w); b[3] *= bfhi(g.w);
                    float* p = M1 + (size_t)row * 1024 + col; *(f32x4*)p = a; *(f32x4*)(p + 4) = b; } }
    }
};
struct EpiConv {
    static constexpr bool PERM = true, AFTER_DRAIN = false;
    __device__ __forceinline__ bool reset_acc(const Unit&) const { return true; }
    const float* M1; const bf16_t* GAB; bf16_t* Mb;
    __device__ __forceinline__ void operator()(const f32x4 (&acc)[2][2][4][2], const Unit& u, int wr, int wc, int fr, int fq) const {
        const int rbase = u.pm * BM + wr * 64 + fr, c0 = u.pn * BM + wc * 32 + fq * 8;
#pragma unroll
        for (int ai = 0; ai < 2; ++ai)
#pragma unroll
            for (int m = 0; m < 4; ++m) { const int row = rbase + ai * HALF + m * 16;
#pragma unroll
                for (int bj = 0; bj < 2; ++bj) { const int col = c0 + bj * HALF; const u32x4 g = *(const u32x4*)(GAB + (size_t)row * 2048 + 1024 + col);
                    const float* p = M1 + (size_t)row * 1024 + col;
#ifdef DBG_NO_M1
                    f32x4 a = (f32x4){0.f, 0.f, 0.f, 0.f}, b = a; (void)p;
#else
                    f32x4 a = *(const f32x4*)p, b = *(const f32x4*)(p + 4);
#endif
                    const f32x4 x = acc[ai][bj][m][0], y = acc[ai][bj][m][1];
                    a[0] += x[0] * bflo(g.x); a[1] += x[1] * bfhi(g.x); a[2] += x[2] * bflo(g.y); a[3] += x[3] * bfhi(g.y); b[0] += y[0] * bflo(g.z); b[1] += y[1] * bfhi(g.z); b[2] += y[2] * bflo(g.w); b[3] += y[3] * bfhi(g.w);
                    *(u32x4*)(Mb + (size_t)row * 1024 + col) = pack8(a, b); } }
    }
};
struct EpiWo {
    static constexpr bool PERM = true, AFTER_DRAIN = false;
    __device__ __forceinline__ bool reset_acc(const Unit&) const { return true; }
    const float *xp, *xs; float* X1; bf16_t* X1b; float* PSS;
    __device__ __forceinline__ void operator()(const f32x4 (&acc)[2][2][4][2], const Unit& u, int wr, int wc, int fr, int fq) const {
        const int rbase = u.pm * BM + wr * 64 + fr, c0 = u.pn * BM + wc * 32 + fq * 8;
#pragma unroll
        for (int ai = 0; ai < 2; ++ai)
#pragma unroll
            for (int m = 0; m < 4; ++m) { const int row = rbase + ai * HALF + m * 16;
                const float* xr = row < NP ? xp + (size_t)row * 1024 : (row < NP + NSMP ? xs + (size_t)(row - NP) * 1024 : nullptr);
                float ss = 0.f;
#pragma unroll
                for (int bj = 0; bj < 2; ++bj) { const int col = c0 + bj * HALF;
                    f32x4 a = acc[ai][bj][m][0], b = acc[ai][bj][m][1];
                    if (xr) { a += *(const f32x4*)(xr + col); b += *(const f32x4*)(xr + col + 4); }
                    *(u32x4*)(X1b + (size_t)row * 1024 + col) = pack8(a, b);
                    ss += (a[0] * a[0] + a[1] * a[1]) + (a[2] * a[2] + a[3] * a[3]) + (b[0] * b[0] + b[1] * b[1]) + (b[2] * b[2] + b[3] * b[3]); }
                ss += __shfl_xor(ss, 16); ss += __shfl_xor(ss, 32);
                if (fq == 0) PSS[(size_t)row * 16 + u.pn * 4 + wc] = ss; }
    }
};
struct EpiUp {
    static constexpr bool PERM = true, AFTER_DRAIN = false;
    __device__ __forceinline__ bool reset_acc(const Unit&) const { return true; }
    const float* PSS; bf16_t* H;
    __device__ __forceinline__ void operator()(const f32x4 (&acc)[2][2][4][2], const Unit& u, int wr, int wc, int fr, int fq) const {
        const int rbase = u.pm * BM + wr * 64 + fr, c0 = u.pn * BM + wc * 32 + fq * 8;
#pragma unroll
        for (int ai = 0; ai < 2; ++ai)
#pragma unroll
            for (int m = 0; m < 4; ++m) { const int row = rbase + ai * HALF + m * 16;
                const f32x4* ps = (const f32x4*)(PSS + (size_t)row * 16); const f32x4 s0 = ps[0], s1 = ps[1], s2 = ps[2], s3 = ps[3];
                const float ssum = (((s0[0] + s0[1]) + (s0[2] + s0[3])) + ((s1[0] + s1[1]) + (s1[2] + s1[3]))) + (((s2[0] + s2[1]) + (s2[2] + s2[3])) + ((s3[0] + s3[1]) + (s3[2] + s3[3])));
                const float rstd = __builtin_amdgcn_rsqf(ssum * (1.f / 1024.f) + RMS_EPS);
#pragma unroll
                for (int bj = 0; bj < 2; ++bj) { f32x4 a = acc[ai][bj][m][0] * rstd, b = acc[ai][bj][m][1] * rstd;
#pragma unroll
                    for (int i = 0; i < 4; ++i) { a[i] = a[i] > 0.f ? a[i] * a[i] : 0.f; b[i] = b[i] > 0.f ? b[i] * b[i] : 0.f; }
                    *(u32x4*)(H + (size_t)row * 4096 + c0 + bj * HALF) = pack8(a, b); } }
    }
};
struct EpiDownNorm {
    static constexpr bool PERM = true, AFTER_DRAIN = false;
    __device__ __forceinline__ bool reset_acc(const Unit&) const { return true; }
    const bf16_t* X1b; float* out; const float* gf; float* PSS2; unsigned* cnt; unsigned* tmo;
    __device__ __forceinline__ void operator()(f32x4 (&acc)[2][2][4][2], const Unit& u, int wr, int wc, int fr, int fq) const {
        const int rbase = u.pm * BM + wr * 64 + fr, c0 = u.pn * BM + wc * 32 + fq * 8;
#pragma unroll
        for (int ai = 0; ai < 2; ++ai)
#pragma unroll
            for (int m = 0; m < 4; ++m) { const int row = rbase + ai * HALF + m * 16; float ss = 0.f;
#pragma unroll
                for (int bj = 0; bj < 2; ++bj) { const int col = c0 + bj * HALF; const u32x4 g = *(const u32x4*)(X1b + (size_t)row * 1024 + col);
                    f32x4 a = acc[ai][bj][m][0], b = acc[ai][bj][m][1];
                    a[0] += bflo(g.x); a[1] += bfhi(g.x); a[2] += bflo(g.y); a[3] += bfhi(g.y); b[0] += bflo(g.z); b[1] += bfhi(g.z); b[2] += bflo(g.w); b[3] += bfhi(g.w);
                    acc[ai][bj][m][0] = a; acc[ai][bj][m][1] = b;
                    ss += (a[0] * a[0] + a[1] * a[1]) + (a[2] * a[2] + a[3] * a[3]) + (b[0] * b[0] + b[1] * b[1]) + (b[2] * b[2] + b[3] * b[3]); }
                ss += __shfl_xor(ss, 16); ss += __shfl_xor(ss, 32);
                if (fq == 0) __hip_atomic_store(PSS2 + (size_t)row * 16 + u.pn * 4 + wc, ss, __ATOMIC_RELAXED, __HIP_MEMORY_SCOPE_AGENT); }
        asm volatile("s_waitcnt vmcnt(0)" ::: "memory");
        unsigned* c = cnt + 64 * u.pm;
        if ((threadIdx.x & 63) == 0) {
            (void)__hip_atomic_fetch_add(c, 1u, __ATOMIC_RELAXED, __HIP_MEMORY_SCOPE_AGENT);
            unsigned sp = 0;
            while (__hip_atomic_load(c, __ATOMIC_RELAXED, __HIP_MEMORY_SCOPE_AGENT) < 32u) { __builtin_amdgcn_s_sleep(1);
                if (++sp > (1u << 22)) { __hip_atomic_store(tmo, 1u, __ATOMIC_RELAXED, __HIP_MEMORY_SCOPE_AGENT); break; } }
        }
        __builtin_amdgcn_fence(__ATOMIC_ACQUIRE, "agent");
        asm volatile("s_waitcnt vmcnt(0)" ::: "memory");
#pragma unroll
        for (int ai = 0; ai < 2; ++ai)
#pragma unroll
            for (int m = 0; m < 4; ++m) { const int row = rbase + ai * HALF + m * 16;
                const f32x4* ps = (const f32x4*)(PSS2 + (size_t)row * 16); const f32x4 s0 = ps[0], s1 = ps[1], s2 = ps[2], s3 = ps[3];
                const float ssum = (((s0[0] + s0[1]) + (s0[2] + s0[3])) + ((s1[0] + s1[1]) + (s1[2] + s1[3]))) + (((s2[0] + s2[1]) + (s2[2] + s2[3])) + ((s3[0] + s3[1]) + (s3[2] + s3[3])));
                const float rstd = 1.f / sqrtf(ssum * (1.f / 1024.f) + RMS_EPS);
                float* orow = out + O_YP + (size_t)row * 1024;
#pragma unroll
                for (int bj = 0; bj < 2; ++bj) { const int col = c0 + bj * HALF; const f32x4 g0 = *(const f32x4*)(gf + col), g1 = *(const f32x4*)(gf + col + 4);
                    *(f32x4*)(orow + col) = acc[ai][bj][m][0] * rstd * g0; *(f32x4*)(orow + col + 4) = acc[ai][bj][m][1] * rstd * g1; } }
    }
};
struct EpiDown {
    static constexpr bool PERM = true, AFTER_DRAIN = false;
    __device__ __forceinline__ bool reset_acc(const Unit&) const { return true; }
    const bf16_t* X1b; float* out;
    __device__ __forceinline__ void operator()(const f32x4 (&acc)[2][2][4][2], const Unit& u, int wr, int wc, int fr, int fq) const {
        const int rbase = u.pm * BM + wr * 64 + fr, c0 = u.pn * BM + wc * 32 + fq * 8;
#pragma unroll
        for (int ai = 0; ai < 2; ++ai)
#pragma unroll
            for (int m = 0; m < 4; ++m) { const int row = rbase + ai * HALF + m * 16;
                if (row < NP) { float* orow = out + O_YP + (size_t)row * 1024;
#pragma unroll
                    for (int bj = 0; bj < 2; ++bj) { const int col = c0 + bj * HALF; const u32x4 g = *(const u32x4*)(X1b + (size_t)row * 1024 + col);
                        f32x4 a = acc[ai][bj][m][0], b = acc[ai][bj][m][1];
                        a[0] += bflo(g.x); a[1] += bfhi(g.x); a[2] += bflo(g.y); a[3] += bfhi(g.y); b[0] += bflo(g.z); b[1] += bfhi(g.z); b[2] += bflo(g.w); b[3] += bfhi(g.w);
                        *(f32x4*)(orow + col) = a; *(f32x4*)(orow + col + 4) = b; } } }
    }
};
template <class Epi, class Sched, bool ALIGN_EPI = false, bool SP2 = false>
__device__ __forceinline__ void gemm_phase(PG8_LAS unsigned char* lds, const Gemm g, const Sched& S, const Epi& E) {
    const int tid = threadIdx.x, wid = __builtin_amdgcn_readfirstlane(tid >> 6), lane = tid & 63, wr = wid >> 2, wc = wid & 3, fr = lane & 15, fq = lane >> 4;
    const int K = g.K, nt = K / BK;
    unsigned voffA[2], voffB[2];
#pragma unroll
    for (int i = 0; i < 2; ++i) { int R, C; stage_rc(tid * 16 + i * 8192, R, C); const int Rb = Epi::PERM ? ((R & ~31) + perm32(R & 31)) : R;
        voffA[i] = (unsigned)(R * g.lda + C) * 2u; voffB[i] = (unsigned)(Rb * g.ldb + C) * 2u; }
    const size_t kstep = (size_t)(BK * 2);
    const size_t hstepA = (size_t)HALF * g.lda * 2, hstepB = (size_t)HALF * g.ldb * 2;
    const size_t tstepA = 2 * hstepA, tstepB = 2 * hstepB;
    const unsigned ldsw = (unsigned)wid * 1024u;
    const int aoff = lds_byte(wr * 64 + fr, fq * 8), boff = lds_byte(wc * 32 + fr, fq * 8);
#define PG8_SA(b, h) (((b) * 2 + (h)) * HTB)
#define PG8_SB(b, h) ((4 + (b) * 2 + (h)) * HTB)
#define PG8_STAGE(bufoff, gbase, voff) do { _Pragma("unroll") for (int _i = 0; _i < 2; ++_i) \
        __builtin_amdgcn_global_load_lds((const unsigned*)((const char*)(gbase) + (voff)[_i]), (PG8_LAS unsigned*)(lds + (bufoff) + ldsw + _i * 8192), 16, 0, 0); } while (0)
#define PG8_LDA(dst, b, h) do { _Pragma("unroll") for (int m = 0; m < 4; ++m) _Pragma("unroll") for (int k = 0; k < 2; ++k) dst[m][k] = *(const PG8_LAS bf16x8*)(lds + PG8_SA(b, h) + aoff + m * 2048 + k * 1024); } while (0)
#define PG8_LDB(dst, b, h) do { _Pragma("unroll") for (int n = 0; n < 2; ++n) _Pragma("unroll") for (int k = 0; k < 2; ++k) dst[n][k] = *(const PG8_LAS bf16x8*)(lds + PG8_SB(b, h) + boff + n * 2048 + k * 1024); } while (0)
#define PG8_MMA(ai, bj, At, Bt) do { __builtin_amdgcn_s_setprio(1); _Pragma("unroll") for (int m = 0; m < 4; ++m) _Pragma("unroll") for (int n = 0; n < 2; ++n) _Pragma("unroll") for (int k = 0; k < 2; ++k) \
        acc[ai][bj][m][n] = __builtin_amdgcn_mfma_f32_16x16x32_bf16(Bt[n][k], At[m][k], acc[ai][bj][m][n], 0, 0, 0); __builtin_amdgcn_s_setprio(0); } while (0)
#define PG8_WAIT_V(n) asm volatile("s_waitcnt vmcnt(" #n ")" ::: "memory")
#define PG8_WAIT_L(n) asm volatile("s_waitcnt lgkmcnt(" #n ")" ::: "memory")
#define PG8_BAR __builtin_amdgcn_s_barrier()
#define PG8_SCHED __builtin_amdgcn_sched_barrier(0)
    Unit cur, nxt; int ui = 0;
    if (!S.next(0, cur)) return;
    f32x4 acc[2][2][4][2];
#pragma unroll
    for (int a = 0; a < 2; ++a)
#pragma unroll
        for (int b = 0; b < 2; ++b)
#pragma unroll
            for (int m = 0; m < 4; ++m)
#pragma unroll
                for (int n = 0; n < 2; ++n) acc[a][b][m][n] = (f32x4){0.f, 0.f, 0.f, 0.f};
    bf16x8 At[4][2], B0[2][2], B1[2][2];
    const char* cA = (const char*)g.A + (size_t)cur.pm * tstepA + cur.aoff; const char* cB = (const char*)g.Bt + (size_t)cur.pn * tstepB;
    S.a_ready(cur);
    if constexpr (SP2) {
        PG8_STAGE(PG8_SB(0, 0), cB, voffB); PG8_STAGE(PG8_SB(0, 1), cB + hstepB, voffB); PG8_STAGE(PG8_SA(0, 0), cA, voffA); PG8_STAGE(PG8_SA(0, 1), cA + hstepA, voffA);
        if (wr == 1) PG8_BAR;
        PG8_WAIT_V(2); PG8_BAR;
        PG8_STAGE(PG8_SB(1, 0), cB + kstep, voffB); PG8_STAGE(PG8_SA(1, 0), cA + kstep, voffA); PG8_STAGE(PG8_SB(1, 1), cB + hstepB + kstep, voffB);
        PG8_WAIT_V(6); PG8_BAR;
    } else {
        PG8_STAGE(PG8_SB(0, 0), cB, voffB); PG8_STAGE(PG8_SA(0, 0), cA, voffA); PG8_STAGE(PG8_SB(0, 1), cB + hstepB, voffB); PG8_STAGE(PG8_SA(0, 1), cA + hstepA, voffA);
        if (wr == 1) PG8_BAR;
        PG8_WAIT_V(4); PG8_BAR;
        PG8_STAGE(PG8_SB(1, 0), cB + kstep, voffB); PG8_STAGE(PG8_SA(1, 0), cA + kstep, voffA); PG8_STAGE(PG8_SB(1, 1), cB + hstepB + kstep, voffB);
        PG8_WAIT_V(6); PG8_BAR;
    }
    for (;;) {
        const bool has_next = S.next(ui + 1, nxt);
        const char* nA = has_next ? (const char*)g.A + (size_t)nxt.pm * tstepA + nxt.aoff : cA; const char* nB = has_next ? (const char*)g.Bt + (size_t)nxt.pn * tstepB : cB;
        for (int t = 0; t < nt; t += 2) {
            const bool last = (t == nt - 2);
            const char* a1 = cA + (size_t)(t + 1) * kstep;
            const char* a2 = last ? nA : cA + (size_t)(t + 2) * kstep; const char* b2 = last ? nB : cB + (size_t)(t + 2) * kstep;
            const char* a3 = a2 + kstep; const char* b3 = b2 + kstep;
            if (last && has_next) S.a_ready(nxt);
            if constexpr (SP2) {
            PG8_LDB(B0, 0, 0); PG8_LDB(B1, 0, 1); PG8_SCHED; PG8_LDA(At, 0, 0); PG8_STAGE(PG8_SA(1, 1), a1 + hstepA, voffA);
            PG8_WAIT_V(8); PG8_WAIT_L(0); PG8_BAR; PG8_MMA(0, 0, At, B0); PG8_MMA(0, 1, At, B1); PG8_BAR; PG8_SCHED;
            PG8_LDA(At, 0, 1); PG8_STAGE(PG8_SB(0, 0), b2, voffB); PG8_STAGE(PG8_SB(0, 1), b2 + hstepB, voffB); PG8_STAGE(PG8_SA(0, 0), a2, voffA);
            PG8_WAIT_V(8); PG8_WAIT_L(0); PG8_BAR; PG8_MMA(1, 0, At, B0); PG8_MMA(1, 1, At, B1); PG8_BAR; PG8_SCHED;
            PG8_LDB(B0, 1, 0); PG8_LDB(B1, 1, 1); PG8_SCHED; PG8_LDA(At, 1, 0); PG8_STAGE(PG8_SA(0, 1), a2 + hstepA, voffA);
            PG8_WAIT_V(8); PG8_WAIT_L(0); PG8_BAR; PG8_MMA(0, 0, At, B0); PG8_MMA(0, 1, At, B1); PG8_BAR; PG8_SCHED;
            PG8_LDA(At, 1, 1); PG8_STAGE(PG8_SB(1, 0), b3, voffB); PG8_STAGE(PG8_SB(1, 1), b3 + hstepB, voffB); PG8_STAGE(PG8_SA(1, 0), a3, voffA);
            PG8_WAIT_V(8); PG8_WAIT_L(0); PG8_BAR; PG8_MMA(1, 0, At, B0); PG8_MMA(1, 1, At, B1); PG8_BAR; PG8_SCHED;
            } else {
            PG8_LDB(B0, 0, 0); PG8_SCHED; PG8_LDA(At, 0, 0); PG8_STAGE(PG8_SA(1, 1), a1 + hstepA, voffA);
            PG8_WAIT_L(8); PG8_BAR; PG8_WAIT_L(0); PG8_MMA(0, 0, At, B0); PG8_BAR; PG8_SCHED;
            PG8_LDB(B1, 0, 1); PG8_STAGE(PG8_SB(0, 0), b2, voffB);
            PG8_BAR; PG8_WAIT_L(0); PG8_MMA(0, 1, At, B1); PG8_BAR;
            PG8_LDA(At, 0, 1); PG8_STAGE(PG8_SA(0, 0), a2, voffA);
            PG8_BAR; PG8_WAIT_L(0); PG8_MMA(1, 0, At, B0); PG8_BAR; PG8_SCHED;
            PG8_STAGE(PG8_SB(0, 1), b2 + hstepB, voffB);
            PG8_WAIT_V(6); PG8_BAR; PG8_MMA(1, 1, At, B1); PG8_BAR;
            PG8_LDB(B0, 1, 0); PG8_SCHED; PG8_LDA(At, 1, 0); PG8_STAGE(PG8_SA(0, 1), a2 + hstepA, voffA);
            PG8_WAIT_L(8); PG8_BAR; PG8_WAIT_L(0); PG8_MMA(0, 0, At, B0); PG8_BAR; PG8_SCHED;
            PG8_LDB(B1, 1, 1); PG8_STAGE(PG8_SB(1, 0), b3, voffB);
            PG8_BAR; PG8_WAIT_L(0); PG8_MMA(0, 1, At, B1); PG8_BAR;
            PG8_LDA(At, 1, 1); PG8_STAGE(PG8_SA(1, 0), a3, voffA);
            PG8_BAR; PG8_WAIT_L(0); PG8_MMA(1, 0, At, B0); PG8_BAR; PG8_SCHED;
            PG8_STAGE(PG8_SB(1, 1), b3 + hstepB, voffB);
            PG8_WAIT_V(6); PG8_BAR; PG8_MMA(1, 1, At, B1); PG8_BAR;
            }
        }
        if constexpr (ALIGN_EPI) { if (wr == 0) PG8_BAR; }
        if constexpr (!Epi::AFTER_DRAIN) { E(acc, cur, wr, wc, fr, fq); S.done(cur); }
        if (!has_next) break;
        if (E.reset_acc(cur)) {
#pragma unroll
        for (int a = 0; a < 2; ++a)
#pragma unroll
            for (int b = 0; b < 2; ++b)
#pragma unroll
                for (int m = 0; m < 4; ++m)
#pragma unroll
                    for (int n = 0; n < 2; ++n) acc[a][b][m][n] = (f32x4){0.f, 0.f, 0.f, 0.f};
        }
        cur = nxt; cA = nA; cB = nB; ++ui;
        if constexpr (ALIGN_EPI) { if (wr == 1) PG8_BAR; }
    }
    PG8_WAIT_V(0);
    if constexpr (!ALIGN_EPI) { if (wr == 0) PG8_BAR; }
    PG8_BAR;
    if constexpr (Epi::AFTER_DRAIN) { E.fused(acc, cur, wr, wc, fr, fq, lds, wid, lane); S.done(cur); }
#undef PG8_SA
#undef PG8_SB
#undef PG8_STAGE
#undef PG8_LDA
#undef PG8_LDB
#undef PG8_MMA
#undef PG8_WAIT_V
#undef PG8_WAIT_L
#undef PG8_BAR
#undef PG8_SCHED
}
}

#define GAS __attribute__((address_space(1)))
#define LAS __attribute__((address_space(3)))
typedef unsigned short bf16;
typedef unsigned v4u __attribute__((ext_vector_type(4)));
typedef unsigned v2u __attribute__((ext_vector_type(2)));
typedef float f32x4 __attribute__((ext_vector_type(4)));
typedef short bf16x8 __attribute__((ext_vector_type(8)));
typedef GAS unsigned gu32;
#define RLX_AGENT __ATOMIC_RELAXED, __HIP_MEMORY_SCOPE_AGENT
#define LDS_WAIT() asm volatile("s_waitcnt lgkmcnt(0)" ::: "memory")
#define VM_WAIT() asm volatile("s_waitcnt vmcnt(0)" ::: "memory")
using pg8::bf2f; using pg8::bflo; using pg8::bfhi; using pg8::f2bf_rne; using pg8::kperm64; using pg8::ktile_off; using pg8::vtile_off; using pg8::vtile8_off; using pg8::ktile8_off; using pg8::sigmoid_f; using pg8::gelu_tanh_f; using pg8::cvt_pk_bf16;
__device__ __forceinline__ unsigned pk2(float lo, float hi) { return cvt_pk_bf16(lo, hi); }

#define XB_TMO      128
#define XB_XCNT(j)  (256  + 64 * (j))
#define XB_XSUB(j)  (1280 + 64 * (j))
#define XB_XGEN(j)  (2304 + 64 * (j))
#define XB_TOP      3328
#define XB_TOPGEN   3392
#define XCD_BAR_WORDS 3456
#define XB_SPIN_CAP (1u << 18)

__device__ __forceinline__ unsigned xb_ld(unsigned* p)              { return __hip_atomic_load(p, __ATOMIC_RELAXED, __HIP_MEMORY_SCOPE_AGENT); }
__device__ __forceinline__ unsigned xb_add(unsigned* p, unsigned v) { return __hip_atomic_fetch_add(p, v, __ATOMIC_RELAXED, __HIP_MEMORY_SCOPE_AGENT); }
__device__ __forceinline__ unsigned xb_xcc_id() { return (unsigned)__builtin_amdgcn_s_getreg((3 << 11) | 20) & 0xFu; }
#define XB_SPIN(cond, bar) do { unsigned _sp = 0; while (cond) { __builtin_amdgcn_s_sleep(1); \
    if ((++_sp & 255u) == 0u) { if (xb_ld(&(bar)[XB_TMO])) break; if (_sp > XB_SPIN_CAP) { atomicAdd(&(bar)[XB_TMO], 1u); break; } } } } while (0)

struct XcdBarrier {
    unsigned* bar; unsigned x;
    volatile LAS unsigned* st;
};

__device__ __forceinline__ XcdBarrier xcd_barrier_post(unsigned* bar, volatile LAS unsigned* st) {
    XcdBarrier b; b.bar = bar; b.x = xb_xcc_id(); b.st = st;
    if (threadIdx.x == 0) (void)xb_add(&bar[XB_XCNT(b.x)], 1u);
    return b;
}
__device__ __forceinline__ void xcd_barrier_complete(unsigned* bar, unsigned x, unsigned& nloc, unsigned& nx) {
    const unsigned G = gridDim.x * gridDim.y * gridDim.z;
    unsigned sum, cnt, mine, sp = 0u;
    for (;;) {
        sum = 0u; cnt = 0u; mine = 0u;
#pragma unroll
        for (unsigned j = 0; j < 16; ++j) { const unsigned c = xb_ld(&bar[XB_XCNT(j)]); sum += c; cnt += (c > 0u) ? 1u : 0u; mine = (j == x) ? c : mine; }
        if (sum == G) break;
        __builtin_amdgcn_s_sleep(1);
        if ((++sp & 255u) == 0u) { if (xb_ld(&bar[XB_TMO])) break; if (sp > XB_SPIN_CAP) { atomicAdd(&bar[XB_TMO], 1u); break; } }
    }
    nloc = mine > 0u ? mine : 1u; nx = cnt > 0u ? cnt : 1u;
}

__device__ __forceinline__ void xcd_barrier(const XcdBarrier& b) {
    asm volatile("s_waitcnt vmcnt(0)" ::: "memory");
    __syncthreads();
    if (threadIdx.x == 0) {
        unsigned* bar = b.bar;
        __builtin_amdgcn_s_waitcnt(0);
        unsigned nloc = b.st[0], nx = b.st[1];
        if (nloc == 0u) { xcd_barrier_complete(bar, b.x, nloc, nx); b.st[0] = nloc; b.st[1] = nx; }
        const unsigned old = xb_add(&bar[XB_XSUB(b.x)], 1u);
        const unsigned gen = old / nloc;
        if (old + 1u == (gen + 1u) * nloc) {
            __builtin_amdgcn_fence(__ATOMIC_RELEASE, "agent");
            asm volatile("s_waitcnt vmcnt(0)" ::: "memory");
            const unsigned og = xb_add(&bar[XB_TOP], 1u);
            const unsigned tg = og / nx;
            if (og + 1u == (tg + 1u) * nx) xb_add(&bar[XB_TOPGEN], 1u);
            else XB_SPIN(xb_ld(&bar[XB_TOPGEN]) == tg, bar);
            __builtin_amdgcn_fence(__ATOMIC_ACQUIRE, "agent");
            xb_add(&bar[XB_XGEN(b.x)], 1u);
            asm volatile("s_waitcnt vmcnt(0)" ::: "memory");
        } else {
            XB_SPIN(xb_ld(&bar[XB_XGEN(b.x)]) == gen, bar);
            __builtin_amdgcn_fence(__ATOMIC_ACQUIRE, "agent");
            asm volatile("s_waitcnt vmcnt(0)" ::: "memory");
        }
    }
    __syncthreads();
}

__device__ __forceinline__ float wave_sum(float v) {
#pragma unroll
    for (int o = 1; o < 64; o <<= 1) v += __shfl_xor(v, o);
    return v;
}
__device__ __forceinline__ float wave_max(float v) {
#pragma unroll
    for (int o = 1; o < 64; o <<= 1) v = fmaxf(v, __shfl_xor(v, o));
    return v;
}
__device__ __forceinline__ int colmap_in(int n) { return n < 1280 ? n : (n < 4864 ? n + 24 : (n < 4888 ? n - 4864 + 1280 : -1)); }

template <int MODE>
__device__ __forceinline__ void p0_transpose_item(const float* W, int K, int N, int Nout, bf16* WT, const float* kscale, LAS float* scr, int item, int lane) {
    const int nblk = Nout / 32, kb = item / nblk, nb = item % nblk, k0 = 64 * kb, n0 = 32 * nb;
    const int col = MODE ? colmap_in(n0 + (lane & 31)) : n0 + (lane & 31);
    float wv[32];
#pragma unroll
    for (int i = 0; i < 32; ++i) { const int kk = 2 * i + (lane >> 5); wv[i] = col >= 0 ? W[(size_t)(k0 + kk) * N + col] : 0.f; }
#pragma unroll
    for (int i = 0; i < 32; ++i) { const int kk = 2 * i + (lane >> 5); float v = wv[i]; if (kscale) v *= kscale[k0 + kk]; scr[kk * 33 + (lane & 31)] = v; }
    LDS_WAIT(); asm volatile("" ::: "memory");
    const int c = lane & 7;
#pragma unroll
    for (int j = 0; j < 4; ++j) { const int n = (lane >> 3) + 8 * j; const LAS float* s = scr + (8 * c) * 33 + n;
        v4u o; o.x = pk2(s[0 * 33], s[1 * 33]); o.y = pk2(s[2 * 33], s[3 * 33]); o.z = pk2(s[4 * 33], s[5 * 33]); o.w = pk2(s[6 * 33], s[7 * 33]);
        *(GAS v4u*)(WT + (size_t)(n0 + n) * K + k0 + 8 * c) = o; }
    LDS_WAIT(); asm volatile("" ::: "memory");
}
__device__ __forceinline__ void rms_row_to_bf16(const float* xrow, const float* g, bf16* orow, int lane) {
    const GAS f32x4* xr = (const GAS f32x4*)xrow + lane; const GAS f32x4* gr = (const GAS f32x4*)g + lane;
    f32x4 v[4]; float s = 0.f;
#pragma unroll
    for (int j = 0; j < 4; ++j) { v[j] = xr[64 * j]; s += (v[j].x * v[j].x + v[j].y * v[j].y) + (v[j].z * v[j].z + v[j].w * v[j].w); }
    const float rstd = 1.f / sqrtf(wave_sum(s) * (1.f / 1024.f) + RMS_EPS);
    GAS v2u* o8 = (GAS v2u*)orow + lane;
#pragma unroll
    for (int j = 0; j < 4; ++j) { const f32x4 gg = gr[64 * j]; v2u w; w.x = pk2(v[j].x * rstd * gg.x, v[j].y * rstd * gg.y); w.y = pk2(v[j].z * rstd * gg.z, v[j].w * rstd * gg.w); o8[64 * j] = w; }
}

template <int RT, int CT, bool TR = true, class Epi>
__device__ __forceinline__ void skinny_unit(const bf16* A, int lda, const bf16* Bt, int ldb, int K, int row0, int col0, const Epi& E, int lane) {
    const int r = lane & 15, q = lane >> 4;
    f32x4 acc[RT][CT];
#pragma unroll
    for (int a = 0; a < RT; ++a)
#pragma unroll
        for (int b = 0; b < CT; ++b) acc[a][b] = (f32x4){0.f, 0.f, 0.f, 0.f};
    const bf16* ap = A + (size_t)(row0 + r) * lda + q * 8;
    const bf16* bp = Bt + (size_t)(col0 + r) * ldb + q * 8;
    constexpr int UN = (RT + CT <= 5) ? 8 : 4;
#pragma unroll 1
    for (int k0 = 0; k0 < K; k0 += 32 * UN) {
        bf16x8 af[UN][RT], bfr[UN][CT];
#pragma unroll
        for (int u = 0; u < UN; ++u) {
#pragma unroll
            for (int a = 0; a < RT; ++a) af[u][a] = *(const GAS bf16x8*)(ap + (size_t)a * 16 * lda + k0 + 32 * u);
#pragma unroll
            for (int b = 0; b < CT; ++b) bfr[u][b] = *(const GAS bf16x8*)(bp + (size_t)b * 16 * ldb + k0 + 32 * u); }
        __builtin_amdgcn_sched_barrier(0);
#pragma unroll
        for (int u = 0; u < UN; ++u)
#pragma unroll
            for (int a = 0; a < RT; ++a)
#pragma unroll
                for (int b = 0; b < CT; ++b) acc[a][b] = TR ? __builtin_amdgcn_mfma_f32_16x16x32_bf16(bfr[u][b], af[u][a], acc[a][b], 0, 0, 0) : __builtin_amdgcn_mfma_f32_16x16x32_bf16(af[u][a], bfr[u][b], acc[a][b], 0, 0, 0);
        __builtin_amdgcn_sched_barrier(0);
    }
    E(acc, row0, col0, r, q);
}
struct SkHid {
    bf16* G; const float* pe;
    template <int RT, int CT> __device__ __forceinline__ void operator()(const f32x4 (&acc)[RT][CT], int row0, int col0, int r, int q) const {
#pragma unroll
        for (int b = 0; b < CT; ++b) { const int col = col0 + 16 * b + 4 * q; const f32x4 pv = *(const f32x4*)(pe + col);
#pragma unroll
            for (int a = 0; a < RT; ++a) { f32x4 v = acc[a][b] + pv;
#pragma unroll
                for (int i = 0; i < 4; ++i) v[i] = gelu_tanh_f(v[i]);
                v2u w; w.x = pk2(v[0], v[1]); w.y = pk2(v[2], v[3]); *(GAS v2u*)(G + (size_t)(row0 + 16 * a + r) * 256 + col) = w; } }
    }
};
struct SkOutF32 {
    float* O;
    template <int RT, int CT> __device__ __forceinline__ void operator()(const f32x4 (&acc)[RT][CT], int row0, int col0, int r, int q) const {
#pragma unroll
        for (int a = 0; a < RT; ++a)
#pragma unroll
            for (int b = 0; b < CT; ++b) *(GAS f32x4*)(O + (size_t)(row0 + 16 * a + r) * 64 + col0 + 16 * b + 4 * q) = acc[a][b];
    }
};
struct SkOutKT {
    bf16* O;
    template <int RT, int CT> __device__ __forceinline__ void operator()(const f32x4 (&acc)[RT][CT], int row0, int col0, int r, int q) const {
#pragma unroll
        for (int a = 0; a < RT; ++a) { const int row = row0 + 16 * a + r; bf16* base = O + (size_t)(row >> 6) * 4096;
#pragma unroll
            for (int b = 0; b < CT; ++b) { v2u w; w.x = pk2(acc[a][b][0], acc[a][b][1]); w.y = pk2(acc[a][b][2], acc[a][b][3]); *(GAS v2u*)(base + ktile_off(row & 63, col0 + 16 * b + 4 * q)) = w; } }
    }
};
struct SkOutVT {
    bf16* VT;
    template <int RT, int CT> __device__ __forceinline__ void operator()(const f32x4 (&acc)[RT][CT], int row0, int col0, int r, int q) const {
#pragma unroll
        for (int a = 0; a < RT; ++a) { const int row = row0 + 16 * a + 4 * q; bf16* base = VT + (size_t)(row >> 6) * 4096;
#pragma unroll
            for (int b = 0; b < CT; ++b) { v2u w; w.x = pk2(acc[a][b][0], acc[a][b][1]); w.y = pk2(acc[a][b][2], acc[a][b][3]); *(GAS v2u*)(base + vtile_off(row & 63, col0 + 16 * b + r)) = w; } }
    }
};
struct SkWo {
    const float* xs; float* X1; bf16* X1b; float* PSS; int slot;
    template <int RT, int CT> __device__ __forceinline__ void operator()(const f32x4 (&acc)[RT][CT], int row0, int col0, int r, int q) const {
#pragma unroll
        for (int a = 0; a < RT; ++a) { const int row = row0 + 16 * a + r; float ss = 0.f;
#pragma unroll
            for (int b = 0; b < CT; ++b) { const int col = col0 + 16 * b + 4 * q; const f32x4 v = acc[a][b] + *(const GAS f32x4*)(xs + (size_t)(row - NP) * 1024 + col);
                *(GAS f32x4*)(X1 + (size_t)row * 1024 + col) = v; v2u w; w.x = pk2(v[0], v[1]); w.y = pk2(v[2], v[3]); *(GAS v2u*)(X1b + (size_t)row * 1024 + col) = w;
                ss += (v[0] * v[0] + v[1] * v[1]) + (v[2] * v[2] + v[3] * v[3]); }
            ss += __shfl_xor(ss, 16); ss += __shfl_xor(ss, 32);
            if (q == 0) PSS[(size_t)row * 16 + slot] = ss; }
    }
};
struct SkUp {
    const float* PSS; bf16* H;
    template <int RT, int CT> __device__ __forceinline__ void operator()(const f32x4 (&acc)[RT][CT], int row0, int col0, int r, int q) const {
#pragma unroll
        for (int a = 0; a < RT; ++a) { const int row = row0 + 16 * a + r;
            const GAS f32x4* ps = (const GAS f32x4*)(PSS + (size_t)row * 16); const f32x4 s0 = ps[0], s1 = ps[1], s2 = ps[2], s3 = ps[3];
            const float ssum = (((s0[0] + s0[1]) + (s0[2] + s0[3])) + ((s1[0] + s1[1]) + (s1[2] + s1[3]))) + (((s2[0] + s2[1]) + (s2[2] + s2[3])) + ((s3[0] + s3[1]) + (s3[2] + s3[3])));
            const float rstd = __builtin_amdgcn_rsqf(ssum * (1.f / 1024.f) + RMS_EPS);
#pragma unroll
            for (int b = 0; b < CT; ++b) { f32x4 v = acc[a][b] * rstd;
#pragma unroll
                for (int i = 0; i < 4; ++i) v[i] = v[i] > 0.f ? v[i] * v[i] : 0.f;
                v2u w; w.x = pk2(v[0], v[1]); w.y = pk2(v[2], v[3]); *(GAS v2u*)(H + (size_t)row * 4096 + col0 + 16 * b + 4 * q) = w; } }
    }
};
struct SkPart {
    float* P;
    template <int RT, int CT> __device__ __forceinline__ void operator()(const f32x4 (&acc)[RT][CT], int row0, int col0, int r, int q) const {
#pragma unroll
        for (int a = 0; a < RT; ++a)
#pragma unroll
            for (int b = 0; b < CT; ++b) *(GAS f32x4*)(P + (size_t)(row0 + 16 * a + r) * 1024 + col0 + 16 * b + 4 * q) = acc[a][b];
    }
};

struct AttnMaskSel { int d0; bool sel; static constexpr int KS = 16, IS = 1; __device__ __forceinline__ bool ok(int d) const { return sel && d >= 0; } };
struct AttnMaskWin { int d0; static constexpr int KS = 16, IS = 1; __device__ __forceinline__ bool ok(int d) const { return d >= 0 && d < WINL; } };
struct AttnMaskCmp { int d0; static constexpr int KS = 256, IS = 16; __device__ __forceinline__ bool ok(int d) const { return d >= 0; } };

struct SrcB {
    static constexpr bool LATE_V = true;
    const bf16* Kb; const bf16* VTb;
    __device__ __forceinline__ bf16x8 kfrag(int kt, int ks, int r, int qp) const { return *(const GAS bf16x8*)(Kb + ((kt * 2 + ks) * 64 + qp * 16 + r) * 8); }
    __device__ __forceinline__ bf16x8 vfrag(int dt, int k2, int r, int qp) const { return *(const GAS bf16x8*)(VTb + ((dt * 2 + k2) * 64 + qp * 16 + r) * 8); }
};
struct SrcF {
    static constexpr bool LATE_V = true;
    const float* Kp; const float* Vp;
    __device__ __forceinline__ bf16x8 kfrag(int kt, int ks, int r, int qp) const {
        const GAS f32x4* p = (const GAS f32x4*)(Kp + (size_t)(16 * kt + r) * 128 + 32 * ks + 8 * qp); const f32x4 a = p[0], b = p[1];
        v4u w; w.x = pk2(a[0], a[1]); w.y = pk2(a[2], a[3]); w.z = pk2(b[0], b[1]); w.w = pk2(b[2], b[3]); return __builtin_bit_cast(bf16x8, w); }
    __device__ __forceinline__ bf16x8 vfrag(int dt, int k2, int r, int qp) const { float v[8]; const GAS float* p = (const GAS float*)(Vp + (size_t)(4 * qp) * 128 + r);
#pragma unroll
        for (int j = 0; j < 8; ++j) v[j] = p[(32 * k2 + (j < 4 ? j : 12 + j)) * 128 + 16 * dt];
        v4u w; w.x = pk2(v[0], v[1]); w.y = pk2(v[2], v[3]); w.z = pk2(v[4], v[5]); w.w = pk2(v[6], v[7]); return __builtin_bit_cast(bf16x8, w); }
};

template <bool FAST, class Src, class Mask>
__device__ __forceinline__ void attn_scores(const Src& src, const bf16x8 (&qf)[2], const LAS float* lutg, const Mask& mk, float ini, f32x4 (&S)[4], int r, int qp) {
    bf16x8 kf[4][2];
#pragma unroll
    for (int kt = 0; kt < 4; ++kt)
#pragma unroll
        for (int ks = 0; ks < 2; ++ks) kf[kt][ks] = src.kfrag(kt, ks, r, qp);
#pragma unroll
    for (int kt = 0; kt < 4; ++kt) {
        S[kt] = __builtin_amdgcn_mfma_f32_16x16x32_bf16(kf[kt][0], qf[0], (f32x4){ini, ini, ini, ini}, 0, 0, 0);
        S[kt] = __builtin_amdgcn_mfma_f32_16x16x32_bf16(kf[kt][1], qf[1], S[kt], 0, 0, 0);
    }
    if (!FAST) {
        int d0 = mk.d0; asm volatile("" : "+v"(d0));
        float bvv[4][4];
#pragma unroll
        for (int kt = 0; kt < 4; ++kt)
#pragma unroll
            for (int i = 0; i < 4; ++i) { const int d = d0 - Mask::KS * kt - Mask::IS * i; const int dc = d < 0 ? 0 : (d > 127 ? 127 : d); bvv[kt][i] = lutg[dc]; }
#pragma unroll
        for (int kt = 0; kt < 4; ++kt) asm volatile("" : "+v"(bvv[kt][0]), "+v"(bvv[kt][1]), "+v"(bvv[kt][2]), "+v"(bvv[kt][3]));
#pragma unroll
        for (int kt = 0; kt < 4; ++kt)
#pragma unroll
            for (int i = 0; i < 4; ++i) { const int d = d0 - Mask::KS * kt - Mask::IS * i; S[kt][i] = mk.ok(d) ? S[kt][i] + bvv[kt][i] : -1.0e30f; }
    }
}
template <bool FAST, class Src, class Mask>
__device__ __forceinline__ void attn_block(const Src& src, const bf16x8 (&qf)[2], const LAS float* lutg, const Mask& mk, float bcol, float& m, float& l, f32x4 (&O)[4], int r, int qp) {
    bf16x8 vf[4][2];
    if constexpr (!Src::LATE_V) {
#pragma unroll
        for (int dt = 0; dt < 4; ++dt)
#pragma unroll
            for (int k2 = 0; k2 < 2; ++k2) vf[dt][k2] = src.vfrag(dt, k2, r, qp);
    }
    const bool have = m > -1.0e29f; const float off = have ? m : 0.f;
    f32x4 S[4];
    attn_scores<FAST>(src, qf, lutg, mk, FAST ? bcol - off : -off, S, r, qp);
    if constexpr (Src::LATE_V) {
        asm volatile("" ::: "memory");
#pragma unroll
        for (int dt = 0; dt < 4; ++dt)
#pragma unroll
            for (int k2 = 0; k2 < 2; ++k2) vf[dt][k2] = src.vfrag(dt, k2, r, qp);
    }
    float mx = fmaxf(fmaxf(fmaxf(S[0][0], S[0][1]), fmaxf(S[0][2], S[0][3])), fmaxf(fmaxf(S[1][0], S[1][1]), fmaxf(S[1][2], S[1][3])));
    mx = fmaxf(mx, fmaxf(fmaxf(fmaxf(S[2][0], S[2][1]), fmaxf(S[2][2], S[2][3])), fmaxf(fmaxf(S[3][0], S[3][1]), fmaxf(S[3][2], S[3][3]))));
    if (__any(have ? (mx > 8.f) : (mx > -1.0e29f))) {
        mx = fmaxf(mx, __shfl_xor(mx, 16)); mx = fmaxf(mx, __shfl_xor(mx, 32));
        const bool need = have ? (mx > 8.f) : (mx > -1.0e29f);
        const float delta = need ? mx : 0.f, sc = __builtin_amdgcn_exp2f(-delta);
        l *= sc; m = need ? off + mx : m;
#pragma unroll
        for (int dt = 0; dt < 4; ++dt) O[dt] = O[dt] * sc;
#pragma unroll
        for (int kt = 0; kt < 4; ++kt) S[kt] = S[kt] - delta;
    }
    float ps = 0.f;
#pragma unroll
    for (int kt = 0; kt < 4; ++kt)
#pragma unroll
        for (int i = 0; i < 4; ++i) { const float p = __builtin_amdgcn_exp2f(S[kt][i]); S[kt][i] = p; ps += p; }
    l += ps;
    bf16x8 pf[2];
#pragma unroll
    for (int k2 = 0; k2 < 2; ++k2) { v4u w; w.x = pk2(S[2 * k2][0], S[2 * k2][1]); w.y = pk2(S[2 * k2][2], S[2 * k2][3]); w.z = pk2(S[2 * k2 + 1][0], S[2 * k2 + 1][1]); w.w = pk2(S[2 * k2 + 1][2], S[2 * k2 + 1][3]);
        pf[k2] = __builtin_bit_cast(bf16x8, w); }
#pragma unroll
    for (int dt = 0; dt < 4; ++dt) {
        O[dt] = __builtin_amdgcn_mfma_f32_16x16x32_bf16(vf[dt][0], pf[0], O[dt], 0, 0, 0);
        O[dt] = __builtin_amdgcn_mfma_f32_16x16x32_bf16(vf[dt][1], pf[1], O[dt], 0, 0, 0); }
}
__device__ __forceinline__ float quad_xor1(float v) { return __builtin_bit_cast(float, __builtin_amdgcn_mov_dpp(__builtin_bit_cast(int, v), 0xB1, 0xF, 0xF, true)); }
__device__ __forceinline__ float quad_xor2(float v) { return __builtin_bit_cast(float, __builtin_amdgcn_mov_dpp(__builtin_bit_cast(int, v), 0x4E, 0xF, 0xF, true)); }
__device__ __forceinline__ float col_total(float l) { float lt = l + __shfl_xor(l, 16); lt += __shfl_xor(lt, 32); return lt; }

struct NoHook { __device__ __forceinline__ void rescale(float) {} __device__ __forceinline__ void mref(int, float) {} __device__ __forceinline__ void p(const f32x4 (&)[4], int) {} };
struct ImpHook {
    LAS float* imph; LAS float* mlog; float hprev; int lane;
    __device__ __forceinline__ void rescale(float sc) { hprev *= sc; }
    __device__ __forceinline__ void mref(int cb, float m) { if (lane < 16) mlog[cb * 16 + lane] = m > -1.0e29f ? m : 0.f; }
    __device__ __forceinline__ void p(const f32x4 (&P)[4], int cb) { const int r = lane & 15, qp = lane >> 4, src_lane = (lane + 48) & 63;
#pragma unroll
        for (int kt = 0; kt < 4; ++kt) { const float h = 0.5f * P[kt][3]; const float a = (P[kt][0] + P[kt][1]) + (P[kt][2] + h);
            const float r1 = __shfl(hprev, src_lane), r2 = __shfl(h, src_lane);
            imph[(16 * cb + 4 * kt + qp) * 16 + r] = a + (qp == 0 ? r1 : r2); hprev = h; } }
};
__device__ __forceinline__ float max16(const f32x4 (&S)[4]) {
    const float a = fmaxf(fmaxf(S[0][0], S[0][1]), S[0][2]), b = fmaxf(fmaxf(S[0][3], S[1][0]), S[1][1]), c = fmaxf(fmaxf(S[1][2], S[1][3]), S[2][0]);
    const float d = fmaxf(fmaxf(S[2][1], S[2][2]), S[2][3]), e = fmaxf(fmaxf(S[3][0], S[3][1]), S[3][2]);
    return fmaxf(fmaxf(fmaxf(a, b), c), fmaxf(fmaxf(d, e), S[3][3])); }
__device__ __forceinline__ float max2(float a, float b) { return fmaxf(a, b); }
struct Blk { const bf16* K; const bf16* VT; int j; bool fast; bool edge; };
struct LaneCtx { int dbase; float bfar; unsigned long long mlo, mhi; };
template <bool VF8>
__device__ __forceinline__ void load_block(v4u (&kf)[8], v4u (&vf)[8], const Blk& bl, unsigned lane16) {
    const GAS unsigned char* kb = (const GAS unsigned char*)bl.K; const GAS unsigned char* vb = (const GAS unsigned char*)bl.VT;
    if (VF8) {
#pragma unroll
        for (int kt = 0; kt < 4; ++kt) kf[kt] = *(const GAS v4u*)(kb + (size_t)lane16 + kt * 1024);
#pragma unroll
        for (int dt = 0; dt < 4; ++dt) vf[dt] = *(const GAS v4u*)(vb + (size_t)lane16 + dt * 1024);
    } else {
#pragma unroll
        for (int f = 0; f < 8; ++f) kf[f] = *(const GAS v4u*)(kb + (size_t)lane16 + f * 1024);
#pragma unroll
        for (int f = 0; f < 8; ++f) vf[f] = *(const GAS v4u*)(vb + (size_t)lane16 + f * 1024);
    }
}
template <int KS, int IS, int DSTEP, bool WIN, bool VF8, bool MASKED, class Hook>
__device__ __forceinline__ void compute_block(const v4u (&kf)[8], const v4u (&vf)[8], const Blk& bl, const LaneCtx& lc, const bf16x8 (&qf)[2], const long (&qf8)[2], const LAS float* lutg, float& m, float& l, f32x4 (&O)[4], Hook& hook) {
    const bool have = m > -1.0e29f; const float off = have ? m : 0.f;
    bool sel = true;
    if (MASKED) { const unsigned long long mq = (bl.j & 64) ? lc.mhi : lc.mlo; sel = ((mq >> (bl.j & 63)) & 1ull) != 0ull; }
    const float bcol = sel ? lc.bfar : -1.0e30f;
    const float ini = (bl.fast || (WIN && bl.edge)) ? bcol - off : -off;
    f32x4 S[4];
#pragma unroll
    for (int kt = 0; kt < 4; ++kt) {
        if (VF8) { const long k0 = (long)(((unsigned long long)kf[kt].y << 32) | (unsigned long long)kf[kt].x), k1 = (long)(((unsigned long long)kf[kt].w << 32) | (unsigned long long)kf[kt].z);
            S[kt] = __builtin_amdgcn_mfma_f32_16x16x32_fp8_fp8(k0, qf8[0], (f32x4){ini, ini, ini, ini}, 0, 0, 0);
            S[kt] = __builtin_amdgcn_mfma_f32_16x16x32_fp8_fp8(k1, qf8[1], S[kt], 0, 0, 0);
        } else {
            S[kt] = __builtin_amdgcn_mfma_f32_16x16x32_bf16(__builtin_bit_cast(bf16x8, kf[kt * 2]), qf[0], (f32x4){ini, ini, ini, ini}, 0, 0, 0);
            S[kt] = __builtin_amdgcn_mfma_f32_16x16x32_bf16(__builtin_bit_cast(bf16x8, kf[kt * 2 + 1]), qf[1], S[kt], 0, 0, 0); }
    }
    if (!bl.fast) {
        if constexpr (KS == 16 && IS == 1) {
            int d0 = lc.dbase - DSTEP * bl.j;
            if (WIN && bl.edge) {
                asm volatile("" : "+v"(d0));
#pragma unroll
                for (int kt = 0; kt < 4; ++kt)
#pragma unroll
                    for (int i = 0; i < 4; ++i) S[kt][i] = d0 < WINL + KS * kt + IS * i ? S[kt][i] : -1.0e30f;
            } else {
                d0 = (sel) ? d0 : -16; asm volatile("" : "+v"(d0));
                const LAS float* pb = lutg + (d0 - 51);
                float bv[4][4];
#pragma unroll
                for (int kt = 0; kt < 4; ++kt)
#pragma unroll
                    for (int i = 0; i < 4; ++i) bv[kt][i] = pb[51 - KS * kt - IS * i];
#pragma unroll
                for (int kt = 0; kt < 4; ++kt) asm volatile("" : "+v"(bv[kt][0]), "+v"(bv[kt][1]), "+v"(bv[kt][2]), "+v"(bv[kt][3]));
#pragma unroll
                for (int kt = 0; kt < 4; ++kt) S[kt] = S[kt] + (f32x4){bv[kt][0], bv[kt][1], bv[kt][2], bv[kt][3]};
            }
        } else {
        int d0 = lc.dbase - DSTEP * bl.j; asm volatile("" : "+v"(d0));
        float bv[4][4];
#pragma unroll
        for (int kt = 0; kt < 4; ++kt)
#pragma unroll
            for (int i = 0; i < 4; ++i) { const int d = d0 - KS * kt - IS * i; const int dc = d < 0 ? 0 : (d > 127 ? 127 : d); bv[kt][i] = lutg[dc]; }
#pragma unroll
        for (int kt = 0; kt < 4; ++kt) asm volatile("" : "+v"(bv[kt][0]), "+v"(bv[kt][1]), "+v"(bv[kt][2]), "+v"(bv[kt][3]));
#pragma unroll
        for (int kt = 0; kt < 4; ++kt)
#pragma unroll
            for (int i = 0; i < 4; ++i) { const int d = d0 - KS * kt - IS * i; const bool ok = sel && d >= 0 && (!WIN || d < WINL);
                S[kt][i] = ok ? S[kt][i] + bv[kt][i] : -1.0e30f; }
        }
    }
    float mx = max16(S);
    const float thr = have ? 8.f : -1.0e29f;
    if (__builtin_amdgcn_ballot_w64(mx > thr) != 0ull) {
        mx = max2(mx, __shfl_xor(mx, 16)); mx = max2(mx, __shfl_xor(mx, 32));
        const bool need = mx > thr;
        const float delta = need ? mx : 0.f, sc = __builtin_amdgcn_exp2f(-delta);
        l *= sc; m = need ? off + mx : m; hook.rescale(sc);
#pragma unroll
        for (int dt = 0; dt < 4; ++dt) O[dt] = O[dt] * sc;
#pragma unroll
        for (int kt = 0; kt < 4; ++kt) S[kt] = S[kt] - delta;
    }
    hook.mref(bl.j, m);
#pragma unroll
    for (int kt = 0; kt < 4; ++kt)
#pragma unroll
        for (int i = 0; i < 4; ++i) S[kt][i] = __builtin_amdgcn_exp2f(S[kt][i]);
    { const f32x4 t = (S[0] + S[1]) + (S[2] + S[3]); l += (t[0] + t[1]) + (t[2] + t[3]); }
    hook.p(S, bl.j);
    if (VF8) {
        long pf8[2];
#pragma unroll
        for (int k2 = 0; k2 < 2; ++k2) { int w0 = __builtin_bit_cast(int, S[2 * k2][0]), w1 = __builtin_bit_cast(int, S[2 * k2 + 1][0]);
            w0 = __builtin_amdgcn_cvt_pk_fp8_f32(S[2 * k2][0], S[2 * k2][1], w0, false); w0 = __builtin_amdgcn_cvt_pk_fp8_f32(S[2 * k2][2], S[2 * k2][3], w0, true);
            w1 = __builtin_amdgcn_cvt_pk_fp8_f32(S[2 * k2 + 1][0], S[2 * k2 + 1][1], w1, false); w1 = __builtin_amdgcn_cvt_pk_fp8_f32(S[2 * k2 + 1][2], S[2 * k2 + 1][3], w1, true);
            pf8[k2] = (long)(((unsigned long long)(unsigned)w1 << 32) | (unsigned long long)(unsigned)w0); }
#pragma unroll
        for (int dt = 0; dt < 4; ++dt) {
            const long v0 = (long)(((unsigned long long)vf[dt].y << 32) | (unsigned long long)vf[dt].x), v1 = (long)(((unsigned long long)vf[dt].w << 32) | (unsigned long long)vf[dt].z);
            O[dt] = __builtin_amdgcn_mfma_f32_16x16x32_fp8_fp8(v0, pf8[0], O[dt], 0, 0, 0);
            O[dt] = __builtin_amdgcn_mfma_f32_16x16x32_fp8_fp8(v1, pf8[1], O[dt], 0, 0, 0); }
    } else {
        bf16x8 pf[2];
#pragma unroll
        for (int k2 = 0; k2 < 2; ++k2) { v4u w; w.x = pk2(S[2 * k2][0], S[2 * k2][1]); w.y = pk2(S[2 * k2][2], S[2 * k2][3]); w.z = pk2(S[2 * k2 + 1][0], S[2 * k2 + 1][1]); w.w = pk2(S[2 * k2 + 1][2], S[2 * k2 + 1][3]);
            pf[k2] = __builtin_bit_cast(bf16x8, w); }
#pragma unroll
        for (int dt = 0; dt < 4; ++dt) {
            O[dt] = __builtin_amdgcn_mfma_f32_16x16x32_bf16(__builtin_bit_cast(bf16x8, vf[dt * 2]), pf[0], O[dt], 0, 0, 0);
            O[dt] = __builtin_amdgcn_mfma_f32_16x16x32_bf16(__builtin_bit_cast(bf16x8, vf[dt * 2 + 1]), pf[1], O[dt], 0, 0, 0); }
    }
}
__device__ __forceinline__ void make_qf8(const bf16x8 (&qf)[2], long (&qf8)[2]) {
#pragma unroll
    for (int ks = 0; ks < 2; ++ks) { const v4u w = __builtin_bit_cast(v4u, qf[ks]); int a = 0, b = 0;
        a = __builtin_amdgcn_cvt_pk_fp8_f32(bflo(w.x), bfhi(w.x), a, false); a = __builtin_amdgcn_cvt_pk_fp8_f32(bflo(w.y), bfhi(w.y), a, true);
        b = __builtin_amdgcn_cvt_pk_fp8_f32(bflo(w.z), bfhi(w.z), b, false); b = __builtin_amdgcn_cvt_pk_fp8_f32(bflo(w.w), bfhi(w.w), b, true);
        qf8[ks] = (long)(((unsigned long long)(unsigned)b << 32) | (unsigned long long)(unsigned)a); } }
__device__ __forceinline__ void loadK8(v4u (&kf)[4], const Blk& bl, unsigned lane16) { const GAS unsigned char* kb = (const GAS unsigned char*)bl.K;
#pragma unroll
    for (int kt = 0; kt < 4; ++kt) kf[kt] = *(const GAS v4u*)(kb + (size_t)lane16 + kt * 1024); }
__device__ __forceinline__ void loadV8(v4u (&vf)[4], const Blk& bl, unsigned lane16) { const GAS unsigned char* vb = (const GAS unsigned char*)bl.VT;
#pragma unroll
    for (int dt = 0; dt < 4; ++dt) vf[dt] = *(const GAS v4u*)(vb + (size_t)lane16 + dt * 1024); }
template <bool MASKED>
__device__ __forceinline__ bool lane_sel(const Blk& bl, const LaneCtx& lc) { if (!MASKED) return true; const unsigned long long mq = (bl.j & 64) ? lc.mhi : lc.mlo; return ((mq >> (bl.j & 63)) & 1ull) != 0ull; }
__device__ __forceinline__ void softmax_pv8(f32x4 (&S0)[4], const v4u (&vf)[4], float& l, f32x4 (&O)[4]) {
#pragma unroll
    for (int kt = 0; kt < 4; ++kt)
#pragma unroll
        for (int i = 0; i < 4; ++i) S0[kt][i] = __builtin_amdgcn_exp2f(S0[kt][i]);
    { const f32x4 t = (S0[0] + S0[1]) + (S0[2] + S0[3]); l += (t[0] + t[1]) + (t[2] + t[3]); }
    long pf8[2];
#pragma unroll
    for (int k2 = 0; k2 < 2; ++k2) { int w0 = __builtin_bit_cast(int, S0[2 * k2][0]), w1 = __builtin_bit_cast(int, S0[2 * k2 + 1][0]);
        w0 = __builtin_amdgcn_cvt_pk_fp8_f32(S0[2 * k2][0], S0[2 * k2][1], w0, false); w0 = __builtin_amdgcn_cvt_pk_fp8_f32(S0[2 * k2][2], S0[2 * k2][3], w0, true);
        w1 = __builtin_amdgcn_cvt_pk_fp8_f32(S0[2 * k2 + 1][0], S0[2 * k2 + 1][1], w1, false); w1 = __builtin_amdgcn_cvt_pk_fp8_f32(S0[2 * k2 + 1][2], S0[2 * k2 + 1][3], w1, true);
        pf8[k2] = (long)(((unsigned long long)(unsigned)w1 << 32) | (unsigned long long)(unsigned)w0); }
#pragma unroll
    for (int dt = 0; dt < 4; ++dt) {
        const long v0 = (long)(((unsigned long long)vf[dt].y << 32) | (unsigned long long)vf[dt].x), v1 = (long)(((unsigned long long)vf[dt].w << 32) | (unsigned long long)vf[dt].z);
        O[dt] = __builtin_amdgcn_mfma_f32_16x16x32_fp8_fp8(v0, pf8[0], O[dt], 0, 0, 0);
        O[dt] = __builtin_amdgcn_mfma_f32_16x16x32_fp8_fp8(v1, pf8[1], O[dt], 0, 0, 0); }
}
template <bool MASKED>
__device__ __forceinline__ void qk8(const v4u (&kf)[4], const Blk& bl, const LaneCtx& lc, const long (&qf8)[2], float m, f32x4 (&S1)[4]) {
    const bool have = m > -1.0e29f; const float off = have ? m : 0.f;
    const float bcol = lane_sel<MASKED>(bl, lc) ? lc.bfar : -1.0e30f;
    const float ini = (bl.fast || bl.edge) ? bcol - off : -off;
#pragma unroll
    for (int kt = 0; kt < 4; ++kt) { const long k0 = (long)(((unsigned long long)kf[kt].y << 32) | (unsigned long long)kf[kt].x), k1 = (long)(((unsigned long long)kf[kt].w << 32) | (unsigned long long)kf[kt].z);
        S1[kt] = __builtin_amdgcn_mfma_f32_16x16x32_fp8_fp8(k0, qf8[0], (f32x4){ini, ini, ini, ini}, 0, 0, 0);
        S1[kt] = __builtin_amdgcn_mfma_f32_16x16x32_fp8_fp8(k1, qf8[1], S1[kt], 0, 0, 0); }
}
template <int KS, int IS, int DSTEP, bool WIN, bool MASKED>
__device__ __forceinline__ void post8(f32x4 (&S)[4], const Blk& bl, const LaneCtx& lc, const LAS float* lutg, float& m, float& l, f32x4 (&O)[4]) {
    const bool have = m > -1.0e29f; const float off = have ? m : 0.f;
    if (!bl.fast) {
        if constexpr (KS == 16 && IS == 1) {
            int d0 = lc.dbase - DSTEP * bl.j;
            if (WIN && bl.edge) {
                asm volatile("" : "+v"(d0));
#pragma unroll
                for (int kt = 0; kt < 4; ++kt)
#pragma unroll
                    for (int i = 0; i < 4; ++i) S[kt][i] = d0 < WINL + KS * kt + IS * i ? S[kt][i] : -1.0e30f;
            } else {
                d0 = (lane_sel<MASKED>(bl, lc)) ? d0 : -16; asm volatile("" : "+v"(d0));
                const LAS float* pb = lutg + (d0 - 51);
                float bv[4][4];
#pragma unroll
                for (int kt = 0; kt < 4; ++kt)
#pragma unroll
                    for (int i = 0; i < 4; ++i) bv[kt][i] = pb[51 - KS * kt - IS * i];
#pragma unroll
                for (int kt = 0; kt < 4; ++kt) asm volatile("" : "+v"(bv[kt][0]), "+v"(bv[kt][1]), "+v"(bv[kt][2]), "+v"(bv[kt][3]));
#pragma unroll
                for (int kt = 0; kt < 4; ++kt) S[kt] = S[kt] + (f32x4){bv[kt][0], bv[kt][1], bv[kt][2], bv[kt][3]};
            }
        } else {
        const bool sel = lane_sel<MASKED>(bl, lc);
        int d0 = lc.dbase - DSTEP * bl.j; asm volatile("" : "+v"(d0));
        float bv[4][4];
#pragma unroll
        for (int kt = 0; kt < 4; ++kt)
#pragma unroll
            for (int i = 0; i < 4; ++i) { const int d = d0 - KS * kt - IS * i; const int dc = d < 0 ? 0 : (d > 127 ? 127 : d); bv[kt][i] = lutg[dc]; }
#pragma unroll
        for (int kt = 0; kt < 4; ++kt) asm volatile("" : "+v"(bv[kt][0]), "+v"(bv[kt][1]), "+v"(bv[kt][2]), "+v"(bv[kt][3]));
#pragma unroll
        for (int kt = 0; kt < 4; ++kt)
#pragma unroll
            for (int i = 0; i < 4; ++i) { const int d = d0 - KS * kt - IS * i; const bool ok = sel && d >= 0 && (!WIN || d < WINL);
                S[kt][i] = ok ? S[kt][i] + bv[kt][i] : -1.0e30f; }
        }
    }
    float mx = max16(S);
    const float thr = have ? 8.f : -1.0e29f;
    if (__builtin_amdgcn_ballot_w64(mx > thr) != 0ull) {
        mx = max2(mx, __shfl_xor(mx, 16)); mx = max2(mx, __shfl_xor(mx, 32));
        const bool need = mx > thr;
        const float delta = need ? mx : 0.f, sc = __builtin_amdgcn_exp2f(-delta);
        l *= sc; m = need ? off + mx : m;
#pragma unroll
        for (int dt = 0; dt < 4; ++dt) O[dt] = O[dt] * sc;
#pragma unroll
        for (int kt = 0; kt < 4; ++kt) S[kt] = S[kt] - delta;
    }
}
template <int KS, int IS, int DSTEP, bool WIN, bool MASKED, bool PRE, class Next>
__device__ __forceinline__ void run_blocks8(Next& next, int n, const LaneCtx& lc, const long (&qf8)[2], const LAS float* lutg, float& m, float& l, f32x4 (&O)[4], unsigned lane16, Blk& bX, v4u (&kX)[4], v4u (&vX)[4]) {
    Blk bY, bN; v4u kY[4], vY[4]; f32x4 S0[4], S1[4];
    if (!PRE) { (void)next(bX); loadK8(kX, bX, lane16); loadV8(vX, bX, lane16); }
    bY = bX; (void)next(bY); loadK8(kY, bY, lane16); loadV8(vY, bY, lane16);
    qk8<MASKED>(kX, bX, lc, qf8, m, S0);
    post8<KS, IS, DSTEP, WIN, MASKED>(S0, bX, lc, lutg, m, l, O);
#pragma unroll 1
    for (int p = n >> 1; p > 0; --p) {
        bN = bY; (void)next(bN); loadK8(kX, bN, lane16); __builtin_amdgcn_sched_barrier(0);
        qk8<MASKED>(kY, bY, lc, qf8, m, S1); softmax_pv8(S0, vX, l, O);
        post8<KS, IS, DSTEP, WIN, MASKED>(S1, bY, lc, lutg, m, l, O);
        loadV8(vX, bN, lane16); bX = bN;
        bN = bX; (void)next(bN); loadK8(kY, bN, lane16); __builtin_amdgcn_sched_barrier(0);
        qk8<MASKED>(kX, bX, lc, qf8, m, S0); softmax_pv8(S1, vY, l, O);
        post8<KS, IS, DSTEP, WIN, MASKED>(S0, bX, lc, lutg, m, l, O);
        loadV8(vY, bN, lane16); bY = bN;
    }
    if (n & 1) softmax_pv8(S0, vX, l, O);
}
template <int KS, int IS, int DSTEP, bool WIN, bool VF8, bool MASKED, class Next, class Hook>
__device__ __forceinline__ void run_blocks(Next& next, int n, const LaneCtx& lc, const bf16x8 (&qf)[2], const LAS float* lutg, float& m, float& l, f32x4 (&O)[4], unsigned lane16, Hook& hook) {
    Blk b0, b1; v4u kA[8], kB[8], vA[8], vB[8];
    long qf8[2] = {0, 0};
    if (VF8) {
#pragma unroll
        for (int ks = 0; ks < 2; ++ks) { const v4u w = __builtin_bit_cast(v4u, qf[ks]); int a = 0, b = 0;
            a = __builtin_amdgcn_cvt_pk_fp8_f32(bflo(w.x), bfhi(w.x), a, false); a = __builtin_amdgcn_cvt_pk_fp8_f32(bflo(w.y), bfhi(w.y), a, true);
            b = __builtin_amdgcn_cvt_pk_fp8_f32(bflo(w.z), bfhi(w.z), b, false); b = __builtin_amdgcn_cvt_pk_fp8_f32(bflo(w.w), bfhi(w.w), b, true);
            qf8[ks] = (long)(((unsigned long long)(unsigned)b << 32) | (unsigned long long)(unsigned)a); } }
    if (n <= 0) return;
    if (VF8) { Blk bX; v4u kX[4], vX[4]; run_blocks8<KS, IS, DSTEP, WIN, MASKED, false>(next, n, lc, qf8, lutg, m, l, O, lane16, bX, kX, vX); return; }
    (void)next(b0);
    load_block<VF8>(kA, vA, b0, lane16);
#pragma unroll 1
    for (int p = n >> 1; p > 0; --p) {
        b1 = b0; (void)next(b1);
        load_block<VF8>(kB, vB, b1, lane16); __builtin_amdgcn_sched_barrier(0);
        compute_block<KS, IS, DSTEP, WIN, VF8, MASKED>(kA, vA, b0, lc, qf, qf8, lutg, m, l, O, hook);
        b0 = b1; (void)next(b0);
        load_block<VF8>(kA, vA, b0, lane16); __builtin_amdgcn_sched_barrier(0);
        compute_block<KS, IS, DSTEP, WIN, VF8, MASKED>(kB, vB, b1, lc, qf, qf8, lutg, m, l, O, hook);
    }
    if (n & 1) compute_block<KS, IS, DSTEP, WIN, VF8, MASKED>(kA, vA, b0, lc, qf, qf8, lutg, m, l, O, hook);
}

template <int KS, int IS, int DSTEP, bool WIN, bool VF8, bool MASKED, class Next>
__device__ __forceinline__ void run_blocks(Next& next, int n, const LaneCtx& lc, const bf16x8 (&qf)[2], const LAS float* lutg, float& m, float& l, f32x4 (&O)[4], unsigned lane16) {
    NoHook nh; run_blocks<KS, IS, DSTEP, WIN, VF8, MASKED>(next, n, lc, qf, lutg, m, l, O, lane16, nh); }
__device__ __forceinline__ void acc_set(LAS float* aL, const f32x4 (&O)[4], float s, int lane) {
#pragma unroll
    for (int dt = 0; dt < 4; ++dt)
#pragma unroll
        for (int i = 0; i < 4; ++i) aL[(dt * 4 + i) * 64 + lane] = O[dt][i] * s; }
__device__ __forceinline__ void acc_add(LAS float* aL, const f32x4 (&O)[4], float s, int lane) {
#pragma unroll
    for (int dt = 0; dt < 4; ++dt)
#pragma unroll
        for (int i = 0; i < 4; ++i) aL[(dt * 4 + i) * 64 + lane] += O[dt][i] * s; }
template <int NSBP, bool ONLINE = false>
__device__ __forceinline__ void cmp_branch(const bf16* KC, const bf16* VCT, int ncb, int tcol, int t0, bool want_imp, const bf16x8 (&qf)[2], const LAS float* lutg, float bfar, float gate, LAS float* aL, LAS float* imp, int lane) {
    const int r = lane & 15, qp = lane >> 4, slot = r >> 2, g = r & 3;
    float m = -3.0e38f, l = 0.f; f32x4 O[4];
#pragma unroll
    for (int dt = 0; dt < 4; ++dt) O[dt] = (f32x4){0.f, 0.f, 0.f, 0.f};
    { int cb = 0;
      const LaneCtx lc{tcol - 31 - 64 * qp, bfar, 0ull, 0ull};
      auto next = [&](Blk& bl) -> bool { if (cb >= ncb) return false; bl.K = KC + (size_t)cb * 4096; bl.VT = VCT + (size_t)cb * 4096; bl.j = cb;
          bl.fast = t0 - (1024 * cb + 1039) >= 113; bl.edge = false; ++cb; return true; };
      if constexpr (ONLINE) { ImpHook hk{imp + 2048, imp + 640, 0.f, lane}; run_blocks<256, 16, 1024, false, false, false>(next, ncb, lc, qf, lutg, m, l, O, (unsigned)lane * 16u, hk); }
      else run_blocks<256, 16, 1024, false, false, false>(next, ncb, lc, qf, lutg, m, l, O, (unsigned)lane * 16u); }
    const float lt = col_total(l), rl = lt > 0.f ? 1.f / lt : 0.f;
    acc_set(aL, O, gate * rl, lane);
    if constexpr (ONLINE) {
      if (want_imp) {
        LAS float* imph = imp + 2048; LAS float* mlog = imp + 640; LAS float* mfl = imp + 768; LAS float* rll = imp + 784; LAS float* fac = imp + 800;
        if (lane < 16) { mfl[lane] = m > -1.0e29f ? m : 0.f; rll[lane] = rl; }
        LDS_WAIT(); asm volatile("" ::: "memory");
#pragma unroll
        for (int i = 0; i < 2; ++i) { const int e = lane + 64 * i, col = e & 15; fac[e] = (e >> 4) < ncb ? __builtin_amdgcn_exp2f(mlog[e] - mfl[col]) * rll[col] : 0.f; }
        LDS_WAIT(); asm volatile("" ::: "memory");
#pragma unroll
        for (int i = 0; i < 8; ++i) { const int o = lane + 64 * i, sl = o >> 7, j = o & 127;
            const f32x4 a = *(const LAS f32x4*)(imph + j * 16 + sl * 4), f = *(const LAS f32x4*)(fac + (j >> 4) * 16 + sl * 4);
            imp[o] = (j >> 4) < ncb ? (a[0] * f[0] + a[1] * f[1]) + (a[2] * f[2] + a[3] * f[3]) : 0.f; }
        LDS_WAIT(); asm volatile("" ::: "memory");
      }
    } else
    if (want_imp) {
        float hprev = 0.f; const int src_lane = (lane + 48) & 63; const float mm = m > -1.0e29f ? m : 0.f;
        bf16x8 kA[4][2], kB[4][2];
        auto ldk = [&](bf16x8 (&kf)[4][2], int cb) { const bf16* K = KC + (size_t)cb * 4096;
#pragma unroll
            for (int kt = 0; kt < 4; ++kt)
#pragma unroll
                for (int ks = 0; ks < 2; ++ks) kf[kt][ks] = *(const GAS bf16x8*)(K + ((kt * 2 + ks) * 64 + lane) * 8); };
        auto score = [&](const bf16x8 (&kf)[4][2], int cb) {
            const bool fast = t0 - (1024 * cb + 1039) >= 113; const float ini = fast ? bfar - mm : -mm; f32x4 S[4];
#pragma unroll
            for (int kt = 0; kt < 4; ++kt) { S[kt] = __builtin_amdgcn_mfma_f32_16x16x32_bf16(kf[kt][0], qf[0], (f32x4){ini, ini, ini, ini}, 0, 0, 0); S[kt] = __builtin_amdgcn_mfma_f32_16x16x32_bf16(kf[kt][1], qf[1], S[kt], 0, 0, 0); }
            if (!fast) { int d0 = tcol - 31 - 16 * (64 * cb + 4 * qp); asm volatile("" : "+v"(d0)); float b2[4][4];
#pragma unroll
                for (int kt = 0; kt < 4; ++kt)
#pragma unroll
                    for (int i = 0; i < 4; ++i) { const int d = d0 - 256 * kt - 16 * i; const int dc = d < 0 ? 0 : (d > 127 ? 127 : d); b2[kt][i] = lutg[dc]; }
#pragma unroll
                for (int kt = 0; kt < 4; ++kt) asm volatile("" : "+v"(b2[kt][0]), "+v"(b2[kt][1]), "+v"(b2[kt][2]), "+v"(b2[kt][3]));
#pragma unroll
                for (int kt = 0; kt < 4; ++kt)
#pragma unroll
                    for (int i = 0; i < 4; ++i) { const int d = d0 - 256 * kt - 16 * i; S[kt][i] = d >= 0 ? S[kt][i] + b2[kt][i] : -1.0e30f; } }
#pragma unroll
            for (int kt = 0; kt < 4; ++kt) { float pr[4];
#pragma unroll
                for (int i = 0; i < 4; ++i) pr[i] = __builtin_amdgcn_exp2f(S[kt][i]) * rl;
                const float h = 0.5f * pr[3]; const float a = (pr[0] + pr[1]) + (pr[2] + h);
                const float r1 = __shfl(hprev, src_lane), r2 = __shfl(h, src_lane);
                float v = a + (qp == 0 ? r1 : r2);
                v += quad_xor1(v); v += quad_xor2(v);
                const int j = 16 * cb + 4 * kt + qp;
                if (g == 0 && j < NSBP) imp[slot * NSBP + j] = v;
                hprev = h; } };
        if (ncb > 0) { ldk(kA, 0); int cb = 0;
#pragma unroll 1
            for (int p = ncb >> 1; p > 0; --p) {
                ldk(kB, cb + 1); score(kA, cb); ++cb;
                ldk(kA, cb + 1 < ncb ? cb + 1 : cb); score(kB, cb); ++cb;
            }
            if (ncb & 1) score(kA, cb); }
        LDS_WAIT(); asm volatile("" ::: "memory");
    }
}
struct PAttn { const bf16 *Qb, *KSp, *KWp, *VTs, *VTw, *KCp, *VCTp; const float* GN; bf16* Ab; };

template <class Pre>
__device__ __forceinline__ void prompt_attn_group(const PAttn& T, int b, int kvh, int t0, const LAS float* lut, LAS float* imp  , LAS unsigned* selm  , int lane, const Pre& pre) {
    const int r = lane & 15, qp = lane >> 4, qi = r >> 2, g = r & 3;
    const int tcol = t0 + qi, tok = b * SEQ + tcol, head = kvh * 4 + g, bk = b * 2 + kvh, cur = t0 >> 6;
    const LAS float* lutg = lut + head * LUTS + LUT0; const float bfar = lutg[127];
    LAS float* aL = imp + 1024;
    bf16x8 qf[2];
#pragma unroll
    for (int ks = 0; ks < 2; ++ks) qf[ks] = *(const GAS bf16x8*)(T.Qb + (size_t)tok * 512 + head * 64 + 32 * ks + 8 * qp);
    const float* gp = T.GN + (size_t)tok * 32 + kvh * 12 + g * 3;
    const float g0 = gp[0], g1 = gp[1], g2 = gp[2];
    unsigned mym[4], un[4];
    const int tmax = t0 + 3;
    const int ncb = tmax >= 31 ? (((tmax - 31) >> 4) >> 6) + 1 : 0;
    cmp_branch<128, true>(T.KCp + (size_t)bk * 512 * 64, T.VCTp + (size_t)bk * 8 * 4096, ncb, tcol, t0, cur >= 16, qf, lutg, bfar, g0, aL, imp, lane);
    Blk bS0; v4u kS0[4], vS0[4];
    bS0.K = T.KSp + (size_t)(bk * SEQ) * 64; bS0.VT = T.VTs + (size_t)(bk * 128) * 4096; bS0.j = 0; bS0.fast = 0 <= cur - 3; bS0.edge = false;
    loadK8(kS0, bS0, (unsigned)lane * 16u); loadV8(vS0, bS0, (unsigned)lane * 16u);
    if (cur >= 16) {
        { const int qs = lane >> 4, e = lane & 15; int io = qs * 128 + e; asm volatile("" : "+v"(io));
            LAS unsigned* impk = (LAS unsigned*)imp; unsigned key[8], rank[8];
#pragma unroll
            for (int i = 0; i < 8; ++i) { const int j = e + 16 * i; const unsigned bits = impk[io + 16 * i]; key[i] = (j >= 1 && j <= cur - 2) ? ((bits & ~127u) | (unsigned)(127 - j)) : 0u; rank[i] = 0u; }
#pragma unroll
            for (int i = 0; i < 8; ++i) impk[io + 16 * i] = key[i];
            if (e < 4) selm[qs * 4 + e] = 0u;
            LDS_WAIT(); asm volatile("" ::: "memory");
            const LAS v4u* kq = (const LAS v4u*)(impk + qs * 128);
            const int nk4 = (cur + 2) >> 2;
#pragma unroll 4
            for (int k4 = 0; k4 < nk4; ++k4) { const v4u kk = kq[k4];
#pragma unroll
                for (int i = 0; i < 8; ++i) rank[i] += (kk.x > key[i] ? 1u : 0u) + (kk.y > key[i] ? 1u : 0u) + (kk.z > key[i] ? 1u : 0u) + (kk.w > key[i] ? 1u : 0u); }
            unsigned mk4[4] = {0u, 0u, 0u, 0u};
#pragma unroll
            for (int i = 0; i < 8; ++i) { const int j = e + 16 * i; const bool tk = key[i] != 0u && rank[i] < (unsigned)(NSEL - 3);
#pragma unroll
                for (int w = 0; w < 4; ++w) mk4[w] |= (tk && w == (j >> 5)) ? (1u << (j & 31)) : 0u; }
            if (e == 0) {
#pragma unroll
                for (int w = 0; w < 4; ++w) { unsigned f = 0u; if (w == 0) f |= 1u; if (w == (cur >> 5)) f |= 1u << (cur & 31); if (w == ((cur - 1) >> 5)) f |= 1u << ((cur - 1) & 31); mk4[w] |= f; } }
#pragma unroll
            for (int w = 0; w < 4; ++w) if (mk4[w]) (void)__hip_atomic_fetch_or(selm + qs * 4 + w, mk4[w], __ATOMIC_RELAXED, __HIP_MEMORY_SCOPE_WORKGROUP);
        }
        LDS_WAIT(); asm volatile("" ::: "memory");
#pragma unroll
        for (int w = 0; w < 4; ++w) { mym[w] = selm[qi * 4 + w]; const unsigned u = selm[w] | selm[4 + w] | selm[8 + w] | selm[12 + w]; un[w] = (unsigned)__builtin_amdgcn_readfirstlane((int)u); }
        LDS_WAIT(); asm volatile("" ::: "memory");
    } else {
        mym[0] = (2u << cur) - 1u; mym[1] = 0u; mym[2] = 0u; mym[3] = 0u;
#pragma unroll
        for (int w = 0; w < 4; ++w) un[w] = mym[w];
    }
    {
        float m = -3.0e38f, l = 0.f; f32x4 O[4];
#pragma unroll
        for (int dt = 0; dt < 4; ++dt) O[dt] = (f32x4){0.f, 0.f, 0.f, 0.f};
        { unsigned long long ulo = ((unsigned long long)un[1] << 32) | un[0], uhi = ((unsigned long long)un[3] << 32) | un[2];
          const int nsel = __builtin_popcountll(ulo) + __builtin_popcountll(uhi); ulo &= ~1ull;
          const LaneCtx lc{tcol - 4 * qp, bfar, ((unsigned long long)mym[1] << 32) | mym[0], ((unsigned long long)mym[3] << 32) | mym[2]};
          auto next = [&](Blk& bl) -> bool {
              if ((ulo | uhi) == 0ull) return false;
              const bool inlo = ulo != 0ull; const unsigned long long u = inlo ? ulo : uhi;
              const int j = (inlo ? 0 : 64) + __builtin_ctzll(u); const unsigned long long u2 = u & (u - 1ull);
              ulo = inlo ? u2 : ulo; uhi = inlo ? uhi : u2;
              bl.K = T.KSp + (size_t)(bk * SEQ + 64 * j) * 64; bl.VT = T.VTs + (size_t)(bk * 128 + j) * 4096; bl.j = j; bl.fast = j <= cur - 3; bl.edge = false; return true; };
          long qf8[2]; make_qf8(qf, qf8);
          run_blocks8<16, 1, 64, false, true, true>(next, nsel, lc, qf8, lutg, m, l, O, (unsigned)lane * 16u, bS0, kS0, vS0); }
        const float lt = col_total(l), rl = lt > 0.f ? 1.f / lt : 0.f;
        acc_add(aL, O, g1 * rl, lane);
    }
    pre();
    {
        float m = -3.0e38f, l = 0.f; f32x4 O[4];
#pragma unroll
        for (int dt = 0; dt < 4; ++dt) O[dt] = (f32x4){0.f, 0.f, 0.f, 0.f};
        const int jlo = t0 >= WINL - 1 ? (t0 - (WINL - 1)) >> 6 : 0;
        { int j = jlo;
          const LaneCtx lc{tcol - 4 * qp, bfar, 0ull, 0ull};
          auto next = [&](Blk& bl) -> bool { if (j > cur) return false; bl.K = T.KWp + (size_t)(bk * SEQ + 64 * j) * 64; bl.VT = T.VTw + (size_t)(bk * 128 + j) * 4096; bl.j = j;
              bl.edge = t0 + 3 - 64 * j >= WINL; bl.fast = t0 - (64 * j + 63) >= 113 && !bl.edge; ++j; return true; };
          run_blocks<16, 1, 64, true, true, false>(next, cur - jlo + 1, lc, qf, lutg, m, l, O, (unsigned)lane * 16u); }
        const float lt = col_total(l), rl = lt > 0.f ? 1.f / lt : 0.f;
        bf16* ap = T.Ab + (size_t)tok * 512 + head * 64 + 4 * qp; const float s2 = g2 * rl;
#pragma unroll
        for (int dt = 0; dt < 4; ++dt) { float a[4];
#pragma unroll
            for (int i = 0; i < 4; ++i) a[i] = aL[(dt * 4 + i) * 64 + lane] + O[dt][i] * s2;
            v2u w; w.x = pk2(a[0], a[1]); w.y = pk2(a[2], a[3]); *(GAS v2u*)(ap + 16 * dt) = w; }
    }
}

struct SAttn { const bf16* Qb; const bf16 *KCs, *VCTs, *KWs, *VTWs, *KSn, *VTSn; const float *ck, *cv; const int* pt; const float* GN; bf16* Ab; };

template <class Pre>
__device__ __forceinline__ void sample_attn_unit(const SAttn& T, int unit, const LAS float* lut, LAS float* imp  , LAS int* sel  , int lane, const Pre& pre) {
    const int b = unit >> 3, kvh = (unit >> 2) & 1, qi = unit & 3, t = PAST + qi, tok = NP + b * DECS + qi, bk = b * 2 + kvh;
    const int r = lane & 15, qp = lane >> 4, g = r & 3, head = kvh * 4 + g;
    const LAS float* lutg = lut + head * LUTS + LUT0; const float bfar = lutg[127];
    LAS float* aL = imp + 2048;
    bf16x8 qf[2];
#pragma unroll
    for (int ks = 0; ks < 2; ++ks) qf[ks] = *(const GAS bf16x8*)(T.Qb + (size_t)tok * 512 + head * 64 + 32 * ks + 8 * qp);
    const float* gp = T.GN + (size_t)tok * 32 + kvh * 12 + g * 3;
    const float g0 = gp[0], g1 = gp[1], g2 = gp[2];
    cmp_branch<256>(T.KCs + (size_t)bk * 1024 * 64, T.VCTs + (size_t)bk * 16 * 4096, 16, t, t, true, qf, lutg, bfar, g0, aL, imp, lane);
    { LAS unsigned* impk = (LAS unsigned*)imp; unsigned key[4], rank[4];
#pragma unroll
      for (int jb = 0; jb < 4; ++jb) { const int j = jb * 64 + lane; const unsigned bits = impk[j]; key[jb] = (j >= 1 && j <= 254) ? ((bits & ~255u) | (unsigned)(255 - j)) : 0u; rank[jb] = 0u; }
#pragma unroll
      for (int jb = 0; jb < 4; ++jb) impk[jb * 64 + lane] = key[jb];
      if (lane == 0) { sel[0] = 0; sel[1] = 255; sel[2] = 256; }
      LDS_WAIT(); asm volatile("" ::: "memory");
      const LAS v4u* kq = (const LAS v4u*)impk;
#pragma unroll 4
      for (int k4 = 0; k4 < 64; ++k4) { const v4u kk = kq[k4];
#pragma unroll
          for (int i = 0; i < 4; ++i) rank[i] += (kk.x > key[i] ? 1u : 0u) + (kk.y > key[i] ? 1u : 0u) + (kk.z > key[i] ? 1u : 0u) + (kk.w > key[i] ? 1u : 0u); }
      int base = 3;
#pragma unroll
      for (int jb = 0; jb < 4; ++jb) { const bool tk = key[jb] != 0u && rank[jb] < (unsigned)(NSEL - 3); const unsigned long long bm = __ballot(tk);
          if (tk) sel[base + __popcll(bm & ((1ull << lane) - 1ull))] = jb * 64 + lane;
          base += __popcll(bm); }
      LDS_WAIT(); asm volatile("" ::: "memory"); }
    {
        float m = -3.0e38f, l = 0.f; f32x4 O[4];
#pragma unroll
        for (int dt = 0; dt < 4; ++dt) O[dt] = (f32x4){0.f, 0.f, 0.f, 0.f};
        const int* ptb = T.pt + b * NPAGE;
        const int jv = sel[lane & 15]; const int pgv = jv < 256 ? ptb[jv >> 1] : 0;
#pragma unroll 1
        for (int i = 0; i < NSEL; ++i) { const int j = __builtin_amdgcn_readlane(jv, i);
            const AttnMaskSel mk{t - 64 * j - 4 * qp, true};
            if (j >= 256) { const SrcB src{T.KSn + (size_t)bk * 4096, T.VTSn + (size_t)bk * 4096};
                attn_block<false>(src, qf, lutg, mk, 0.f, m, l, O, r, qp); }
            else { const int page = __builtin_amdgcn_readlane(pgv, i); const size_t o = (((size_t)page * PAGE + (j & 1) * 64) * 2 + kvh) * 64; const SrcF src{T.ck + o, T.cv + o};
                if (j <= 253) attn_block<true>(src, qf, lutg, mk, bfar, m, l, O, r, qp);
                else attn_block<false>(src, qf, lutg, mk, 0.f, m, l, O, r, qp); } }
        const float lt = col_total(l), rl = lt > 0.f ? 1.f / lt : 0.f;
        acc_add(aL, O, g1 * rl, lane);
    }
    pre();
    {
        float m = -3.0e38f, l = 0.f; f32x4 O[4];
#pragma unroll
        for (int dt = 0; dt < 4; ++dt) O[dt] = (f32x4){0.f, 0.f, 0.f, 0.f};
        constexpr int WPOS0 = PAST + DECS - (WINL + DECS);
        { int jb = 0;
          const LaneCtx lc{t - WPOS0 - 4 * qp, bfar, 0ull, 0ull};
          auto next = [&](Blk& bl) -> bool { if (jb >= 9) return false; const int pos0 = WPOS0 + 64 * jb; bl.K = T.KWs + (size_t)(bk * 576 + 64 * jb) * 64; bl.VT = T.VTWs + (size_t)(bk * 9 + jb) * 4096; bl.j = jb;
              bl.edge = t - pos0 >= WINL; bl.fast = t - (pos0 + 63) >= 113 && !bl.edge; ++jb; return true; };
          run_blocks<16, 1, 64, true, false, false>(next, 9, lc, qf, lutg, m, l, O, (unsigned)lane * 16u); }
        const float lt = col_total(l), rl = lt > 0.f ? 1.f / lt : 0.f;
        bf16* ap = T.Ab + (size_t)tok * 512 + head * 64 + 4 * qp; const float s2 = g2 * rl;
#pragma unroll
        for (int dt = 0; dt < 4; ++dt) { float a[4];
#pragma unroll
            for (int i = 0; i < 4; ++i) a[i] = aL[(dt * 4 + i) * 64 + lane] + O[dt][i] * s2;
            if (r < 4) { v2u w; w.x = pk2(a[0], a[1]); w.y = pk2(a[2], a[3]); *(GAS v2u*)(ap + 16 * dt) = w; } }
    }
}


constexpr int N_PHASES = 10;
struct Args { const void* in[28]; float* out; unsigned char* ws; int ph_lo, ph_hi; };
static_assert(sizeof(Args) == 28 * 8 + 8 + 8 + 8, "Args has no padding");

__global__ void __launch_bounds__(NWAVES * 64, 2) nsa_fwd(Args args) {
    extern __shared__ __attribute__((aligned(16))) unsigned char lds_raw[];
    LAS unsigned char* lds = (LAS unsigned char*)lds_raw;
    volatile LAS unsigned* MISC = (volatile LAS unsigned*)(lds + MISC_OFF);
    const int tid = threadIdx.x;
    const int G = gridDim.x, bx = blockIdx.x, NGW = G * NWAVES;
#define PHASE_IDS() int tid_ = threadIdx.x; asm volatile("" : "+v"(tid_)); const int lane = tid_ & 63, wave = __builtin_amdgcn_readfirstlane(tid_ >> 6), gw = bx * NWAVES + wave; (void)lane; (void)gw
    unsigned char* ws = args.ws; float* out = args.out;
    gu32* ctl = (gu32*)(ws + WS_CTL);
    const float* x_prompt = (const float*)args.in[0]; const float* x_sample = (const float*)args.in[1];
    for (int u = tid; u < (LDS_BYTES - LDSCTL_OFF) / 4; u += NWAVES * 64) ((LAS unsigned*)(lds + LDSCTL_OFF))[u] = 0u;
    { const float* rel_bias = (const float*)args.in[26]; LAS float* lut = (LAS float*)(lds + LUT_OFF);
      for (int u = tid; u < 8 * LUTS; u += NWAVES * 64) { const int h = u / LUTS, d = u % LUTS - LUT0; const int n = d > 127 ? 127 : d; int bkt = n;
          if (n >= 16) { bkt = 16; const int th[15] = {19, 21, 24, 27, 31, 35, 40, 46, 52, 59, 67, 77, 87, 99, 113};
#pragma unroll
              for (int i = 0; i < 15; ++i) bkt += (n >= th[i]) ? 1 : 0; }
          lut[u] = d < 0 ? -1.0e30f : rel_bias[bkt * NH + h] * LOG2E; } }
    __syncthreads();
#if MK_N_LAUNCHES == 1
    XcdBarrier bar = xcd_barrier_post((unsigned*)(ctl + CW_BAR), MISC + 8);
#define GRID_BAR() xcd_barrier(bar)
#else
#define GRID_BAR() do {} while (0)
#endif
    const int lo = args.ph_lo, hi = args.ph_hi;
#ifndef PH_MASK
#define PH_MASK 0x3ff
#endif
#define IN(k) ((((PH_MASK) >> (k)) & 1) && lo <= (k) && (k) < hi)
#define BOTH(k) (IN(k) && IN((k) + 1))
#ifdef DBG_REP_PHASE
#define REP(k) ((((DBG_REP_PHASE) >> (k)) & 1) ? 2 : 1)
#else
#define REP(k) 1
#endif
    using pg8::bf16_t;
    bf16* WinT = (bf16*)(ws + WS_WIN); bf16* WnsaT = (bf16*)(ws + WS_WNSA); bf16* WconvT = (bf16*)(ws + WS_WCONV); bf16* WoT = (bf16*)(ws + WS_WO);
    bf16* WupT = (bf16*)(ws + WS_WUP); bf16* WdnT = (bf16*)(ws + WS_WDN); bf16* W1Tk = (bf16*)(ws + WS_W1K); bf16* W1Tv = (bf16*)(ws + WS_W1V);
    bf16* W2Tk = (bf16*)(ws + WS_W2K); bf16* W2Tv = (bf16*)(ws + WS_W2V); float* PE = (float*)(ws + WS_PE);
    bf16* XN = (bf16*)(ws + WS_XN); bf16* Qb = (bf16*)(ws + WS_QB); bf16* CV = (bf16*)(ws + WS_CV); bf16* GAB = (bf16*)(ws + WS_GAB); float* GN = (float*)(ws + WS_GN);
    bf16* CKp = (bf16*)(ws + WS_CKP); bf16* CVp = (bf16*)(ws + WS_CVP); bf16* KSp = (bf16*)(ws + WS_KSP); bf16* KWp = (bf16*)(ws + WS_KWP); bf16* VTs = (bf16*)(ws + WS_VTS); bf16* VTw = (bf16*)(ws + WS_VTW);
    bf16* Gp = (bf16*)(ws + WS_GP); bf16* KCp = (bf16*)(ws + WS_KCP); bf16* VCTp = (bf16*)(ws + WS_VCTP); bf16* Ab = (bf16*)(ws + WS_AB); bf16* Cb = (bf16*)(ws + WS_CB);
    float* M1 = (float*)(ws + WS_M1); bf16* Mb = (bf16*)(ws + WS_MB); float* X1 = (float*)(ws + WS_X1); bf16* X1b = (bf16*)(ws + WS_X1B); float* PSS = (float*)(ws + WS_PSS); bf16* Hb = (bf16*)(ws + WS_H);
    bf16* CKs = (bf16*)(ws + WS_CKS); bf16* CVs = (bf16*)(ws + WS_CVS); bf16* Gs = (bf16*)(ws + WS_GS); bf16* KCs = (bf16*)(ws + WS_KCS); bf16* VCTs = (bf16*)(ws + WS_VCS); bf16* KWs = (bf16*)(ws + WS_KWS); bf16* VTWs = (bf16*)(ws + WS_VTWS); float* PD = (float*)(ws + WS_PD);

    if (IN(0)) for (int rep = 0; rep < REP(0); ++rep) {
        PHASE_IDS();
        LAS float* scr = (LAS float*)(lds + RING_OFF + wave * 16384);
        constexpr int I_IN = 16 * (NIN / 32), I_NSA = 8 * 32, I_CONV = 8 * 32, I_WO = 16 * 32, I_UP = 16 * 128, I_DN = 64 * 32, I_W1 = 32 * 8, I_W2 = 4 * 2;
        constexpr int NT_ITEMS = I_IN + I_NSA + I_CONV + I_WO + I_UP + I_DN + 2 * I_W1 + 2 * I_W2;
        for (int it = gw; it < NT_ITEMS; it += NGW) {
            int r = it;
            if (r < I_IN) { p0_transpose_item<1>((const float*)args.in[11], 1024, INCOLS, NIN, WinT, nullptr, scr, r, lane); continue; } r -= I_IN;
            if (r < I_NSA) { p0_transpose_item<0>((const float*)args.in[20], 512, 1024, 1024, WnsaT, nullptr, scr, r, lane); continue; } r -= I_NSA;
            if (r < I_CONV) { p0_transpose_item<0>((const float*)args.in[21], 512, 1024, 1024, WconvT, nullptr, scr, r, lane); continue; } r -= I_CONV;
            if (r < I_WO) { p0_transpose_item<0>((const float*)args.in[22], 1024, 1024, 1024, WoT, nullptr, scr, r, lane); continue; } r -= I_WO;
            if (r < I_UP) { p0_transpose_item<0>((const float*)args.in[24], 1024, 4096, 4096, WupT, (const float*)args.in[23], scr, r, lane); continue; } r -= I_UP;
            if (r < I_DN) { p0_transpose_item<0>((const float*)args.in[25], 4096, 1024, 1024, WdnT, nullptr, scr, r, lane); continue; } r -= I_DN;
            if (r < I_W1) { p0_transpose_item<0>((const float*)args.in[13], 2048, 256, 256, W1Tk, nullptr, scr, r, lane); continue; } r -= I_W1;
            if (r < I_W1) { p0_transpose_item<0>((const float*)args.in[16], 2048, 256, 256, W1Tv, nullptr, scr, r, lane); continue; } r -= I_W1;
            if (r < I_W2) { p0_transpose_item<0>((const float*)args.in[14], 256, 64, 64, W2Tk, nullptr, scr, r, lane); continue; } r -= I_W2;
            p0_transpose_item<0>((const float*)args.in[17], 256, 64, 64, W2Tv, nullptr, scr, r, lane);
        }
        { const float* g_attn = (const float*)args.in[10];
#pragma unroll 4
          for (int m = gw; m < NP; m += NGW) rms_row_to_bf16(x_prompt + (size_t)m * DM, g_attn, XN + (size_t)m * DM, lane);
          for (int m = NP + gw; m < MTOK; m += NGW) {
              if (m < NP + NSMP) rms_row_to_bf16(x_sample + (size_t)(m - NP) * DM, g_attn, XN + (size_t)m * DM, lane);
              else { GAS v4u* o = (GAS v4u*)(XN + (size_t)m * DM) + lane; o[0] = (v4u){0u, 0u, 0u, 0u}; o[64] = (v4u){0u, 0u, 0u, 0u}; } } }
        for (int it = (wave ^ 5) * G + bx; it < 128; it += NGW) { const int kv = it >> 6, c0 = (it & 63) * 4, c = lane & 3, kp = lane >> 2;
            const float* pe = (const float*)args.in[kv ? 15 : 12]; const float* w1 = (const float*)args.in[kv ? 16 : 13];
            float s = 0.f;
#pragma unroll 32
            for (int i = 0; i < 128; ++i) { const int k = kp + 16 * i; s += pe[k] * w1[(size_t)k * 256 + c0 + c]; }
            s += __shfl_xor(s, 4); s += __shfl_xor(s, 8); s += __shfl_xor(s, 16); s += __shfl_xor(s, 32);
            if (kp == 0) PE[kv * 256 + c0 + c] = s; }
        for (int it = wave * G + bx; it < 2 * DECB * 16; it += NGW) { const int kv = it / (DECB * 16), b = (it / 16) % DECB, part = it & 15;
            const float* src = (const float*)args.in[kv ? 7 : 6] + (size_t)b * WINL * 128; float* dst = out + (kv ? O_SWV : O_SWK) + (size_t)b * WINL * 128;
            f32x4 v[16];
#pragma unroll
            for (int i = 0; i < 16; ++i) { const int j = part * 32 + 2 * i + (lane >> 5); v[i] = *(const GAS f32x4*)(src + (size_t)(j + DECS < WINL ? j + DECS : WINL - 1) * 128 + (lane & 31) * 4); }
#pragma unroll
            for (int i = 0; i < 16; ++i) { const int j = part * 32 + 2 * i + (lane >> 5); if (j < WINL - DECS) *(GAS f32x4*)(dst + (size_t)j * 128 + (lane & 31) * 4) = v[i]; } }
        if (gw < 4) { bf16* p = gw == 0 ? CKp + (size_t)4 * SEQ * 64 : gw == 1 ? CVp + (size_t)4 * SEQ * 64 : gw == 2 ? CKs + (size_t)64 * PAST * 64 : CVs + (size_t)64 * PAST * 64;
            ((GAS v4u*)p)[lane] = (v4u){0u, 0u, 0u, 0u}; ((GAS v4u*)p)[64 + lane] = (v4u){0u, 0u, 0u, 0u}; }
        if (BOTH(0)) GRID_BAR();
    }

    if (IN(1)) for (int rep = 0; rep < REP(1); ++rep) {
        if ((bx & 1) == 0) { PHASE_IDS();
          constexpr int NITEM = 2 * DECB * NPAGE * 4; const int istep = (G >> 1) * NWAVES; const int c = (lane & 31) * 4, kvh = c >> 6, d = c & 63, rsel = lane >> 5;
          const int* ptab = (const int*)args.in[9];
          auto ipage = [&](int it) -> int { const int rem = it % (DECB * NPAGE * 4), b = rem / (NPAGE * 4), pg = (rem / 4) % NPAGE; return b * NPAGE + pg; };
          auto idst = [&](int it) -> bf16* { const int kv = it / (DECB * NPAGE * 4), rem = it % (DECB * NPAGE * 4), b = rem / (NPAGE * 4), pg = (rem / 4) % NPAGE, qt = rem & 3;
              return (kv ? CVs : CKs) + ((size_t)(b * 2 + kvh) * PAST + pg * PAGE + qt * 32 + rsel) * 64 + d; };
          f32x4 va[16], vb[16];
#pragma unroll 1
          for (int itc = (bx >> 1) * NWAVES + wave; itc < NITEM; itc += 64 * istep) {
              const int itl = itc + lane * istep; const int pv = ptab[ipage(itl < NITEM ? itl : itc)];
              const int nleft = (NITEM - itc + istep - 1) / istep, n = nleft < 64 ? nleft : 64;
              auto ld = [&](f32x4 (&v)[16], int k) { const int it = itc + k * istep; const int page = __builtin_amdgcn_readlane(pv, k);
                  const float* s0 = (const float*)args.in[it >= DECB * NPAGE * 4 ? 3 : 2] + ((size_t)page * PAGE + (it & 3) * 32 + rsel) * 128 + c;
#pragma unroll
                  for (int i = 0; i < 16; ++i) v[i] = __builtin_nontemporal_load((const GAS f32x4*)(s0 + (size_t)i * 256)); };
              auto st = [&](const f32x4 (&v)[16], int k) { bf16* dp = idst(itc + k * istep);
#pragma unroll
                  for (int i = 0; i < 16; ++i) { v2u w; w.x = pk2(v[i].x, v[i].y); w.y = pk2(v[i].z, v[i].w); __builtin_nontemporal_store(w, (GAS v2u*)(dp + (size_t)i * 128)); } };
              ld(va, 0); int k = 0;
#pragma unroll 1
              for (int p = n >> 1; p > 0; --p) {
                  ld(vb, k + 1); __builtin_amdgcn_sched_barrier(0); st(va, k);
                  ld(va, k + 2 < n ? k + 2 : k + 1); __builtin_amdgcn_sched_barrier(0); st(vb, k + 1);
                  k += 2;
              }
              if (n & 1) st(va, k);
          }
        }
        { pg8::Gemm g{XN, WinT, MTOK, NIN, DM, DM, DM}; pg8::MixedOrder S; S.init(MTOK, NIN, bx, W_IN_R0);
          pg8::EpiIn E{out, Qb, CV, GAB, GN, CKp, CVp};
          pg8::gemm_phase<pg8::EpiIn, pg8::MixedOrder, true, true>(lds + RING_OFF, g, S, E); }
        GRID_BAR();
        { PHASE_IDS();
        for (int it = wave * G + bx; it < 2 * 64 * 8; it += NGW) { const int kv = it >> 9, rg = (it >> 3) & 63, cg = it & 7;
            const SkHid E{Gp + (size_t)kv * 2048 * 256, PE + kv * 256};
            skinny_unit<2, 2>(kv ? CVp : CKp, 1024, kv ? W1Tv : W1Tk, 2048, 2048, rg * 32, cg * 32, E, lane); }
        for (int it = (wave & 3) * G + bx + (wave < 4 ? 0 : NGW); it < 64 * 10; it += NGW) { const int bk = it / 10, jb = it % 10, b = bk >> 1, kvh = bk & 1, j = jb * 64 + lane;
            const float* kr = nullptr; const float* vr = nullptr;
            if (jb == 9) { if (lane < DECS) { const size_t o = ((size_t)(b * DECS + lane) * 2 + kvh) * 64; kr = out + O_SSK + o; vr = out + O_SSV + o; } }
            else if (j < WINL) { const size_t o = ((size_t)(b * WINL + j) * 2 + kvh) * 64; kr = (const float*)args.in[6] + o; vr = (const float*)args.in[7] + o; }
            else if (j < WINL + DECS) { const size_t o = ((size_t)(b * WINL + (WINL - DECS) + (j - WINL)) * 2 + kvh) * 64; kr = out + O_SWK + o; vr = out + O_SWV + o; }
            bf16* kd = jb == 9 ? KWs + (size_t)64 * 576 * 64 + (size_t)bk * 4096 : KWs + (size_t)(bk * 9 + jb) * 4096;
            bf16* vd = jb == 9 ? VTWs + (size_t)64 * 9 * 4096 + (size_t)bk * 4096 : VTWs + (size_t)(bk * 9 + jb) * 4096;
#pragma unroll 4
            for (int c = 0; c < 8; ++c) { f32x4 a = (f32x4){0.f, 0.f, 0.f, 0.f}, bb = a, x = a, y = a;
                if (kr) { a = *(const GAS f32x4*)(kr + 8 * c); bb = *(const GAS f32x4*)(kr + 8 * c + 4); x = *(const GAS f32x4*)(vr + 8 * c); y = *(const GAS f32x4*)(vr + 8 * c + 4); }
                v4u w; w.x = pk2(a[0], a[1]); w.y = pk2(a[2], a[3]); w.z = pk2(bb[0], bb[1]); w.w = pk2(bb[2], bb[3]); *(GAS v4u*)(kd + ktile_off(lane, 8 * c)) = w;
#pragma unroll
                for (int i = 0; i < 4; ++i) { vd[vtile_off(lane, 8 * c + i)] = f2bf_rne(x[i]); vd[vtile_off(lane, 8 * c + 4 + i)] = f2bf_rne(y[i]); } } }
        { const float* conv_w = (const float*)args.in[18]; const float* conv_b = (const float*)args.in[19]; const float* state_conv = (const float*)args.in[8];
          if (wave >= 4) { const int nwv = 4 * G, wid = (wave - 4) * G + bx, CH = (NP + nwv - 1) / nwv, m0 = wid * CH, m1 = m0 + CH < NP ? m0 + CH : NP;
            if (m0 < m1) { const int d0 = lane * 8;
              auto cvt8 = [&](const v4u& w, float (&v)[8]) { v[0] = bflo(w.x); v[1] = bfhi(w.x); v[2] = bflo(w.y); v[3] = bfhi(w.y); v[4] = bflo(w.z); v[5] = bfhi(w.z); v[6] = bflo(w.w); v[7] = bfhi(w.w); };
              auto ldf8 = [&](const float* p, float (&u)[8]) { const f32x4 a = *(const GAS f32x4*)p, c = *(const GAS f32x4*)(p + 4); u[0] = a.x; u[1] = a.y; u[2] = a.z; u[3] = a.w; u[4] = c.x; u[5] = c.y; u[6] = c.z; u[7] = c.w; };
              float w0[8], w1[8], w2[8], cb[8]; ldf8(conv_w + d0, w0); ldf8(conv_w + CONVD + d0, w1); ldf8(conv_w + 2 * CONVD + d0, w2); ldf8(conv_b + d0, cb);
              float u0[8], u1[8];
              { const int r1 = m0 >= 1 ? m0 - 1 : 0, r0 = m0 >= 2 ? m0 - 2 : 0;
                const v4u a1 = *(const GAS v4u*)(CV + (size_t)r1 * 1536 + 512 + d0), c1 = *(const GAS v4u*)(CV + (size_t)r1 * 1536 + 1024 + d0);
                const v4u a0 = *(const GAS v4u*)(CV + (size_t)r0 * 1536 + 512 + d0), c0 = *(const GAS v4u*)(CV + (size_t)r0 * 1536 + 1024 + d0);
                float fa[8], fc[8]; cvt8(a1, fa); cvt8(c1, fc);
#pragma unroll
                for (int i = 0; i < 8; ++i) u1[i] = fa[i] * fc[i];
                cvt8(a0, fa); cvt8(c0, fc);
#pragma unroll
                for (int i = 0; i < 8; ++i) u0[i] = fa[i] * fc[i]; }
              v4u rb = *(const GAS v4u*)(CV + (size_t)m0 * 1536 + d0), ra = *(const GAS v4u*)(CV + (size_t)m0 * 1536 + 512 + d0), rc = *(const GAS v4u*)(CV + (size_t)m0 * 1536 + 1024 + d0);
#pragma unroll 1
              for (int m = m0; m < m1; ++m) { const int mn = m + 1 < m1 ? m + 1 : m;
                  const v4u nb = *(const GAS v4u*)(CV + (size_t)mn * 1536 + d0), na = *(const GAS v4u*)(CV + (size_t)mn * 1536 + 512 + d0), nc = *(const GAS v4u*)(CV + (size_t)mn * 1536 + 1024 + d0);
                  float bg[8], fa[8], fc[8], u2[8]; cvt8(rb, bg); cvt8(ra, fa); cvt8(rc, fc);
                  const int t = m & (SEQ - 1); const float z1 = t >= 1 ? 1.f : 0.f, z0 = t >= 2 ? 1.f : 0.f;
                  float y[8];
#pragma unroll
                  for (int i = 0; i < 8; ++i) { u2[i] = fa[i] * fc[i]; y[i] = bg[i] * (cb[i] + w0[i] * (z0 * u0[i]) + w1[i] * (z1 * u1[i]) + w2[i] * u2[i]); }
                  if (t >= SEQ - 2) { float* pc = out + O_PCONV + (size_t)((m >> 13) * 2 + (t - (SEQ - 2))) * CONVD + d0; *(GAS f32x4*)pc = (f32x4){u2[0], u2[1], u2[2], u2[3]}; *(GAS f32x4*)(pc + 4) = (f32x4){u2[4], u2[5], u2[6], u2[7]}; }
                  v4u w; w.x = pk2(y[0], y[1]); w.y = pk2(y[2], y[3]); w.z = pk2(y[4], y[5]); w.w = pk2(y[6], y[7]);
                  *(GAS v4u*)(Cb + (size_t)m * 512 + d0) = w;
#pragma unroll
                  for (int i = 0; i < 8; ++i) { u0[i] = u1[i]; u1[i] = u2[i]; }
                  rb = nb; ra = na; rc = nc; } } }
          for (int m = wave < 4 ? NP + NSMP : NP + (wave - 4) * G + bx; m < NP + NSMP; m += 4 * G) {
              const int d0 = lane * 8; float u0[8], u1[8], u2[8], bg[8];
              auto ld8 = [&](const bf16* p, float (&v)[8]) { const v4u w = *(const GAS v4u*)p; v[0] = bflo(w.x); v[1] = bfhi(w.x); v[2] = bflo(w.y); v[3] = bfhi(w.y); v[4] = bflo(w.z); v[5] = bfhi(w.z); v[6] = bflo(w.w); v[7] = bfhi(w.w); };
              auto urow = [&](int row, float (&u)[8]) { float a[8], c[8]; ld8(CV + (size_t)row * 1536 + 512 + d0, a); ld8(CV + (size_t)row * 1536 + 1024 + d0, c);
#pragma unroll
                  for (int i = 0; i < 8; ++i) u[i] = a[i] * c[i]; };
              auto zero8 = [&](float (&u)[8]) {
#pragma unroll
                  for (int i = 0; i < 8; ++i) u[i] = 0.f; };
              auto st8 = [&](const float* p, float (&u)[8]) { const f32x4 a = *(const GAS f32x4*)p, c = *(const GAS f32x4*)(p + 4); u[0] = a.x; u[1] = a.y; u[2] = a.z; u[3] = a.w; u[4] = c.x; u[5] = c.y; u[6] = c.z; u[7] = c.w; };
              urow(m, u2); ld8(CV + (size_t)m * 1536 + d0, bg);
              if (m < NP) { const int t = m & (SEQ - 1);
                  if (t >= 1) urow(m - 1, u1); else zero8(u1);
                  if (t >= 2) urow(m - 2, u0); else zero8(u0);
                  if (t >= SEQ - 2) { float* pc = out + O_PCONV + (size_t)((m >> 13) * 2 + (t - (SEQ - 2))) * CONVD + d0; *(GAS f32x4*)pc = (f32x4){u2[0], u2[1], u2[2], u2[3]}; *(GAS f32x4*)(pc + 4) = (f32x4){u2[4], u2[5], u2[6], u2[7]}; }
              } else { const int tk = m - NP, b = tk >> 2, s = tk & 3;
                  if (s >= 1) urow(m - 1, u1); else st8(state_conv + (size_t)(b * 2 + 1) * CONVD + d0, u1);
                  if (s >= 2) urow(m - 2, u0); else st8(state_conv + (size_t)(b * 2 + s) * CONVD + d0, u0);
                  if (s >= 2) { float* pc = out + O_SCONV + (size_t)(b * 2 + (s - 2)) * CONVD + d0; *(GAS f32x4*)pc = (f32x4){u2[0], u2[1], u2[2], u2[3]}; *(GAS f32x4*)(pc + 4) = (f32x4){u2[4], u2[5], u2[6], u2[7]}; }
              }
              float w0[8], w1[8], w2[8], cb[8]; st8(conv_w + d0, w0); st8(conv_w + CONVD + d0, w1); st8(conv_w + 2 * CONVD + d0, w2); st8(conv_b + d0, cb);
              float y[8];
#pragma unroll
              for (int i = 0; i < 8; ++i) y[i] = bg[i] * (cb[i] + w0[i] * u0[i] + w1[i] * u1[i] + w2[i] * u2[i]);
              v4u w; w.x = pk2(y[0], y[1]); w.y = pk2(y[2], y[3]); w.z = pk2(y[4], y[5]); w.w = pk2(y[6], y[7]);
              *(GAS v4u*)(Cb + (size_t)m * 512 + d0) = w; }
          for (int m = NP + NSMP + gw; m < MTOK; m += NGW) *(GAS v4u*)(Cb + (size_t)m * 512 + lane * 8) = (v4u){0u, 0u, 0u, 0u};
        }
        }
#ifndef DBG_NO_CMP
        { pg8::Gemm g{CKs, W1Tk, 65536, 512, 2048, 1024, 2048};
          struct KVOrder { pg8::StaticOrder so; __device__ __forceinline__ bool next(int i, pg8::Unit& u) const { if (!so.next(i, u)) return false; u.aoff = u.pn ? (int)(WS_CVS - WS_CKS) : 0; return true; }
              __device__ __forceinline__ void a_ready(const pg8::Unit&) const {} __device__ __forceinline__ void done(const pg8::Unit&) const {} } S; S.so.init(65536, 512, G, bx);
          pg8::EpiCmp E{Gs, PE, (size_t)65536 * 256};
          pg8::gemm_phase<pg8::EpiCmp, KVOrder, true, true>(lds + RING_OFF, g, S, E);
          { PHASE_IDS(); pg8::Unit u;
            if (S.so.next(wave >> 2, u)) { const int row0 = u.pm * 256 + (wave & 3) * 64;
                if (u.pn == 0) { const SkOutKT Ek{KCs}; skinny_unit<4, 4>(Gs, 256, W2Tk, 256, 256, row0, 0, Ek, lane); }
                else { const SkOutVT Ev{VCTs}; skinny_unit<4, 4, false>(Gs + (size_t)65536 * 256, 256, W2Tv, 256, 256, row0, 0, Ev, lane); } } } }
#endif
        if (BOTH(1)) GRID_BAR();
    }

    if (IN(3)) for (int rep = 0; rep < REP(3); ++rep) {
        PHASE_IDS();
        for (int it = wave * G + bx; it < 2 * 64; it += NGW) { const int kv = it >> 6, rg = it & 63;
            if (kv == 0) { const SkOutKT E{KCp}; skinny_unit<2, 4>(Gp, 256, W2Tk, 256, 256, rg * 32, 0, E, lane); }
            else { const SkOutVT E{VCTp}; skinny_unit<2, 4, false>(Gp + (size_t)2048 * 256, 256, W2Tv, 256, 256, rg * 32, 0, E, lane); } }
        if (BOTH(3)) GRID_BAR();
    }

    if (IN(4)) for (int rep = 0; rep < REP(4); ++rep) {
        PHASE_IDS();
        const LAS float* lut = (const LAS float*)(lds + LUT_OFF);
        LAS float* slog = (LAS float*)(lds + RING_OFF + wave * 16384);
        LAS float* wscr = (LAS float*)(lds + WSCR_OFF + wave * WSCR_BYTES);
        const PAttn PT{Qb, KSp, KWp, VTs, VTw, KCp, VCTp, GN, Ab};
        const SAttn ST{Qb, KCs, VCTs, KWs, VTWs, KWs + (size_t)64 * 576 * 64, VTWs + (size_t)64 * 9 * 4096, (const float*)args.in[4], (const float*)args.in[5], (const int*)args.in[9], GN, Ab};
        constexpr int NUNITS = 256 + 4 * (SEQ / 4); static_assert(NUNITS % 16 == 0, "queue shards");
#ifdef DBG_NO_ATTN
        for (int m = gw; m < NP + NSMP; m += NGW) *(GAS v4u*)(Ab + (size_t)m * 512 + lane * 8) = (v4u){0u, 0u, 0u, 0u};
#else
        int shard = (bx + wave) & 15, tried = 0, nraw = 0;
        gu32* qbase = ctl + CW_QUEUE + 1024 * rep;
        auto pop_sync = [&]() -> int {
            for (;;) { int t = 0; if (lane == 0) t = (int)__hip_atomic_fetch_add((unsigned*)(qbase + 64 * shard), 1u, RLX_AGENT);
                t = __builtin_amdgcn_readfirstlane(t);
                if (t < NUNITS / 16) return t * 16 + shard;
                if (++tried >= 16) return -1; shard = (shard + 1) & 15; } };
        auto pre = [&]() { if (lane == 0) nraw = (int)__hip_atomic_fetch_add((unsigned*)(qbase + 64 * shard), 1u, RLX_AGENT); };
        int u = pop_sync();
        while (u >= 0) {
            int ln = lane; asm volatile("" : "+v"(ln));
#ifdef DBG_REP4_MODE
            if (rep == 1 && ((DBG_REP4_MODE == 1) ? (u >= 256) : (u < 256))) pre(); else
#endif
            {
#ifndef NO_SAMPLE_ATTN
            if (u < 256) sample_attn_unit(ST, u, lut, slog, (LAS int*)(slog + 1024), ln, pre);
#else
            if (u < 256) pre();
#endif
#ifndef NO_PROMPT_ATTN
            else { const int v = u - 256, bk = v / (SEQ / 4), tg = (SEQ / 4 - 1) - (v % (SEQ / 4));
                prompt_attn_group(PT, bk >> 1, bk & 1, tg * 4, lut, slog, (LAS unsigned*)(slog + 512), ln, pre); }
#else
            else pre();
#endif
            }
            const int nt = __builtin_amdgcn_readfirstlane(nraw);
            if (nt < NUNITS / 16) u = nt * 16 + shard;
            else { if (++tried >= 16) break; shard = (shard + 1) & 15; u = pop_sync(); }
        }
#endif
        for (int m = NP + NSMP + gw; m < MTOK; m += NGW) *(GAS v4u*)(Ab + (size_t)m * 512 + lane * 8) = (v4u){0u, 0u, 0u, 0u};
        if (BOTH(4)) GRID_BAR();
    }

    if (IN(5)) for (int rep = 0; rep < REP(5); ++rep) {
        { pg8::Gemm g{Ab, WnsaT, NP, 2 * DM, 512, 512, 512};
          pg8::PairOrder S; S.init(NP, DM, G, bx, (int)(WS_CB - WS_AB));
          pg8::EpiNC E{GAB, Mb};
          pg8::gemm_phase<pg8::EpiNC, pg8::PairOrder, true, true>(lds + RING_OFF, g, S, E); }
        { PHASE_IDS();
          for (int it = wave * G + bx; it < 8 * 32; it += NGW) { const int row0 = NP + (it >> 5) * 16, col0 = (it & 31) * 32, r = lane & 15, qd = lane >> 4;
              f32x4 a1[2], a2[2];
#pragma unroll
              for (int b = 0; b < 2; ++b) { a1[b] = (f32x4){0.f, 0.f, 0.f, 0.f}; a2[b] = a1[b]; }
              const bf16* ap1 = Ab + (size_t)(row0 + r) * 512 + qd * 8; const bf16* ap2 = Cb + (size_t)(row0 + r) * 512 + qd * 8;
              const bf16* bp1 = WnsaT + (size_t)(col0 + r) * 512 + qd * 8; const bf16* bp2 = WconvT + (size_t)(col0 + r) * 512 + qd * 8;
#pragma unroll 1
              for (int k0 = 0; k0 < 512; k0 += 256) { bf16x8 f1[8], f2[8], w1[8][2], w2[8][2];
#pragma unroll
                  for (int u = 0; u < 8; ++u) { f1[u] = *(const GAS bf16x8*)(ap1 + k0 + 32 * u); f2[u] = *(const GAS bf16x8*)(ap2 + k0 + 32 * u);
#pragma unroll
                      for (int b = 0; b < 2; ++b) { w1[u][b] = *(const GAS bf16x8*)(bp1 + (size_t)b * 16 * 512 + k0 + 32 * u); w2[u][b] = *(const GAS bf16x8*)(bp2 + (size_t)b * 16 * 512 + k0 + 32 * u); } }
                  __builtin_amdgcn_sched_barrier(0);
#pragma unroll
                  for (int u = 0; u < 8; ++u)
#pragma unroll
                      for (int b = 0; b < 2; ++b) { a1[b] = __builtin_amdgcn_mfma_f32_16x16x32_bf16(w1[u][b], f1[u], a1[b], 0, 0, 0); a2[b] = __builtin_amdgcn_mfma_f32_16x16x32_bf16(w2[u][b], f2[u], a2[b], 0, 0, 0); }
                  __builtin_amdgcn_sched_barrier(0); }
#pragma unroll
              for (int b = 0; b < 2; ++b) { const int row = row0 + r, col = col0 + 16 * b + 4 * qd;
                  const v2u ga = *(const GAS v2u*)(GAB + (size_t)row * 2048 + col), gb = *(const GAS v2u*)(GAB + (size_t)row * 2048 + 1024 + col);
                  v2u w; w.x = pk2(bflo(ga.x) * a1[b][0] + bflo(gb.x) * a2[b][0], bfhi(ga.x) * a1[b][1] + bfhi(gb.x) * a2[b][1]);
                  w.y = pk2(bflo(ga.y) * a1[b][2] + bflo(gb.y) * a2[b][2], bfhi(ga.y) * a1[b][3] + bfhi(gb.y) * a2[b][3]);
                  *(GAS v2u*)(Mb + (size_t)row * 1024 + col) = w; } } }
        if (BOTH(5)) GRID_BAR();
    }

    if (IN(6)) for (int rep = 0; rep < REP(6); ++rep) {
        { pg8::Gemm g{Mb, WoT, NP, DM, DM, DM, DM}; pg8::StaticOrder S; S.init(NP, DM, G, bx);
          pg8::EpiWo E{x_prompt, x_sample, X1, X1b, PSS};
          pg8::gemm_phase<pg8::EpiWo, pg8::StaticOrder, false, true>(lds + RING_OFF, g, S, E); }
        { PHASE_IDS();
          for (int it = wave * G + bx; it < 8 * 16; it += NGW) { const int row0 = NP + (it >> 4) * 16, cgp = it & 15;
              const SkWo E{x_sample, X1, X1b, PSS, cgp};
              skinny_unit<1, 4>(Mb, 1024, WoT, 1024, 1024, row0, cgp * 64, E, lane); } }
        if (BOTH(6)) GRID_BAR();
    }

    if (IN(7)) for (int rep = 0; rep < REP(7); ++rep) {
        { pg8::Gemm g{X1b, WupT, NP, DFF, DM, DM, DM}; pg8::StaticOrder S; S.init(NP, DFF, G, bx);
          pg8::EpiUp E{PSS, Hb};
          pg8::gemm_phase<pg8::EpiUp, pg8::StaticOrder, true, true>(lds + RING_OFF, g, S, E); }
        { PHASE_IDS();
          for (int it = wave * G + bx; it < 8 * 64; it += NGW) { const int row0 = NP + (it >> 6) * 16, col0 = (it & 63) * 64;
              const SkUp E{PSS, Hb};
              skinny_unit<1, 4>(X1b, 1024, WupT, 1024, 1024, row0, col0, E, lane); } }
        if (BOTH(7)) GRID_BAR();
    }

    if (IN(8)) for (int rep = 0; rep < REP(8); ++rep) {
        { pg8::Gemm g{Hb, WdnT, NP, DM, DFF, DFF, DFF}; pg8::StaticOrder S; S.init(NP, DM, G, bx);
          pg8::EpiDownNorm E{X1b, out, (const float*)args.in[27], (float*)(ws + WS_PSS2), (unsigned*)(ctl + CW_PANEL), (unsigned*)(ctl + CW_TMO)};
          pg8::gemm_phase<pg8::EpiDownNorm, pg8::StaticOrder, true, true>(lds + RING_OFF, g, S, E); }
        { PHASE_IDS();
          for (int it = wave * G + bx; it < 8 * 16 * 8; it += NGW) { const int kp = it & 7, cgp = (it >> 3) & 15, row0 = NP + (it >> 7) * 16;
              const SkPart E{PD + (size_t)kp * NSMP * 1024 - (size_t)NP * 1024};
              skinny_unit<1, 4>(Hb + kp * 512, 4096, WdnT + kp * 512, 4096, 512, row0, cgp * 64, E, lane); } }
        if (BOTH(8)) GRID_BAR();
    }

#ifdef DBG_DUMP
    if (lo <= 9 && 9 < hi) {
        PHASE_IDS();
        for (int m = gw; m < NP + NSMP; m += NGW) { GAS f32x4* o = (GAS f32x4*)(out + O_YP + (size_t)m * DM) + lane;
#pragma unroll
            for (int j = 0; j < 4; ++j) { const int col = (lane + 64 * j) * 4; f32x4 v;
#if DBG_DUMP == 1
                const v2u w = *(const GAS v2u*)(Mb + (size_t)m * 1024 + col); v = (f32x4){bflo(w.x), bfhi(w.x), bflo(w.y), bfhi(w.y)};
#elif DBG_DUMP == 2
                v = *(const GAS f32x4*)(X1 + (size_t)m * 1024 + col);
#elif DBG_DUMP == 5
                if (col < 512) { const v2u w = *(const GAS v2u*)(Cb + (size_t)m * 512 + col); v = (f32x4){bflo(w.x), bfhi(w.x), bflo(w.y), bfhi(w.y)}; } else { const v2u w = *(const GAS v2u*)(Qb + (size_t)m * 512 + col - 512); v = (f32x4){bflo(w.x), bfhi(w.x), bflo(w.y), bfhi(w.y)}; }
#elif DBG_DUMP == 6
                { const v2u w = *(const GAS v2u*)(GAB + (size_t)m * 2048 + col); v = (f32x4){bflo(w.x), bfhi(w.x), bflo(w.y), bfhi(w.y)}; }
#elif DBG_DUMP == 7
                { const v2u w = *(const GAS v2u*)(GAB + (size_t)m * 2048 + 1024 + col); v = (f32x4){bflo(w.x), bfhi(w.x), bflo(w.y), bfhi(w.y)}; }
#elif DBG_DUMP == 3
                const v2u w = *(const GAS v2u*)(Hb + (size_t)m * 4096 + col); v = (f32x4){bflo(w.x), bfhi(w.x), bflo(w.y), bfhi(w.y)};
#else
                v = *(const GAS f32x4*)(M1 + (size_t)m * 1024 + col);
#endif
                o[64 * j] = v; } }
    }
#endif
    if (IN(9)) {
        PHASE_IDS();
        const float* g_final = (const float*)args.in[27];
        for (int m = NP + wave * G + bx; m < NP + NSMP; m += NGW) { GAS f32x4* xr = (GAS f32x4*)(out + O_YP + (size_t)m * DM) + lane; const GAS f32x4* gr = (const GAS f32x4*)g_final + lane;
            f32x4 v[4]; float s = 0.f;
            if (m >= NP) {
#pragma unroll
                for (int j = 0; j < 4; ++j) { v[j] = ((const GAS f32x4*)(X1 + (size_t)m * DM) + lane)[64 * j];
#pragma unroll
                    for (int kp = 0; kp < 8; ++kp) v[j] += ((const GAS f32x4*)(PD + ((size_t)kp * NSMP + (m - NP)) * DM) + lane)[64 * j]; }
            } else {
#pragma unroll
                for (int j = 0; j < 4; ++j) v[j] = xr[64 * j];
            }
#pragma unroll
            for (int j = 0; j < 4; ++j) s += (v[j].x * v[j].x + v[j].y * v[j].y) + (v[j].z * v[j].z + v[j].w * v[j].w);
            const float rstd = 1.f / sqrtf(wave_sum(s) * (1.f / 1024.f) + RMS_EPS);
#pragma unroll
            for (int j = 0; j < 4; ++j) xr[64 * j] = v[j] * rstd * gr[64 * j]; }
    }
#undef IN
#undef BOTH
}

extern "C" void kernel_launch(void* const* d_in, const int* in_sizes, int n_in, void* d_out, int out_size, void* d_ws, size_t ws_size, hipStream_t stream) {
    static int grid = 0;
    if (grid == 0) {
        if (n_in != 28 || out_size != (int)O_END || ws_size < WS_END) { fprintf(stderr, "kernel_launch: unexpected problem: n_in %d out %d ws %zu (need %zu)\n", n_in, out_size, ws_size, (size_t)WS_END); grid = -1; return; }
        int dev = 0, cus = 0, per_cu = 0;
        if (hipGetDevice(&dev) != hipSuccess || hipDeviceGetAttribute(&cus, hipDeviceAttributeMultiprocessorCount, dev) != hipSuccess) { grid = -1; return; }
        if (hipFuncSetAttribute((const void*)nsa_fwd, hipFuncAttributeMaxDynamicSharedMemorySize, LDS_BYTES) != hipSuccess) { fprintf(stderr, "kernel_launch: hipFuncSetAttribute failed\n"); grid = -1; return; }
        if (hipOccupancyMaxActiveBlocksPerMultiprocessor(&per_cu, (const void*)nsa_fwd, NWAVES * 64, LDS_BYTES) != hipSuccess || per_cu < 1) { fprintf(stderr, "kernel_launch: occupancy query says %d workgroups per CU\n", per_cu); }
        (void)hipGetLastError();
        grid = cus;
    }
    if (grid < 0) return;
    if (hipMemsetAsync((char*)d_ws + WS_CTL, 0, CTL_ZERO_BYTES, stream) != hipSuccess) return;
    Args a{};
    for (int i = 0; i < 28; ++i) a.in[i] = d_in[i];
    a.out = (float*)d_out; a.ws = (unsigned char*)d_ws;
#if MK_N_LAUNCHES == 1
    a.ph_lo = 0; a.ph_hi = N_PHASES;
    hipLaunchKernelGGL(nsa_fwd, dim3(grid), dim3(NWAVES * 64), LDS_BYTES, stream, a);
#else
    for (int p = 0; p < N_PHASES; ++p) { a.ph_lo = p; a.ph_hi = p + 1; hipLaunchKernelGGL(nsa_fwd, dim3(grid), dim3(NWAVES * 64), LDS_BYTES, stream, a); }
#endif
}
```
